# Optimizing an MI355X kernel written in HIP

```python
import math
import jax, jax.numpy as jnp
from jax import lax
import numpy as np

D_MODEL = 1024
BATCH = 8
SEQ = 4096
DEPTH = 4

F32 = jnp.float32
GRID_W = 64
CTX_LEN = 256
N_MIXERS = 4
NORM_EPS = 1e-6

HG_HEADS = 8
HG_KEY = D_MODEL // HG_HEADS
HG_VAL = D_MODEL // HG_HEADS
HG_CHUNK = 32

HY_ORDER = 2
HY_SHORT = 3
HY_EMB = 33
HY_FILTER_W = 64
HY_DECAY_TARGET = 1e-2
HY_DECAY_HI_PCT = 0.3
HY_DECAY_LO_PCT = 1.5

MB_INNER = 2 * D_MODEL
MB_HEADDIM = 64
MB_HEADS = MB_INNER // MB_HEADDIM
MB_GROUPS = 8
MB_HPG = MB_HEADS // MB_GROUPS
MB_STATE = 128
MB_CONV = 5
MB_CHUNK = 64
MB_CONV_DIM = MB_INNER + 2 * MB_GROUPS * MB_STATE
MB_IN = MB_INNER + MB_CONV_DIM + 2 * MB_HEADS

GLA_HEADS = 4
GLA_KEY_DIM = D_MODEL // 2
GLA_VAL_DIM = D_MODEL
GLA_HK = GLA_KEY_DIM // GLA_HEADS
GLA_HV = GLA_VAL_DIM // GLA_HEADS
GLA_GATE_RANK = 16
GLA_GATE_NORM = 16.0
GLA_CHUNK = 32
GLA_IN = 2 * GLA_KEY_DIM + 2 * GLA_VAL_DIM + 2 * GLA_GATE_RANK

N_EXPERTS = 16
EC_CAPACITY_FACTOR = 2
EXPERT_FF = 2048

kernel_name = 'hybrid_interleaved_diffusion_trunk'


def rmsnorm(x, g):
    xf = x.astype(F32)
    return xf * lax.rsqrt(jnp.mean(xf * xf, axis=-1, keepdims=True) + NORM_EPS) * g


def adaln(cond, w, b):
    m = jax.nn.silu(cond.astype(F32)) @ w + b
    return jnp.split(m[..., None, :], 6, axis=-1)


def modulate(h, shift, scale):
    return h * (1.0 + scale) + shift


def heads(t, n):
    b, l, _ = t.shape
    return t.reshape(b, l, n, -1).transpose(0, 2, 1, 3)


def dwconv_centered(x, w, b):
    k_w = w.shape[0]
    pad = k_w // 2
    length = x.shape[1]
    xp = jnp.pad(x, ((0, 0), (pad, pad), (0, 0)))
    return sum(xp[:, j:j + length] * w[j] for j in range(k_w)) + b


def raster_to_colmajor(h, rows):
    b, l, d = h.shape
    return h.reshape(b, rows, GRID_W, d).transpose(0, 2, 1, 3).reshape(b, l, d)


def colmajor_to_raster(h, rows):
    b, l, d = h.shape
    return h.reshape(b, GRID_W, rows, d).transpose(0, 2, 1, 3).reshape(b, l, d)


def chunk_gla(q, k, v, g, s0, chunk):
    bsz, nh, length, kd = q.shape
    vd = v.shape[-1]
    n = length // chunk

    def split_chunks(t):
        return jnp.moveaxis(t.astype(F32).reshape(bsz, nh, n, chunk, t.shape[-1]), 2, 0)

    qs, ks, vs, gs = split_chunks(q), split_chunks(k), split_chunks(v), split_chunks(g)
    cum = jnp.cumsum(gs, axis=3)
    lower = jnp.tril(jnp.ones((chunk, chunk), bool))[:, :, None]

    def step(state, inp):
        qc, kc, vc, gc = inp
        rel = jnp.where(lower, gc[:, :, :, None, :] - gc[:, :, None, :, :], -jnp.inf)
        att = jnp.einsum('bhtk,bhsk,bhtsk->bhts', qc, kc, jnp.exp(rel))
        g_end = gc[:, :, -1:, :]
        o = att @ vc + jnp.einsum('bhtk,bhkv->bhtv', qc * jnp.exp(gc), state)
        state = jnp.exp(g_end[:, :, 0, :, None]) * state + jnp.einsum('bhsk,bhsv->bhkv', kc * jnp.exp(g_end - gc), vc)
        return state, o

    state, o = lax.scan(step, s0.astype(F32), (qs, ks, vs, cum))
    return jnp.moveaxis(o, 0, 2).reshape(bsz, nh, length, vd), state


def bidir_gla(lat, ctx, chunk):
    q, kf, kb, v, gf, gb = lat
    qc, kfc, kbc, vc, gfc, gbc = ctx
    s0 = jnp.zeros(q.shape[:2] + (q.shape[-1], v.shape[-1]), F32)
    oc_f, s_f = chunk_gla(qc, kfc, vc, gfc, s0, chunk)
    ox_f, _ = chunk_gla(q, kf, v, gf, s_f, chunk)
    r = lambda t: jnp.flip(t, axis=2)
    oc_b, s_b = chunk_gla(r(qc), r(kbc), r(vc), r(gbc), s0, chunk)
    ox_b, _ = chunk_gla(r(q), r(kb), r(v), r(gb), s_b, chunk)
    return ox_f + r(ox_b), oc_f + r(oc_b)


def gated_head_out(o, og, gain, w_out):
    b, nh, l, vd = o.shape
    o = rmsnorm(o.transpose(0, 2, 1, 3), gain).reshape(b, l, nh * vd)
    return (o * jax.nn.silu(og)) @ w_out


def hgrn_lower_bound(lb_param, layer):
    return jnp.cumsum(jax.nn.softmax(lb_param.astype(F32), axis=0), axis=0)[layer]


def hgrn2_mixer(hx, hc, w_in, lb, onorm_g, w_out):
    def project(h):
        q, ff, fb, inp, og = jnp.split(h @ w_in, 5, axis=-1)
        f_fwd = lb + (1.0 - lb) * jax.nn.sigmoid(ff.astype(F32))
        f_bwd = lb + (1.0 - lb) * jax.nn.sigmoid(fb.astype(F32))
        hd = lambda t: heads(t, HG_HEADS)
        streams = (hd(jax.nn.silu(q) * HG_KEY ** -0.5), hd(1.0 - f_fwd), hd(1.0 - f_bwd), hd(inp),
                   hd(jnp.log(f_fwd)), hd(jnp.log(f_bwd)))
        return streams, og

    lat, ogx = project(hx)
    ctxs, ogc = project(hc)
    ox, oc = bidir_gla(lat, ctxs, HG_CHUNK)
    return gated_head_out(ox, ogx, onorm_g, w_out), gated_head_out(oc, ogc, onorm_g, w_out)


def hyena_pos_features(length):
    t = jnp.linspace(0.0, 1.0, length, dtype=F32)[:, None]
    bands = (HY_EMB - 1) // 2
    f = jnp.linspace(1e-4, bands - 1, bands, dtype=F32)[None, :]
    w = 2.0 * math.pi * jnp.arange(length, dtype=F32)[:, None] / length
    return jnp.concatenate([t, jnp.cos(f * w), -jnp.sin(f * w)], axis=-1), t


def hyena_window(t):
    max_decay = math.log(HY_DECAY_TARGET) / HY_DECAY_HI_PCT
    min_decay = math.log(HY_DECAY_TARGET) / HY_DECAY_LO_PCT
    deltas = jnp.abs(jnp.linspace(min_decay, max_decay, D_MODEL, dtype=F32))
    return jnp.exp(-t * deltas[None, :])


def hyena_filters(length, w1, b1, w2, b2, w3, b3, w4, freq):
    z, t = hyena_pos_features(length)
    a = jnp.sin(freq * (z @ w1 + b1))
    a = jnp.sin(freq * (a @ w2 + b2))
    a = jnp.sin(freq * (a @ w3 + b3))
    h = (a @ w4).astype(F32).reshape(length, HY_ORDER, 2, D_MODEL) * hyena_window(t)[:, None, None, :]
    return h / jnp.sum(jnp.abs(h), axis=(0, 2), keepdims=True)


def twosided_fftconv(u, h_fwd, h_bwd):
    length = u.shape[1]
    k2 = jnp.concatenate([h_fwd, jnp.zeros_like(h_fwd[:1]), h_bwd[:0:-1]], axis=0)
    spec = jnp.fft.rfft(u, n=2 * length, axis=1) * jnp.fft.rfft(k2, axis=0)[None]
    return jnp.fft.irfft(spec, n=2 * length, axis=1)[:, :length]


def hyena_mixer(hx, hc, w_in, b_in, short_w, short_b, f_w1, f_b1, f_w2, f_b2, f_w3, f_b3, f_w4,
                f_freq, f_bias, w_out, b_out):
    def run(h):
        length = h.shape[1]
        u = dwconv_centered(h @ w_in + b_in, short_w, short_b).astype(F32)
        x1, x2, v = jnp.split(u, 3, axis=-1)
        filt = hyena_filters(length, f_w1, f_b1, f_w2, f_b2, f_w3, f_b3, f_w4, f_freq)
        z = v
        for o, gate in enumerate((x1, x2)):
            z = gate * (twosided_fftconv(z, filt[:, o, 0], filt[:, o, 1]) + z * f_bias[o])
        return z @ w_out + b_out

    return run(hx), run(hc)


def chunk_ssd(xs, bm, cm, dt, a, s0, chunk):
    bsz, length = xs.shape[:2]
    n = length // chunk

    def split_chunks(t):
        return jnp.moveaxis(t.astype(F32).reshape((bsz, n, chunk) + t.shape[2:]), 1, 0)

    xcs, bcs, ccs, dts = split_chunks(xs), split_chunks(bm), split_chunks(cm), split_chunks(dt)
    cum = jnp.cumsum(dts * a.astype(F32), axis=2)
    lower = jnp.tril(jnp.ones((chunk, chunk), bool))[:, :, None, None]

    def step(state, inp):
        xc, bc, cc, dtc, lc = inp
        seg = jnp.exp(jnp.where(lower, lc[:, :, None] - lc[:, None, :], -jnp.inf))
        w = jnp.einsum('btgn,bsgn->btsg', cc, bc)[..., None] * seg * dtc[:, None]
        y = jnp.einsum('btsgh,bsghp->btghp', w, xc)
        y = y + jnp.einsum('btgn,bghnp->btghp', cc, state) * jnp.exp(lc)[..., None]
        l_end = lc[:, -1]
        state = jnp.exp(l_end)[..., None, None] * state + jnp.einsum(
            'bsgn,bsgh,bsghp->bghnp', bc, jnp.exp(l_end[:, None] - lc) * dtc, xc)
        return state, y

    state, y = lax.scan(step, s0.astype(F32), (xcs, bcs, ccs, dts, cum))
    return jnp.moveaxis(y, 0, 1).reshape(xs.shape), state


def mamba2_mixer(hx, hc, w_in, conv_w, conv_b, dt_bias, a_log, d_skip, norm_g, w_out):
    a = -jnp.exp(a_log.astype(F32)).reshape(2, MB_GROUPS, MB_HPG)

    def project(h):
        bsz, length, _ = h.shape
        z, xbc, dt_raw = jnp.split(h @ w_in, [MB_INNER, MB_INNER + MB_CONV_DIM], axis=-1)
        xbc = jax.nn.silu(dwconv_centered(xbc, conv_w, conv_b))
        xs, bm, cm = jnp.split(xbc, [MB_INNER, MB_INNER + MB_GROUPS * MB_STATE], axis=-1)
        xs = xs.reshape(bsz, length, MB_GROUPS, MB_HPG, MB_HEADDIM)
        bm = bm.reshape(bsz, length, MB_GROUPS, MB_STATE)
        cm = cm.reshape(bsz, length, MB_GROUPS, MB_STATE)
        dt = jax.nn.softplus(dt_raw.astype(F32).reshape(bsz, length, 2, MB_GROUPS, MB_HPG)
                             + dt_bias.reshape(2, MB_GROUPS, MB_HPG))
        return z, xs, bm, cm, dt

    zx, xx, bx, cx, dtx = project(hx)
    zc, xc, bc, cc, dtc = project(hc)
    s0 = jnp.zeros((hx.shape[0], MB_GROUPS, MB_HPG, MB_STATE, MB_HEADDIM), F32)
    yc_f, s_f = chunk_ssd(xc, bc, cc, dtc[:, :, 0], a[0], s0, MB_CHUNK)
    yx_f, _ = chunk_ssd(xx, bx, cx, dtx[:, :, 0], a[0], s_f, MB_CHUNK)
    r = lambda t: jnp.flip(t, axis=1)
    yc_b, s_b = chunk_ssd(r(xc), r(bc), r(cc), r(dtc[:, :, 1]), a[1], s0, MB_CHUNK)
    yx_b, _ = chunk_ssd(r(xx), r(bx), r(cx), r(dtx[:, :, 1]), a[1], s_b, MB_CHUNK)

    def finish(y, xs, z):
        bsz, length = y.shape[:2]
        y = y + d_skip.reshape(MB_GROUPS, MB_HPG)[..., None] * xs
        y = y.reshape(bsz, length, MB_INNER) * jax.nn.silu(z)
        y = rmsnorm(y.reshape(bsz, length, MB_GROUPS, MB_INNER // MB_GROUPS),
                    norm_g.reshape(MB_GROUPS, MB_INNER // MB_GROUPS))
        return y.reshape(bsz, length, MB_INNER) @ w_out

    return finish(yx_f + r(yx_b), xx, zx), finish(yc_f + r(yc_b), xc, zc)


def gla_mixer(hx, hc, w_in, gk_w2, gk_b, onorm_g, w_out):
    rows = hx.shape[1] // GRID_W
    kd, vd, rk = GLA_KEY_DIM, GLA_VAL_DIM, GLA_GATE_RANK
    cuts = [kd, 2 * kd, 2 * kd + vd, 2 * kd + 2 * vd, 2 * kd + 2 * vd + rk]

    def project(h):
        q, k, v, og, rf, rb = jnp.split(h @ w_in, cuts, axis=-1)
        gf = jax.nn.log_sigmoid((rf @ gk_w2[0] + gk_b[0]).astype(F32)) / GLA_GATE_NORM
        gb = jax.nn.log_sigmoid((rb @ gk_w2[1] + gk_b[1]).astype(F32)) / GLA_GATE_NORM
        hd = lambda t: heads(t, GLA_HEADS)
        kh = hd(k)
        return (hd(q * GLA_HK ** -0.5), kh, kh, hd(v), hd(gf), hd(gb)), og

    lat, ogx = project(raster_to_colmajor(hx, rows))
    ctxs, ogc = project(hc)
    ox, oc = bidir_gla(lat, ctxs, GLA_CHUNK)
    yx = colmajor_to_raster(gated_head_out(ox, ogx, onorm_g, w_out), rows)
    return yx, gated_head_out(oc, ogc, onorm_g, w_out)


def expert_choice_ffn(h, router_w, w_gate, w_up, w_down):
    bsz, t_len, d = h.shape
    cap = max(1, EC_CAPACITY_FACTOR * t_len // N_EXPERTS)
    aff = jax.nn.softmax(h.astype(F32) @ router_w.astype(F32), axis=-1)
    gate, idx = lax.top_k(jnp.swapaxes(aff, 1, 2), cap)
    xg = jax.vmap(lambda hb, ib: hb[ib])(h, idx)
    hid = jax.nn.silu(jnp.einsum('becd,edf->becf', xg, w_gate)) * jnp.einsum('becd,edf->becf', xg, w_up)
    ye = jnp.einsum('becf,efd->becd', hid, w_down) * gate[..., None]
    return jax.vmap(lambda ib, yb: jnp.zeros((t_len, d), yb.dtype).at[ib.reshape(-1)].add(yb.reshape(-1, d)))(idx, ye)


def setup_inputs(seed: int = 0) -> dict:
    key = jax.random.key(seed)
    ks = iter(jax.random.split(key, 64))

    def nrm(shape, scale):
        return scale * jax.random.normal(next(ks), shape, F32)

    def lin(*shape):
        return nrm(shape, shape[-2] ** -0.5)

    def gain(*shape):
        return 1.0 + nrm(shape, 0.05)

    n_a, n_b, n_c, n_d = (len(range(m, DEPTH, N_MIXERS)) for m in range(N_MIXERS))
    d = D_MODEL
    dt0 = jnp.exp(jax.random.uniform(next(ks), (n_c, 2, MB_HEADS), F32, math.log(1e-3), math.log(1e-1)))
    a0 = jax.random.uniform(next(ks), (n_c, 2, MB_HEADS), F32, 1.0, 16.0)
    return dict(
        x=nrm((BATCH, SEQ, d), 1.0),
        c=nrm((BATCH, d), 1.0),
        ctx=nrm((BATCH, CTX_LEN, d), 1.0),
        c_ctx=nrm((d,), 1.0),
        ada_w=nrm((DEPTH, d, 6 * d), 0.5 * d ** -0.5),
        ada_b=nrm((DEPTH, 6 * d), 0.02),
        norm1_g=gain(DEPTH, d),
        norm2_g=gain(DEPTH, d),
        hg_w_in=lin(n_a, d, 5 * d),
        hg_lb=nrm((DEPTH + 1, d), 0.1),
        hg_onorm_g=gain(n_a, HG_VAL),
        hg_w_out=lin(n_a, d, d),
        hy_w_in=lin(n_b, d, 3 * d),
        hy_b_in=nrm((n_b, 3 * d), 0.02),
        hy_short_w=nrm((n_b, HY_SHORT, 3 * d), HY_SHORT ** -0.5),
        hy_short_b=nrm((n_b, 3 * d), 0.02),
        hy_f_w1=lin(n_b, HY_EMB, HY_FILTER_W),
        hy_f_b1=nrm((n_b, HY_FILTER_W), 0.1),
        hy_f_w2=lin(n_b, HY_FILTER_W, HY_FILTER_W),
        hy_f_b2=nrm((n_b, HY_FILTER_W), 0.1),
        hy_f_w3=lin(n_b, HY_FILTER_W, HY_FILTER_W),
        hy_f_b3=nrm((n_b, HY_FILTER_W), 0.1),
        hy_f_w4=lin(n_b, HY_FILTER_W, HY_ORDER * 2 * d),
        hy_f_freq=gain(n_b, HY_FILTER_W),
        hy_f_bias=nrm((n_b, HY_ORDER, d), 0.5),
        hy_w_out=lin(n_b, d, d),
        hy_b_out=nrm((n_b, d), 0.02),
        mb_w_in=lin(n_c, d, MB_IN),
        mb_conv_w=nrm((n_c, MB_CONV, MB_CONV_DIM), MB_CONV ** -0.5),
        mb_conv_b=nrm((n_c, MB_CONV_DIM), 0.02),
        mb_dt_bias=dt0 + jnp.log(-jnp.expm1(-dt0)),
        mb_a_log=jnp.log(a0),
        mb_d=gain(n_c, MB_HEADS),
        mb_norm_g=gain(n_c, MB_INNER),
        mb_w_out=lin(n_c, MB_INNER, d),
        gla_w_in=lin(n_d, d, GLA_IN),
        gla_gk_w2=lin(n_d, 2, GLA_GATE_RANK, GLA_KEY_DIM),
        gla_gk_b=nrm((n_d, 2, GLA_KEY_DIM), 0.1),
        gla_onorm_g=gain(n_d, GLA_HV),
        gla_w_out=lin(n_d, GLA_VAL_DIM, d),
        router_w=lin(DEPTH, d, N_EXPERTS),
        moe_w_gate=lin(DEPTH, N_EXPERTS, d, EXPERT_FF),
        moe_w_up=lin(DEPTH, N_EXPERTS, d, EXPERT_FF),
        moe_w_down=lin(DEPTH, N_EXPERTS, EXPERT_FF, d),
        final_norm_g=gain(d),
    )


def reference(x, c, ctx, c_ctx, ada_w, ada_b, norm1_g, norm2_g,
              hg_w_in, hg_lb, hg_onorm_g, hg_w_out,
              hy_w_in, hy_b_in, hy_short_w, hy_short_b, hy_f_w1, hy_f_b1, hy_f_w2, hy_f_b2,
              hy_f_w3, hy_f_b3, hy_f_w4, hy_f_freq, hy_f_bias, hy_w_out, hy_b_out,
              mb_w_in, mb_conv_w, mb_conv_b, mb_dt_bias, mb_a_log, mb_d, mb_norm_g, mb_w_out,
              gla_w_in, gla_gk_w2, gla_gk_b, gla_onorm_g, gla_w_out,
              router_w, moe_w_gate, moe_w_up, moe_w_down, final_norm_g):
    for i in range(DEPTH):
        last = i == DEPTH - 1
        sh1, sc1, g1, sh2, sc2, g2 = adaln(c, ada_w[i], ada_b[i])
        csh1, csc1, cg1, csh2, csc2, cg2 = adaln(c_ctx, ada_w[i], ada_b[i])
        hx = modulate(rmsnorm(x, norm1_g[i]), sh1, sc1)
        hc = modulate(rmsnorm(ctx, norm1_g[i]), csh1, csc1)
        kind, j = i % N_MIXERS, i // N_MIXERS
        if kind == 0:
            yx, yc = hgrn2_mixer(hx, hc, hg_w_in[j], hgrn_lower_bound(hg_lb, i), hg_onorm_g[j], hg_w_out[j])
        elif kind == 1:
            yx, yc = hyena_mixer(hx, hc, hy_w_in[j], hy_b_in[j], hy_short_w[j], hy_short_b[j],
                                 hy_f_w1[j], hy_f_b1[j], hy_f_w2[j], hy_f_b2[j], hy_f_w3[j], hy_f_b3[j],
                                 hy_f_w4[j], hy_f_freq[j], hy_f_bias[j], hy_w_out[j], hy_b_out[j])
        elif kind == 2:
            yx, yc = mamba2_mixer(hx, hc, mb_w_in[j], mb_conv_w[j], mb_conv_b[j], mb_dt_bias[j],
                                  mb_a_log[j], mb_d[j], mb_norm_g[j], mb_w_out[j])
        else:
            yx, yc = gla_mixer(hx, hc, gla_w_in[j], gla_gk_w2[j], gla_gk_b[j], gla_onorm_g[j], gla_w_out[j])
        x = x + g1 * yx
        x = x + g2 * expert_choice_ffn(modulate(rmsnorm(x, norm2_g[i]), sh2, sc2),
                                       router_w[i], moe_w_gate[i], moe_w_up[i], moe_w_down[i])
        if not last:
            ctx = ctx + cg1 * yc
            ctx = ctx + cg2 * expert_choice_ffn(modulate(rmsnorm(ctx, norm2_g[i]), csh2, csc2),
                                                router_w[i], moe_w_gate[i], moe_w_up[i], moe_w_down[i])
    return rmsnorm(x, final_norm_g)
```

```cpp
#include <hip/hip_runtime.h>
#include <cstdio>
#include <cstdint>
#define N_LAUNCH_MODE 0
namespace pg8 {
#define PG8_LAS __attribute__((address_space(3)))
typedef unsigned short bf16_t;
typedef short bf16x8 __attribute__((ext_vector_type(8)));
typedef float f32x4 __attribute__((ext_vector_type(4)));
typedef unsigned u32x4 __attribute__((ext_vector_type(4)));
constexpr int BM = 256, BK = 64, HALF = 128, HTB = HALF * BK * 2  , STAGE_BYTES = 8 * HTB, NXCD = 8, WGM = 4;

__host__ __device__ __forceinline__ int lds_byte(int r, int c) { const int st = (r >> 4) * 2 + (c >> 5), rr = r & 15, cc = c & 31, ob = rr * 64 + cc * 2; return st * 1024 + (ob ^ (((ob >> 9) & 1) << 5)); }
__host__ __device__ __forceinline__ void stage_rc(int b, int& R, int& C) { const int st = b / 1024, sb = b % 1024, swz = sb ^ (((sb >> 9) & 1) << 5); R = (st >> 1) * 16 + swz / 64; C = (st & 1) * 32 + (swz % 64) / 2; }
__host__ __device__ __forceinline__ int perm32(int rho) { const int n = rho >> 4, i = rho & 15; return 8 * (i >> 2) + 4 * n + (i & 3); }

struct Unit { int pm, pn; int kq = 0; };
struct Gemm { const bf16_t* A; const bf16_t* Bt; int M, N, K; const int* rowmap; int lda; };

struct StaticOrder {
    int nM, nN, nwg, G, c;
    __host__ __device__ void init(int M, int N, int G_, int c_) { nM = M / BM; nN = N / BM; nwg = nM * nN; G = G_; c = c_; }
    __host__ __device__ bool next(int i, Unit& u) const {
        const long L = (long)i * G + c; if (L >= nwg) return false;
        int wgid = (int)L; { const int q = nwg / NXCD, r = nwg % NXCD, xcd = wgid % NXCD, off = wgid / NXCD; wgid = (xcd < r ? xcd * (q + 1) : r * (q + 1) + (xcd - r) * q) + off; }
        const int nig = WGM * nN, gid = wgid / nig, fm = gid * WGM, gsz = (nM - fm) < WGM ? (nM - fm) : WGM;
        u.pm = fm + ((wgid % nig) % gsz); u.pn = (wgid % nig) / gsz; return true;
    }
    __device__ __forceinline__ void a_ready(const Unit&) const {}
    __device__ __forceinline__ void done(const Unit&) const {}
};

__device__ __forceinline__ unsigned cvt_pk_bf16(float lo, float hi) { unsigned r; asm volatile("v_cvt_pk_bf16_f32 %0, %1, %2" : "=v"(r) : "v"(lo), "v"(hi)); return r; }

template <class Epi, class Sched, bool ALIGN_EPI = false, bool SP2 = false, bool GATHER = false>
__device__ __forceinline__ void gemm_phase(PG8_LAS unsigned char* lds, const Gemm g, const Sched& S, const Epi& E) {
    const int tid = threadIdx.x, wid = __builtin_amdgcn_readfirstlane(tid >> 6), lane = tid & 63, wr = wid >> 2, wc = wid & 3, fr = lane & 15, fq = lane >> 4;
    const int K = g.K, nt = K / BK, LD = g.lda ? g.lda : g.K;
    unsigned voffA[2], voffB[2];
#pragma unroll
    for (int i = 0; i < 2; ++i) { int R, C; stage_rc(tid * 16 + i * 8192, R, C); const int Rb = Epi::PERM ? ((R & ~31) + perm32(R & 31)) : R;
        voffA[i] = (unsigned)(R * LD + C) * 2u; voffB[i] = (unsigned)(Rb * LD + C) * 2u; }
    const size_t kstep = (size_t)(BK * 2);
    const size_t hstep = (size_t)HALF * LD * 2;
    const size_t tstep = 2 * hstep;
    const unsigned ldsw = (unsigned)wid * 1024u;
    const int aoff = lds_byte(wr * 64 + fr, fq * 8), boff = lds_byte(wc * 32 + fr, fq * 8);
#define PG8_SA(b, h) (((b) * 2 + (h)) * HTB)
#define PG8_SB(b, h) ((4 + (b) * 2 + (h)) * HTB)
#define PG8_STAGE(bufoff, gbase, voff) do { _Pragma("unroll") for (int _i = 0; _i < 2; ++_i) \
        __builtin_amdgcn_global_load_lds((const unsigned*)((const char*)(gbase) + (voff)[_i]), (PG8_LAS unsigned*)(lds + (bufoff) + ldsw + _i * 8192), 16, 0, 0); } while (0)
#define PG8_LDA(dst, b, h) do { _Pragma("unroll") for (int m = 0; m < 4; ++m) _Pragma("unroll") for (int k = 0; k < 2; ++k) dst[m][k] = *(const PG8_LAS bf16x8*)(lds + PG8_SA(b, h) + aoff + m * 2048 + k * 1024); } while (0)
#define PG8_LDB(dst, b, h) do { _Pragma("unroll") for (int n = 0; n < 2; ++n) _Pragma("unroll") for (int k = 0; k < 2; ++k) dst[n][k] = *(const PG8_LAS bf16x8*)(lds + PG8_SB(b, h) + boff + n * 2048 + k * 1024); } while (0)
#define PG8_MMA(ai, bj, At, Bt) do { __builtin_amdgcn_s_setprio(1); _Pragma("unroll") for (int m = 0; m < 4; ++m) _Pragma("unroll") for (int n = 0; n < 2; ++n) _Pragma("unroll") for (int k = 0; k < 2; ++k) \
        acc[ai][bj][m][n] = __builtin_amdgcn_mfma_f32_16x16x32_bf16(Bt[n][k], At[m][k], acc[ai][bj][m][n], 0, 0, 0); __builtin_amdgcn_s_setprio(0); } while (0)
#define PG8_WAIT_V(n) asm volatile("s_waitcnt vmcnt(" #n ")" ::: "memory")
#define PG8_WAIT_L(n) asm volatile("s_waitcnt lgkmcnt(" #n ")" ::: "memory")
#define PG8_BAR __builtin_amdgcn_s_barrier()
#define PG8_SCHED __builtin_amdgcn_sched_barrier(0)
    Unit cur, nxt; int ui = 0;
    if (!S.next(0, cur)) return;
    f32x4 acc[2][2][4][2];
#pragma unroll
    for (int a = 0; a < 2; ++a)
#pragma unroll
        for (int b = 0; b < 2; ++b)
#pragma unroll
            for (int m = 0; m < 4; ++m)
#pragma unroll
                for (int n = 0; n < 2; ++n) acc[a][b][m][n] = (f32x4){0.f, 0.f, 0.f, 0.f};
    bf16x8 At[4][2], B0[2][2], B1[2][2];
    const char* cA = (const char*)g.A + (GATHER ? (size_t)0 : (size_t)cur.pm * tstep) + (size_t)cur.kq * K * 2; const char* cB = (const char*)g.Bt + (size_t)cur.pn * tstep + (size_t)cur.kq * K * 2;
    unsigned voffGC[2][2], voffGN[2][2];
#define PG8_GOFF(dst, unit) do { _Pragma("unroll") for (int h_ = 0; h_ < 2; ++h_) _Pragma("unroll") for (int i_ = 0; i_ < 2; ++i_) { int R_, C_; stage_rc(tid * 16 + i_ * 8192, R_, C_); \
        dst[h_][i_] = (unsigned)(g.rowmap[(unit).pm * BM + h_ * HALF + R_] * LD + C_) * 2u; } } while (0)
    if constexpr (GATHER) { PG8_GOFF(voffGC, cur); _Pragma("unroll") for (int h_ = 0; h_ < 2; ++h_) { voffGN[h_][0] = voffGC[h_][0]; voffGN[h_][1] = voffGC[h_][1]; } }
#define PG8_STAGE_A(bufoff, ptr, h, isnext) do { if constexpr (GATHER) { const unsigned vs_[2] = {(isnext) ? voffGN[h][0] : voffGC[h][0], (isnext) ? voffGN[h][1] : voffGC[h][1]}; PG8_STAGE(bufoff, ptr, vs_); } \
        else { PG8_STAGE(bufoff, (ptr) + (h) * hstep, voffA); } } while (0)
    S.a_ready(cur);
    if constexpr (SP2) {
        PG8_STAGE(PG8_SB(0, 0), cB, voffB); PG8_STAGE(PG8_SB(0, 1), cB + hstep, voffB); PG8_STAGE_A(PG8_SA(0, 0), cA, 0, false); PG8_STAGE_A(PG8_SA(0, 1), cA, 1, false);
        if (wr == 1) PG8_BAR;
        PG8_WAIT_V(2); PG8_BAR;
        PG8_STAGE(PG8_SB(1, 0), cB + kstep, voffB); PG8_STAGE_A(PG8_SA(1, 0), cA + kstep, 0, false); PG8_STAGE(PG8_SB(1, 1), cB + hstep + kstep, voffB);
        PG8_WAIT_V(6); PG8_BAR;
    } else {
        PG8_STAGE(PG8_SB(0, 0), cB, voffB); PG8_STAGE_A(PG8_SA(0, 0), cA, 0, false); PG8_STAGE(PG8_SB(0, 1), cB + hstep, voffB); PG8_STAGE_A(PG8_SA(0, 1), cA, 1, false);
        if (wr == 1) PG8_BAR;
        PG8_WAIT_V(4); PG8_BAR;
        PG8_STAGE(PG8_SB(1, 0), cB + kstep, voffB); PG8_STAGE_A(PG8_SA(1, 0), cA + kstep, 0, false); PG8_STAGE(PG8_SB(1, 1), cB + hstep + kstep, voffB);
        PG8_WAIT_V(6); PG8_BAR;
    }
    for (;;) {
        const bool has_next = S.next(ui + 1, nxt);
        const char* nA = GATHER ? cA : (has_next ? (const char*)g.A + (size_t)nxt.pm * tstep + (size_t)nxt.kq * K * 2 : cA);
        if constexpr (GATHER) { if (has_next) PG8_GOFF(voffGN, nxt); } const char* nB = has_next ? (const char*)g.Bt + (size_t)nxt.pn * tstep + (size_t)nxt.kq * K * 2 : cB;
        for (int t = 0; t < nt; t += 2) {
            const bool last = (t == nt - 2);
            const char* a1 = cA + (size_t)(t + 1) * kstep;
            const char* a2 = last ? nA : cA + (size_t)(t + 2) * kstep; const char* b2 = last ? nB : cB + (size_t)(t + 2) * kstep;
            const char* a3 = a2 + kstep; const char* b3 = b2 + kstep;
            if (last && has_next) S.a_ready(nxt);
            if constexpr (SP2) {
            PG8_LDB(B0, 0, 0); PG8_LDB(B1, 0, 1); PG8_SCHED; PG8_LDA(At, 0, 0); PG8_STAGE_A(PG8_SA(1, 1), a1, 1, false);
            PG8_WAIT_V(8); PG8_WAIT_L(0); PG8_BAR; PG8_MMA(0, 0, At, B0); PG8_MMA(0, 1, At, B1); PG8_BAR; PG8_SCHED;
            PG8_LDA(At, 0, 1); PG8_STAGE(PG8_SB(0, 0), b2, voffB); PG8_STAGE(PG8_SB(0, 1), b2 + hstep, voffB); PG8_STAGE_A(PG8_SA(0, 0), a2, 0, last);
            PG8_WAIT_V(8); PG8_WAIT_L(0); PG8_BAR; PG8_MMA(1, 0, At, B0); PG8_MMA(1, 1, At, B1); PG8_BAR; PG8_SCHED;
            PG8_LDB(B0, 1, 0); PG8_LDB(B1, 1, 1); PG8_SCHED; PG8_LDA(At, 1, 0); PG8_STAGE_A(PG8_SA(0, 1), a2, 1, last);
            PG8_WAIT_V(8); PG8_WAIT_L(0); PG8_BAR; PG8_MMA(0, 0, At, B0); PG8_MMA(0, 1, At, B1); PG8_BAR; PG8_SCHED;
            PG8_LDA(At, 1, 1); PG8_STAGE(PG8_SB(1, 0), b3, voffB); PG8_STAGE(PG8_SB(1, 1), b3 + hstep, voffB); PG8_STAGE_A(PG8_SA(1, 0), a3, 0, last);
            PG8_WAIT_V(8); PG8_WAIT_L(0); PG8_BAR; PG8_MMA(1, 0, At, B0); PG8_MMA(1, 1, At, B1); PG8_BAR; PG8_SCHED;
            } else {
            PG8_LDB(B0, 0, 0); PG8_SCHED; PG8_LDA(At, 0, 0); PG8_STAGE_A(PG8_SA(1, 1), a1, 1, false);
            PG8_WAIT_L(8); PG8_BAR; PG8_WAIT_L(0); PG8_MMA(0, 0, At, B0); PG8_BAR; PG8_SCHED;
            PG8_LDB(B1, 0, 1); PG8_STAGE(PG8_SB(0, 0), b2, voffB);
            PG8_BAR; PG8_WAIT_L(0); PG8_MMA(0, 1, At, B1); PG8_BAR;
            PG8_LDA(At, 0, 1); PG8_STAGE_A(PG8_SA(0, 0), a2, 0, last);
            PG8_BAR; PG8_WAIT_L(0); PG8_MMA(1, 0, At, B0); PG8_BAR; PG8_SCHED;
            PG8_STAGE(PG8_SB(0, 1), b2 + hstep, voffB);
            PG8_WAIT_V(6); PG8_BAR; PG8_MMA(1, 1, At, B1); PG8_BAR;
            PG8_LDB(B0, 1, 0); PG8_SCHED; PG8_LDA(At, 1, 0); PG8_STAGE_A(PG8_SA(0, 1), a2, 1, last);
            PG8_WAIT_L(8); PG8_BAR; PG8_WAIT_L(0); PG8_MMA(0, 0, At, B0); PG8_BAR; PG8_SCHED;
            PG8_LDB(B1, 1, 1); PG8_STAGE(PG8_SB(1, 0), b3, voffB);
            PG8_BAR; PG8_WAIT_L(0); PG8_MMA(0, 1, At, B1); PG8_BAR;
            PG8_LDA(At, 1, 1); PG8_STAGE_A(PG8_SA(1, 0), a3, 0, last);
            PG8_BAR; PG8_WAIT_L(0); PG8_MMA(1, 0, At, B0); PG8_BAR; PG8_SCHED;
            PG8_STAGE(PG8_SB(1, 1), b3 + hstep, voffB);
            PG8_WAIT_V(6); PG8_BAR; PG8_MMA(1, 1, At, B1); PG8_BAR;
            }
        }
        if constexpr (ALIGN_EPI) { if (wr == 0) PG8_BAR; }
        if constexpr (!Epi::AFTER_DRAIN) { E(acc, cur, wr, wc, fr, fq); S.done(cur); }
        if (!has_next) break;
#pragma unroll
        for (int a = 0; a < 2; ++a)
#pragma unroll
            for (int b = 0; b < 2; ++b)
#pragma unroll
                for (int m = 0; m < 4; ++m)
#pragma unroll
                    for (int n = 0; n < 2; ++n) acc[a][b][m][n] = (f32x4){0.f, 0.f, 0.f, 0.f};
        cur = nxt; cA = nA; cB = nB; ++ui;
        if constexpr (GATHER) { _Pragma("unroll") for (int h_ = 0; h_ < 2; ++h_) { voffGC[h_][0] = voffGN[h_][0]; voffGC[h_][1] = voffGN[h_][1]; } }
        if constexpr (ALIGN_EPI) { if (wr == 1) PG8_BAR; }
    }
    PG8_WAIT_V(0);
    if constexpr (!ALIGN_EPI) { if (wr == 0) PG8_BAR; }
    PG8_BAR;
    if constexpr (Epi::AFTER_DRAIN) { E.fused(acc, cur, wr, wc, fr, fq, lds, wid, lane); S.done(cur); }
#undef PG8_SA
#undef PG8_SB
#undef PG8_STAGE
#undef PG8_STAGE_A
#undef PG8_GOFF
#undef PG8_LDA
#undef PG8_LDB
#undef PG8_MMA
#undef PG8_WAIT_V
#undef PG8_WAIT_L
#undef PG8_BAR
#undef PG8_SCHED
}
}
#define GAS __attribute__((address_space(1)))
#define LAS __attribute__((address_space(3)))
typedef unsigned short bf16;
typedef unsigned v4u __attribute__((ext_vector_type(4)));
typedef unsigned v2u __attribute__((ext_vector_type(2)));
typedef float f32x4 __attribute__((ext_vector_type(4)));
typedef float f32x2 __attribute__((ext_vector_type(2)));
typedef short bf16x8 __attribute__((ext_vector_type(8)));
typedef short bf16x4 __attribute__((ext_vector_type(4)));
#define RLX_AGENT __ATOMIC_RELAXED, __HIP_MEMORY_SCOPE_AGENT
#define LDS_WAIT() asm volatile("s_waitcnt lgkmcnt(0)" ::: "memory")
#define VM_WAIT() asm volatile("s_waitcnt vmcnt(0)" ::: "memory")

constexpr int NT = 512, NWAVES = 8;
constexpr int D = 1024, NB = 8, SEQ = 4096, CTXL = 256;
constexpr int NLAT = NB * SEQ, NCTX = NB * CTXL, MROWS = NLAT + NCTX;
constexpr int NE = 16, FF = 2048, CAPX = 512, CAPC = 32, ROWS_E = NB * CAPX + NB * CAPC  , MG = NE * ROWS_E  ;
constexpr float NORM_EPS = 1e-6f;
constexpr int N_HG = 5120, N_HY = 3072, N_MB = 6400  , N_MB_REAL = 6208, N_MBP = 4352  , N_GLA = 3328  , N_GLA_REAL = 3104;

enum { I_X = 0, I_C, I_CTX, I_CCTX, I_ADA_W, I_ADA_B, I_N1G, I_N2G, I_HG_WIN, I_HG_LB, I_HG_ONG, I_HG_WOUT,
       I_HY_WIN, I_HY_BIN, I_HY_SW, I_HY_SB, I_HY_W1, I_HY_B1, I_HY_W2, I_HY_B2, I_HY_W3, I_HY_B3, I_HY_W4, I_HY_FREQ, I_HY_FBIAS, I_HY_WOUT, I_HY_BOUT,
       I_MB_WIN, I_MB_CW, I_MB_CB, I_MB_DTB, I_MB_ALOG, I_MB_D, I_MB_NG, I_MB_WOUT,
       I_GLA_WIN, I_GLA_W2, I_GLA_GKB, I_GLA_ONG, I_GLA_WOUT, I_ROUTER, I_MOE_G, I_MOE_U, I_MOE_D, I_FNG, N_IN };

constexpr size_t MiB = 1ull << 20;
constexpr size_t WS_CTL = 0, CTL_ZERO_BYTES = 1 * MiB;
constexpr size_t WS_MOD = 1 * MiB;
constexpr size_t WS_LB = WS_MOD + 4ull * 9 * 6144 * 4;
constexpr size_t WS_X = 2 * MiB;
constexpr size_t WS_H = 138 * MiB;
constexpr size_t WS_WIN = 206 * MiB;
constexpr size_t WS_WOUT = 219 * MiB;
constexpr size_t WS_WGU = 223 * MiB;
constexpr size_t WS_WDN = 351 * MiB;
constexpr size_t WS_AFF = 415 * MiB;
constexpr size_t WS_SLOT = 418 * MiB;
constexpr size_t WS_GATE = 421 * MiB;
constexpr size_t WS_SRCROW = 422 * MiB;
constexpr size_t WS_BIG = 424 * MiB;
constexpr size_t WS_P = WS_BIG;
constexpr size_t WS_XBC = WS_BIG + 426 * MiB;
constexpr size_t WS_REC = WS_BIG + 426 * MiB;
constexpr size_t WS_REC_MB = WS_BIG + 837 * MiB;
constexpr size_t WS_O_MB = WS_BIG;
constexpr size_t WS_ZB = WS_BIG + 700 * MiB;
constexpr size_t WS_O = WS_BIG + 850 * MiB;
constexpr size_t WS_OI = WS_BIG + 1124 * MiB;
constexpr size_t WS_O_GLA = WS_BIG + 1124 * MiB;
constexpr size_t WS_A2 = WS_BIG + 1400 * MiB;
constexpr size_t WS_DT = WS_BIG + 1540 * MiB;
constexpr size_t WS_UT = WS_BIG + 426 * MiB;
constexpr size_t WS_UTC = WS_BIG + 810 * MiB;
constexpr size_t WS_HFT = WS_BIG + 1552 * MiB;
constexpr size_t WS_HFC = WS_BIG + 1616 * MiB;
constexpr size_t WS_A3G = WS_BIG + 1620 * MiB;
constexpr size_t WS_SPEC = WS_BIG + 1270 * MiB;
constexpr size_t WS_ZT = WS_BIG + 1040 * MiB;
constexpr size_t WS_ZTC = WS_BIG + 1168 * MiB;
constexpr size_t WS_HYA2 = WS_BIG + 1180 * MiB;
constexpr size_t WS_YEP = WS_BIG;
constexpr size_t WS_HID = WS_BIG + 136 * MiB;
constexpr size_t WS_YE = WS_BIG + 408 * MiB;
constexpr size_t WS_END = WS_BIG + 1624 * MiB;

constexpr int CW_CVT = 1024;
constexpr int CW_BAR = 4096;

constexpr int LDS_BYTES = 163840, LDSCTL_BYTES = 512, MISC_OFF = 320;

__device__ __forceinline__ unsigned f2bf(float f) { return (unsigned)__builtin_bit_cast(unsigned short, (__bf16)f); }
typedef __bf16 bf16x2_t __attribute__((ext_vector_type(2)));
__device__ __forceinline__ unsigned pk2(float lo, float hi) { const f32x2 v = {lo, hi}; return __builtin_bit_cast(unsigned, __builtin_convertvector(v, bf16x2_t)); }
__device__ __forceinline__ float bf2f(unsigned b) { return __builtin_bit_cast(float, b << 16); }
__device__ __forceinline__ float bflo(unsigned w) { return __builtin_bit_cast(float, w << 16); }
__device__ __forceinline__ float bfhi(unsigned w) { return __builtin_bit_cast(float, w & 0xffff0000u); }
__device__ __forceinline__ float sigmoidf_(float x) { return __builtin_amdgcn_rcpf(1.0f + __expf(-x)); }
__device__ __forceinline__ float siluf_(float x) { return x * __builtin_amdgcn_rcpf(1.0f + __expf(-x)); }
__device__ __forceinline__ float wave_sum(float v) {
#pragma unroll
    for (int o = 1; o < 64; o <<= 1) v += __shfl_xor(v, o);
    return v;
}
__device__ __forceinline__ bf16x8 pack8(f32x4 a, f32x4 b) {
    v4u w; w.x = pk2(a[0], a[1]); w.y = pk2(a[2], a[3]); w.z = pk2(b[0], b[1]); w.w = pk2(b[2], b[3]);
    return __builtin_bit_cast(bf16x8, w);
}
__device__ __forceinline__ bf16x8 cat8(bf16x4 lo, bf16x4 hi) { return __builtin_shufflevector(lo, hi, 0, 1, 2, 3, 4, 5, 6, 7); }
#define MFMA16(a, b, c) __builtin_amdgcn_mfma_f32_16x16x32_bf16((a), (b), (c), 0, 0, 0)

struct Args { const float* in[N_IN]; float* out; unsigned char* ws; int ph_lo, ph_hi; };
struct Frame { LAS unsigned char* lds; int tid, lane, wave, G, bid; };

struct EpiStoreBf16 {
    static constexpr bool PERM = true, AFTER_DRAIN = false;
    bf16* O; int ldc; const float* bias; bf16* O2; int ldc2, split_pn;
    __device__ __forceinline__ void operator()(const pg8::f32x4 (&acc)[2][2][4][2], const pg8::Unit& u, int wr, int wc, int fr, int fq) const {
        const int row0 = u.pm * 256 + wr * 64 + fr, col0 = u.pn * 256 + wc * 32 + 8 * fq;
        const bool lo = u.pn < split_pn; bf16* base = lo ? O2 : O; const int ld = lo ? ldc2 : ldc, ocol0 = lo ? col0 : col0 - 256 * split_pn;
        f32x4 bv[2][2];
#pragma unroll
        for (int bj = 0; bj < 2; ++bj)
#pragma unroll
            for (int n = 0; n < 2; ++n) bv[bj][n] = bias ? *(const f32x4*)(bias + col0 + bj * 128 + 4 * n) : (f32x4){0.f, 0.f, 0.f, 0.f};
#pragma unroll
        for (int ai = 0; ai < 2; ++ai)
#pragma unroll
            for (int m = 0; m < 4; ++m) { bf16* rowp = base + (size_t)(row0 + ai * 128 + m * 16) * ld + ocol0;
#pragma unroll
                for (int bj = 0; bj < 2; ++bj) { const f32x4 v0 = acc[ai][bj][m][0] + bv[bj][0], v1 = acc[ai][bj][m][1] + bv[bj][1];
                    v4u w; w.x = pk2(v0[0], v0[1]); w.y = pk2(v0[2], v0[3]); w.z = pk2(v1[0], v1[1]); w.w = pk2(v1[2], v1[3]);
                    *(v4u*)(rowp + bj * 128) = w; } }
    }
};
struct EpiResid {
    static constexpr bool PERM = false, AFTER_DRAIN = false;
    float* X; const float* gate  ; const float* bias; const float* xin; const float* cin;
    __device__ __forceinline__ void operator()(const pg8::f32x4 (&acc)[2][2][4][2], const pg8::Unit& u, int wr, int wc, int fr, int fq) const {
        const int row0 = u.pm * 256 + wr * 64 + fr, col0 = u.pn * 256 + wc * 32 + 4 * fq;
        const int modrow = u.pm < 128 ? (u.pm >> 4) : 8;
        const float* gp = gate + (size_t)modrow * 6144 + col0;
        f32x4 gv[2][2], bv[2][2];
#pragma unroll
        for (int bj = 0; bj < 2; ++bj)
#pragma unroll
            for (int n = 0; n < 2; ++n) { gv[bj][n] = *(const f32x4*)(gp + bj * 128 + n * 16); bv[bj][n] = bias ? *(const f32x4*)(bias + col0 + bj * 128 + n * 16) : (f32x4){0.f, 0.f, 0.f, 0.f}; }
#pragma unroll
        for (int ai = 0; ai < 2; ++ai)
#pragma unroll
            for (int m = 0; m < 4; ++m) { const int r = row0 + ai * 128 + m * 16; float* rowp = X + (size_t)r * 1024 + col0;
                const float* srcp = xin ? (u.pm < 128 ? xin + (size_t)r * 1024 + col0 : cin + (size_t)(r - NLAT) * 1024 + col0) : rowp;
#pragma unroll
                for (int bj = 0; bj < 2; ++bj)
#pragma unroll
                    for (int n = 0; n < 2; ++n) { *(f32x4*)(rowp + bj * 128 + n * 16) = *(const f32x4*)(srcp + bj * 128 + n * 16) + gv[bj][n] * (acc[ai][bj][m][n] + bv[bj][n]); } }
    }
};
struct EpiSwiGLU {
    static constexpr bool PERM = true, AFTER_DRAIN = false;
    bf16* HID;
    __device__ __forceinline__ void operator()(const pg8::f32x4 (&acc)[2][2][4][2], const pg8::Unit& u, int wr, int wc, int fr, int fq) const {
        const int row0 = u.pm * 256 + wr * 64 + fr, col0 = (u.pn & 15) * 128 + wc * 32 + 8 * fq;
#pragma unroll
        for (int ai = 0; ai < 2; ++ai)
#pragma unroll
            for (int m = 0; m < 4; ++m) { bf16* rowp = HID + (size_t)(row0 + ai * 128 + m * 16) * 2048 + col0;
                f32x4 h0, h1;
#pragma unroll
                for (int j = 0; j < 4; ++j) { h0[j] = siluf_(acc[ai][0][m][0][j]) * acc[ai][1][m][0][j]; h1[j] = siluf_(acc[ai][0][m][1][j]) * acc[ai][1][m][1][j]; }
                v4u w; w.x = pk2(h0[0], h0[1]); w.y = pk2(h0[2], h0[3]); w.z = pk2(h1[0], h1[1]); w.w = pk2(h1[2], h1[3]);
                *(v4u*)rowp = w; }
    }
};
struct EpiDown {
    static constexpr bool PERM = true, AFTER_DRAIN = false;
    bf16* YE; const float* GATE;
    __device__ __forceinline__ void operator()(const pg8::f32x4 (&acc)[2][2][4][2], const pg8::Unit& u, int wr, int wc, int fr, int fq) const {
        const int row0 = u.pm * 256 + wr * 64 + fr, col0 = (u.pn & 3) * 256 + wc * 32 + 8 * fq;
#pragma unroll
        for (int ai = 0; ai < 2; ++ai)
#pragma unroll
            for (int m = 0; m < 4; ++m) { const int r = row0 + ai * 128 + m * 16; const float gt = GATE[r]; bf16* rowp = YE + (size_t)r * 1024 + col0;
#pragma unroll
                for (int bj = 0; bj < 2; ++bj) { const f32x4 v0 = acc[ai][bj][m][0] * gt, v1 = acc[ai][bj][m][1] * gt;
                    v4u w; w.x = pk2(v0[0], v0[1]); w.y = pk2(v0[2], v0[3]); w.z = pk2(v1[0], v1[1]); w.w = pk2(v1[2], v1[3]);
                    *(v4u*)(rowp + bj * 128) = w; } }
    }
};
struct EpiDownPart {
    static constexpr bool PERM = true, AFTER_DRAIN = false;
    bf16* YEP; const float* GATE;
    __device__ __forceinline__ void operator()(const pg8::f32x4 (&acc)[2][2][4][2], const pg8::Unit& u, int wr, int wc, int fr, int fq) const {
        const int e = u.pn >> 2, lrow0 = wr * 64 + fr, col0 = (u.pn & 3) * 256 + wc * 32 + 8 * fq;
#pragma unroll
        for (int ai = 0; ai < 2; ++ai)
#pragma unroll
            for (int m = 0; m < 4; ++m) { const int lr = lrow0 + ai * 128 + m * 16; const float gt = GATE[u.pm * 256 + lr]; bf16* rowp = YEP + ((size_t)(u.kq * NE + e) * 256 + lr) * 1024 + col0;
#pragma unroll
                for (int bj = 0; bj < 2; ++bj) { const f32x4 v0 = acc[ai][bj][m][0] * gt, v1 = acc[ai][bj][m][1] * gt;
                    v4u w; w.x = pk2(v0[0], v0[1]); w.y = pk2(v0[2], v0[3]); w.z = pk2(v1[0], v1[1]); w.w = pk2(v1[2], v1[3]);
                    *(v4u*)(rowp + bj * 128) = w; } }
    }
};
struct CtxQuarterOrder {
    int G, c;
    __device__ __forceinline__ bool next(int i, pg8::Unit& u) const {
        const int L = i * G + c; if (L >= 256) return false;
        const int e = L >> 4, r = L & 15; u.pm = e * 17 + 16; u.pn = e * 4 + (r >> 2); u.kq = r & 3; return true;
    }
    __device__ __forceinline__ void a_ready(const pg8::Unit&) const {}
    __device__ __forceinline__ void done(const pg8::Unit&) const {}
};
struct GroupedOrder {
    int nN, G, c, nM;
    __device__ __forceinline__ bool next(int i, pg8::Unit& u) const {
        const int nwg = NE * nM * nN; int L = i * G + c; if (L >= nwg) return false;
        { const int q = nwg / 8, r = nwg % 8, xcd = L % 8, off = L / 8; L = (xcd < r ? xcd * (q + 1) : r * (q + 1) + (xcd - r) * q) + off; }
        const int per = nM * nN, e = L / per, r = L % per; int jn, im;
        if (nN == 16) { const int jg = r / (8 * nM), r2 = r % (8 * nM); im = r2 >> 3; jn = jg * 8 + (r2 & 7); }
        else { im = r / nN; jn = r % nN; }
        u.pm = e * 17 + im; u.pn = e * nN + jn; u.kq = 0; return true;
    }
    __device__ __forceinline__ void a_ready(const pg8::Unit&) const {}
    __device__ __forceinline__ void done(const pg8::Unit&) const {}
};
#define XB_TMO      128
#define XB_XCNT(j)  (256  + 64 * (j))
#define XB_XSUB(j)  (1280 + 64 * (j))
#define XB_XGEN(j)  (2304 + 64 * (j))
#define XB_TOP      3328
#define XB_TOPGEN   3392
#define XCD_BAR_WORDS 3456
#define XB_SPIN_CAP (1u << 18)

__device__ __forceinline__ unsigned xb_ld(unsigned* p)              { return __hip_atomic_load(p, __ATOMIC_RELAXED, __HIP_MEMORY_SCOPE_AGENT); }
__device__ __forceinline__ unsigned xb_add(unsigned* p, unsigned v) { return __hip_atomic_fetch_add(p, v, __ATOMIC_RELAXED, __HIP_MEMORY_SCOPE_AGENT); }
__device__ __forceinline__ unsigned xb_xcc_id() { return (unsigned)__builtin_amdgcn_s_getreg((3 << 11) | 20) & 0xFu; }
#define XB_SPIN(cond, bar) do { unsigned _sp = 0; while (cond) { __builtin_amdgcn_s_sleep(1); \
    if ((++_sp & 255u) == 0u) { if (xb_ld(&(bar)[XB_TMO])) break; if (_sp > XB_SPIN_CAP) { atomicAdd(&(bar)[XB_TMO], 1u); break; } } } } while (0)

struct XcdBarrier {
    unsigned* bar; unsigned x;
    volatile LAS unsigned* st;
};

__device__ __forceinline__ XcdBarrier xcd_barrier_post(unsigned* bar, volatile LAS unsigned* st) {
    XcdBarrier b; b.bar = bar; b.x = xb_xcc_id(); b.st = st;
    if (threadIdx.x == 0) (void)xb_add(&bar[XB_XCNT(b.x)], 1u);
    return b;
}
__device__ __forceinline__ void xcd_barrier_complete(unsigned* bar, unsigned x, unsigned& nloc, unsigned& nx) {
    const unsigned G = gridDim.x * gridDim.y * gridDim.z;
    unsigned sum, cnt, mine, sp = 0u;
    for (;;) {
        sum = 0u; cnt = 0u; mine = 0u;
#pragma unroll
        for (unsigned j = 0; j < 16; ++j) { const unsigned c = xb_ld(&bar[XB_XCNT(j)]); sum += c; cnt += (c > 0u) ? 1u : 0u; mine = (j == x) ? c : mine; }
        if (sum == G) break;
        __builtin_amdgcn_s_sleep(1);
        if ((++sp & 255u) == 0u) { if (xb_ld(&bar[XB_TMO])) break; if (sp > XB_SPIN_CAP) { atomicAdd(&bar[XB_TMO], 1u); break; } }
    }
    nloc = mine > 0u ? mine : 1u; nx = cnt > 0u ? cnt : 1u;
}

__device__ __forceinline__ void xcd_barrier(const XcdBarrier& b) {
    asm volatile("s_waitcnt vmcnt(0)" ::: "memory");
    __syncthreads();
    if (threadIdx.x == 0) {
        unsigned* bar = b.bar;
        __builtin_amdgcn_s_waitcnt(0);
        unsigned nloc = b.st[0], nx = b.st[1];
        if (nloc == 0u) { xcd_barrier_complete(bar, b.x, nloc, nx); b.st[0] = nloc; b.st[1] = nx; }
        const unsigned old = xb_add(&bar[XB_XSUB(b.x)], 1u);
        const unsigned gen = old / nloc;
        if (old + 1u == (gen + 1u) * nloc) {
            __builtin_amdgcn_fence(__ATOMIC_RELEASE, "agent");
            asm volatile("s_waitcnt vmcnt(0)" ::: "memory");
            const unsigned og = xb_add(&bar[XB_TOP], 1u);
            const unsigned tg = og / nx;
            if (og + 1u == (tg + 1u) * nx) xb_add(&bar[XB_TOPGEN], 1u);
            else XB_SPIN(xb_ld(&bar[XB_TOPGEN]) == tg, bar);
            __builtin_amdgcn_fence(__ATOMIC_ACQUIRE, "agent");
            xb_add(&bar[XB_XGEN(b.x)], 1u);
            asm volatile("s_waitcnt vmcnt(0)" ::: "memory");
        } else {
            XB_SPIN(xb_ld(&bar[XB_XGEN(b.x)]) == gen, bar);
            __builtin_amdgcn_fence(__ATOMIC_ACQUIRE, "agent");
            asm volatile("s_waitcnt vmcnt(0)" ::: "memory");
        }
    }
    __syncthreads();
}
#define BSYNC() __syncthreads()

__device__ __forceinline__ void ph_prologue(const Args& a, const Frame& F) {
    LAS float* sc = (LAS float*)F.lds;
    LAS float* part = sc + 9 * 1024;
    for (int j = F.tid; j < 9 * 1024; j += NT) { const int r = j >> 10, k = j & 1023; const float v = r < 8 ? a.in[I_C][r * 1024 + k] : a.in[I_CCTX][k]; sc[j] = siluf_(v); }
    BSYNC();
    float* MOD = (float*)(a.ws + WS_MOD);
    for (int unit = F.bid; unit < 4 * 48; unit += F.G) {
        const int l = unit / 48, ch = unit % 48, cn = F.tid & 127, kq = F.tid >> 7;
        const float* W = a.in[I_ADA_W] + (size_t)l * 1024 * 6144 + ch * 128 + cn;
        float acc[9];
#pragma unroll
        for (int j = 0; j < 9; ++j) acc[j] = 0.f;
        for (int k = kq * 256; k < kq * 256 + 256; ++k) { const float w = W[(size_t)k * 6144];
#pragma unroll
            for (int j = 0; j < 9; ++j) acc[j] += sc[j * 1024 + k] * w; }
#pragma unroll
        for (int j = 0; j < 9; ++j) part[(kq * 9 + j) * 128 + cn] = acc[j];
        BSYNC();
        for (int o = F.tid; o < 9 * 128; o += NT) { const int j = o >> 7, cc = o & 127, n = ch * 128 + cc;
            const float s = (part[(0 * 9 + j) * 128 + cc] + part[(1 * 9 + j) * 128 + cc]) + (part[(2 * 9 + j) * 128 + cc] + part[(3 * 9 + j) * 128 + cc]);
            MOD[(size_t)(l * 9 + j) * 6144 + n] = s + a.in[I_ADA_B][l * 6144 + n]; }
        BSYNC();
    }
    if (F.bid == F.G - 1) {
        float* LB = (float*)(a.ws + WS_LB);
        for (int d = F.tid; d < 1024; d += NT) { float v[5], mx = -1e30f;
#pragma unroll
            for (int r = 0; r < 5; ++r) { v[r] = a.in[I_HG_LB][r * 1024 + d]; mx = fmaxf(mx, v[r]); }
            float s = 0.f;
#pragma unroll
            for (int r = 0; r < 5; ++r) { v[r] = expf(v[r] - mx); s += v[r]; }
            LB[d] = v[0] / s; }
    }
}

__device__ __forceinline__ void transpose_item(const float* W, int K, int N, bf16* WT, int dst_row0, int k0, int n0, LAS float* scr, int lane) {
#pragma unroll 8
    for (int i = 0; i < 32; ++i) { const int kk = 2 * i + (lane >> 5); scr[kk * 33 + (lane & 31)] = __builtin_nontemporal_load(&W[(size_t)(k0 + kk) * N + n0 + (lane & 31)]); }
    LDS_WAIT(); asm volatile("" ::: "memory");
    const int c = lane & 7;
#pragma unroll
    for (int j = 0; j < 4; ++j) { const int n = (lane >> 3) + 8 * j; const LAS float* s = scr + (8 * c) * 33 + n;
        v4u o; o.x = pk2(s[0 * 33], s[1 * 33]); o.y = pk2(s[2 * 33], s[3 * 33]); o.z = pk2(s[4 * 33], s[5 * 33]); o.w = pk2(s[6 * 33], s[7 * 33]);
        *(v4u*)(WT + (size_t)(dst_row0 + n) * K + k0 + 8 * c) = o; }
    LDS_WAIT(); asm volatile("" ::: "memory");
}
__device__ __forceinline__ void cvt_plain(const Frame& F, const float* W, int K, int N, bf16* WT, int Npad, int b0 = 0, int nb = 0) {
    if (nb == 0) nb = F.G;
    if (F.bid < b0 || F.bid >= b0 + nb) return;
    LAS float* scr = (LAS float*)(F.lds + F.wave * 8448);
    const int gw = (F.bid - b0) * NWAVES + F.wave, NGW = nb * NWAVES, nnb = N / 32, items = (K / 64) * nnb;
    for (int it = gw; it < items; it += NGW) { const int kb = it / nnb, nb_ = it % nnb; transpose_item(W, K, N, WT, nb_ * 32, kb * 64, nb_ * 32, scr, F.lane); }
    const int padv = (Npad - N) * K / 8;
    for (int i = (F.bid - b0) * NT + F.tid; i < padv; i += nb * NT) ((v4u*)(WT + (size_t)N * K))[i] = (v4u){0u, 0u, 0u, 0u};
}
__device__ __forceinline__ void cvt_moe(const Args& a, const Frame& F, int layer, int which, int b0, int nb, int f0 = 0, int f1 = 8) {
    if (F.bid < b0 || F.bid >= b0 + nb) return;
    LAS float* scr = (LAS float*)(F.lds + F.wave * 8448);
    const int gw = (F.bid - b0) * NWAVES + F.wave, NGW = nb * NWAVES;
    if (which == 0) { bf16* WGU = (bf16*)(a.ws + WS_WGU);
        for (int it = 4096 * f0 + gw; it < 4096 * f1; it += NGW) {
            const int wh = it >> 14, e = (it >> 10) & 15, r = it & 1023, kb = r >> 6, nb_ = r & 63, n0 = nb_ * 32;
            const float* W = a.in[wh ? I_MOE_U : I_MOE_G] + (size_t)(layer * 16 + e) * 1024 * 2048;
            transpose_item(W, 1024, 2048, WGU, e * 4096 + (n0 >> 7) * 256 + wh * 128 + (n0 & 127), kb * 64, n0, scr, F.lane); } }
    else { bf16* WDN = (bf16*)(a.ws + WS_WDN);
        for (int it = 2048 * f0 + gw; it < 2048 * f1; it += NGW) {
            const int e = it >> 10, r = it & 1023, kb = r >> 5, nb_ = r & 31, n0 = nb_ * 32;
            const float* W = a.in[I_MOE_D] + (size_t)(layer * 16 + e) * 2048 * 1024;
            transpose_item(W, 2048, 1024, WDN, e * 1024 + n0, kb * 64, n0, scr, F.lane); } }
}

__device__ __forceinline__ void cvt_moe_dyn(const Args& a, const Frame& F, int layer, int ctr_idx) {
    LAS float* scr = (LAS float*)(F.lds + F.wave * 8448);
    unsigned* ctr = (unsigned*)(a.ws + WS_CTL) + CW_CVT + 64 * ctr_idx;
    bf16* WGU = (bf16*)(a.ws + WS_WGU); bf16* WDN = (bf16*)(a.ws + WS_WDN);
    constexpr unsigned NGU = 4096 * 8, NTOT = NGU + 2048 * 8;
    unsigned curv = 0; if (F.lane == 0) curv = __hip_atomic_fetch_add(ctr, 8u, __ATOMIC_RELAXED, __HIP_MEMORY_SCOPE_AGENT);
    unsigned cur = __builtin_amdgcn_readfirstlane(curv);
    while (cur < NTOT) {
        unsigned nxtv = 0; if (F.lane == 0) nxtv = __hip_atomic_fetch_add(ctr, 8u, __ATOMIC_RELAXED, __HIP_MEMORY_SCOPE_AGENT);
        if (cur < NGU) {
            for (int q = 0; q < 8; ++q) { const int it = cur + q;
                const int wh = it >> 14, e = (it >> 10) & 15, r = it & 1023, kb = r >> 6, nb_ = r & 63, n0 = nb_ * 32;
                const float* W = a.in[wh ? I_MOE_U : I_MOE_G] + (size_t)(layer * 16 + e) * 1024 * 2048;
                transpose_item(W, 1024, 2048, WGU, e * 4096 + (n0 >> 7) * 256 + wh * 128 + (n0 & 127), kb * 64, n0, scr, F.lane); }
        } else {
            for (int q = 0; q < 8; ++q) { const int it = cur - NGU + q;
                const int e = it >> 10, r = it & 1023, kb = r >> 5, nb_ = r & 31, n0 = nb_ * 32;
                const float* W = a.in[I_MOE_D] + (size_t)(layer * 16 + e) * 2048 * 1024;
                transpose_item(W, 2048, 1024, WDN, e * 1024 + n0, kb * 64, n0, scr, F.lane); }
        }
        cur = __builtin_amdgcn_readfirstlane(nxtv);
    }
}

__device__ __forceinline__ void ph_norm1(const Args& a, const Frame& F, int layer) {
    const float* X = (const float*)(a.ws + WS_X); bf16* H = (bf16*)(a.ws + WS_H);
    const float* MOD = (const float*)(a.ws + WS_MOD) + (size_t)layer * 9 * 6144;
    const float* g = a.in[I_N1G] + layer * 1024;
    const int gw = F.bid * NWAVES + F.wave, NGW = F.G * NWAVES;
    for (int row = gw; row < MROWS; row += NGW) {
        const f32x4* xr = (const f32x4*)(layer == 0 ? (row < NLAT ? a.in[I_X] + (size_t)row * 1024 : a.in[I_CTX] + (size_t)(row - NLAT) * 1024) : X + (size_t)row * 1024) + F.lane;
        f32x4 v[4]; float ss = 0.f;
#pragma unroll
        for (int j = 0; j < 4; ++j) { v[j] = xr[64 * j]; ss += (v[j].x * v[j].x + v[j].y * v[j].y) + (v[j].z * v[j].z + v[j].w * v[j].w); }
        const float rstd = rsqrtf(wave_sum(ss) * (1.f / 1024.f) + NORM_EPS);
        const int mr = row < NLAT ? (row >> 12) : 8;
        const f32x4* sh = (const f32x4*)(MOD + (size_t)mr * 6144 + 0 * 1024) + F.lane; const f32x4* sc = (const f32x4*)(MOD + (size_t)mr * 6144 + 1 * 1024) + F.lane;
        const f32x4* gg = (const f32x4*)g + F.lane;
        v2u* o8 = (v2u*)(H + (size_t)row * 1024) + F.lane;
#pragma unroll
        for (int j = 0; j < 4; ++j) { const f32x4 h = v[j] * rstd * gg[64 * j] * (sc[64 * j] + 1.0f) + sh[64 * j]; v2u w; w.x = pk2(h.x, h.y); w.y = pk2(h.z, h.w); o8[64 * j] = w; }
    }
}
__device__ __forceinline__ void ph_norm2_router(const Args& a, const Frame& F, int layer, bool skip_ctx) {
    const float* X = (const float*)(a.ws + WS_X); bf16* H = (bf16*)(a.ws + WS_H); float* AFF = (float*)(a.ws + WS_AFF);
    const float* MOD = (const float*)(a.ws + WS_MOD) + (size_t)layer * 9 * 6144;
    const float* g = a.in[I_N2G] + layer * 1024;
    LAS float* RWt = (LAS float*)F.lds;
    { const float* rw = a.in[I_ROUTER] + (size_t)layer * 1024 * 16; for (int i = F.tid; i < 16384; i += NT) RWt[(i & 15) * 1024 + (i >> 4)] = rw[i]; }
    BSYNC();
    const int gw = F.bid * NWAVES + F.wave, NGW = F.G * NWAVES, nrows = skip_ctx ? NLAT : MROWS;
    for (int row = gw; row < nrows; row += NGW) {
        const f32x4* xr = (const f32x4*)(X + (size_t)row * 1024) + F.lane;
        f32x4 v[4]; float ss = 0.f;
#pragma unroll
        for (int j = 0; j < 4; ++j) { v[j] = xr[64 * j]; ss += (v[j].x * v[j].x + v[j].y * v[j].y) + (v[j].z * v[j].z + v[j].w * v[j].w); }
        const float rstd = rsqrtf(wave_sum(ss) * (1.f / 1024.f) + NORM_EPS);
        const int mr = row < NLAT ? (row >> 12) : 8;
        const f32x4* sh = (const f32x4*)(MOD + (size_t)mr * 6144 + 3 * 1024) + F.lane; const f32x4* sc = (const f32x4*)(MOD + (size_t)mr * 6144 + 4 * 1024) + F.lane;
        const f32x4* gg = (const f32x4*)g + F.lane;
        v2u* o8 = (v2u*)(H + (size_t)row * 1024) + F.lane;
        f32x4 h[4];
#pragma unroll
        for (int j = 0; j < 4; ++j) { h[j] = v[j] * rstd * gg[64 * j] * (sc[64 * j] + 1.0f) + sh[64 * j]; v2u w; w.x = pk2(h[j].x, h[j].y); w.y = pk2(h[j].z, h[j].w); o8[64 * j] = w; }
        float p[16];
#pragma unroll
        for (int e = 0; e < 16; ++e) { float acc = 0.f;
#pragma unroll
            for (int j = 0; j < 4; ++j) { const f32x4 r = *(const LAS f32x4*)(RWt + e * 1024 + 4 * F.lane + 256 * j); acc += (h[j].x * r.x + h[j].y * r.y) + (h[j].z * r.z + h[j].w * r.w); }
            p[e] = acc; if ((e & 3) == 3) __builtin_amdgcn_sched_barrier(0); }
        float q8[8], q4[4], q2[2], mine;
        { const bool hi = F.lane & 1;
#pragma unroll
          for (int i = 0; i < 8; ++i) { const float send = hi ? p[i] : p[i + 8], keep = hi ? p[i + 8] : p[i]; q8[i] = keep + __shfl_xor(send, 1); } }
        { const bool hi = F.lane & 2;
#pragma unroll
          for (int i = 0; i < 4; ++i) { const float send = hi ? q8[i] : q8[i + 4], keep = hi ? q8[i + 4] : q8[i]; q4[i] = keep + __shfl_xor(send, 2); } }
        { const bool hi = F.lane & 4;
#pragma unroll
          for (int i = 0; i < 2; ++i) { const float send = hi ? q4[i] : q4[i + 2], keep = hi ? q4[i + 2] : q4[i]; q2[i] = keep + __shfl_xor(send, 4); } }
        { const bool hi = F.lane & 8; const float send = hi ? q2[0] : q2[1], keep = hi ? q2[1] : q2[0]; mine = keep + __shfl_xor(send, 8); }
        mine += __shfl_xor(mine, 16); mine += __shfl_xor(mine, 32);
        float mx = mine;
#pragma unroll
        for (int m = 1; m < 16; m <<= 1) mx = fmaxf(mx, __shfl_xor(mx, m));
        const float ex = expf(mine - mx); float s = ex;
#pragma unroll
        for (int m = 1; m < 16; m <<= 1) s += __shfl_xor(s, m);
        mine = ex / s;
        const int eidx = ((F.lane & 1) << 3) | ((F.lane & 2) << 1) | ((F.lane & 4) >> 1) | ((F.lane & 8) >> 3);
        if (F.lane < 16) AFF[(size_t)row * 16 + eidx] = mine;
    }
}

__device__ __forceinline__ int wave_incl_scan(int v, int lane) {
#pragma unroll
    for (int o = 1; o < 64; o <<= 1) { const int t = __shfl_up(v, o); if (lane >= o) v += t; }
    return v;
}
__device__ __forceinline__ int block_excl_scan(int v, LAS int* tmp, const Frame& F, int& total) {
    const int incl = wave_incl_scan(v, F.lane);
    if (F.lane == 63) tmp[F.wave] = incl;
    BSYNC();
    int base = 0, tot = 0;
#pragma unroll
    for (int w = 0; w < NWAVES; ++w) { const int t = tmp[w]; base += (w < F.wave) ? t : 0; tot += t; }
    BSYNC();
    total = tot; return base + incl - v;
}
__device__ __forceinline__ void ph_select_gather(const Args& a, const Frame& F, bool skip_ctx) {
    const float* AFF = (const float*)(a.ws + WS_AFF); int* SLOT = (int*)(a.ws + WS_SLOT); float* GATE = (float*)(a.ws + WS_GATE);

    LAS int* hist = (LAS int*)F.lds;
    LAS int* tmp = hist + 256;
    LAS int* res = tmp + 16;
    LAS int* selrow = res + 16;
    int* SRCROW = (int*)(a.ws + WS_SRCROW);
    const int nprob = skip_ctx ? 128 : 256;
    for (int prob = F.bid; prob < nprob; prob += F.G) {
        const bool isx = prob < 128; const int pb = isx ? prob : prob - 128, b = pb >> 4, e = pb & 15;
        const int n = isx ? SEQ : CTXL, kcap = isx ? CAPX : CAPC, row0 = isx ? b * SEQ : NLAT + b * CTXL, slot0 = e * ROWS_E + (isx ? b * CAPX : NB * CAPX + b * CAPC);
        unsigned key[8];
#pragma unroll
        for (int j = 0; j < 8; ++j) { const int t = 8 * F.tid + j; key[j] = t < n ? __builtin_bit_cast(unsigned, AFF[(size_t)(row0 + t) * 16 + e]) : 0u; }
        unsigned prefix = 0u, mask = 0u; int rem = kcap;
        for (int pass = 3; pass >= 0; --pass) {
            const int shift = pass * 8;
            if (F.tid < 256) hist[F.tid] = 0;
            BSYNC();
#pragma unroll
            for (int j = 0; j < 8; ++j) if (8 * F.tid + j < n && (key[j] & mask) == prefix) __hip_atomic_fetch_add(&hist[(key[j] >> shift) & 255u], 1, __ATOMIC_RELAXED, __HIP_MEMORY_SCOPE_WORKGROUP);
            BSYNC();
            if (F.wave == 0) {
                const int h0 = hist[4 * F.lane], h1 = hist[4 * F.lane + 1], h2 = hist[4 * F.lane + 2], h3 = hist[4 * F.lane + 3];
                int S = h0 + h1 + h2 + h3;
#pragma unroll
                for (int o = 1; o < 64; o <<= 1) { const int t = __shfl_down(S, o); if (F.lane + o < 64) S += t; }
                const unsigned long long bal = __ballot(S >= rem);
                const int Ls = 63 - __builtin_clzll(bal);
                const int above0 = __shfl_down(S, 1);
                if (F.lane == Ls) { int above = (F.lane == 63) ? 0 : above0; int bin;
                    if (above + h3 >= rem) bin = 3; else { above += h3; if (above + h2 >= rem) bin = 2; else { above += h2; if (above + h1 >= rem) bin = 1; else { above += h1; bin = 0; } } }
                    res[0] = 4 * F.lane + bin; res[1] = rem - above; }
            }
            BSYNC();
            prefix |= (unsigned)res[0] << shift; mask |= 255u << shift; rem = res[1];
            BSYNC();
        }
        int ceq = 0;
#pragma unroll
        for (int j = 0; j < 8; ++j) ceq += (8 * F.tid + j < n && key[j] == prefix) ? 1 : 0;
        int toteq; int eqbase = block_excl_scan(ceq, tmp, F, toteq);
        int csel = 0; unsigned selm = 0u;
#pragma unroll
        for (int j = 0; j < 8; ++j) { const bool valid = 8 * F.tid + j < n; bool s = valid && key[j] > prefix;
            if (valid && key[j] == prefix) { s = eqbase < rem; ++eqbase; }
            if (s) { selm |= 1u << j; ++csel; } }
        int totsel; int sb = block_excl_scan(csel, tmp, F, totsel);
#pragma unroll
        for (int j = 0; j < 8; ++j) { const int t = 8 * F.tid + j;
            if (t < n) { const int row = row0 + t; int sl = -1;
                if (selm & (1u << j)) { sl = slot0 + sb; SRCROW[sl] = row; GATE[sl] = __builtin_bit_cast(float, key[j]); ++sb; }
                SLOT[(size_t)row * 16 + e] = sl; } }
        BSYNC();
    }
}

__device__ __forceinline__ void ph_combine(const Args& a, const Frame& F, int layer, bool last) {
    float* X = (float*)(a.ws + WS_X); const int* SLOT = (const int*)(a.ws + WS_SLOT); const bf16* YE = (const bf16*)(a.ws + WS_YE); const bf16* YEP = (const bf16*)(a.ws + WS_YEP);
    const float* MOD = (const float*)(a.ws + WS_MOD) + (size_t)layer * 9 * 6144;
    const int gw = F.bid * NWAVES + F.wave, NGW = F.G * NWAVES, nrows = last ? NLAT : MROWS;
    int myslot = gw < nrows ? SLOT[(size_t)gw * 16 + (F.lane & 15)] : -1;
    for (int row = gw; row < nrows; row += NGW) {
        const int mr = row < NLAT ? (row >> 12) : 8;
        const f32x4* g2 = (const f32x4*)(MOD + (size_t)mr * 6144 + 5 * 1024) + F.lane;
        f32x4* xr = (f32x4*)(X + (size_t)row * 1024) + F.lane;
        f32x4 xv[4], gv[4];
#pragma unroll
        for (int j = 0; j < 4; ++j) { xv[j] = xr[64 * j]; gv[j] = g2[64 * j]; }
        const int curslot = myslot;
        if (row + NGW < nrows) myslot = SLOT[(size_t)(row + NGW) * 16 + (F.lane & 15)];
        f32x4 acc[4];
#pragma unroll
        for (int j = 0; j < 4; ++j) acc[j] = (f32x4){0.f, 0.f, 0.f, 0.f};
        unsigned sm = (unsigned)(__ballot(curslot >= 0) & 0xFFFFull);
        while (sm) {
            const int e0 = __builtin_ctz(sm); sm &= sm - 1; const bool two = sm != 0; const int e1 = two ? __builtin_ctz(sm) : e0; if (two) sm &= sm - 1;
            const int s0 = __shfl(curslot, e0), s1 = __shfl(curslot, e1);
            if (row < NLAT) {
                const v2u* y0 = (const v2u*)(YE + (size_t)s0 * 1024) + F.lane; const v2u* y1 = (const v2u*)(YE + (size_t)s1 * 1024) + F.lane;
                v2u w0[4], w1[4];
#pragma unroll
                for (int j = 0; j < 4; ++j) { w0[j] = y0[64 * j]; w1[j] = y1[64 * j]; }
#pragma unroll
                for (int j = 0; j < 4; ++j) { acc[j].x += bflo(w0[j].x); acc[j].y += bfhi(w0[j].x); acc[j].z += bflo(w0[j].y); acc[j].w += bfhi(w0[j].y); }
                if (two) {
#pragma unroll
                    for (int j = 0; j < 4; ++j) { acc[j].x += bflo(w1[j].x); acc[j].y += bfhi(w1[j].x); acc[j].z += bflo(w1[j].y); acc[j].w += bfhi(w1[j].y); } }
            } else {
#pragma unroll
                for (int which = 0; which < 2; ++which) { if (which == 1 && !two) break; const int sl = which ? s1 : s0;
                    const size_t pr = (size_t)(sl / ROWS_E) * 256 + (sl % ROWS_E - NB * CAPX);
#pragma unroll
                    for (int kq = 0; kq < 4; ++kq) { const v2u* yp = (const v2u*)(YEP + ((size_t)kq * NE * 256 + pr) * 1024) + F.lane;
#pragma unroll
                        for (int j = 0; j < 4; ++j) { const v2u w = yp[64 * j]; acc[j].x += bflo(w.x); acc[j].y += bfhi(w.x); acc[j].z += bflo(w.y); acc[j].w += bfhi(w.y); } } }
            }
        }
        f32x4 v[4]; float ss = 0.f;
#pragma unroll
        for (int j = 0; j < 4; ++j) { v[j] = xv[j] + gv[j] * acc[j]; ss += (v[j].x * v[j].x + v[j].y * v[j].y) + (v[j].z * v[j].z + v[j].w * v[j].w); }
        if (!last) {
#pragma unroll
            for (int j = 0; j < 4; ++j) xr[64 * j] = v[j];
            const float rstd = rsqrtf(wave_sum(ss) * (1.f / 1024.f) + NORM_EPS);
            const float* MODN = MOD + 9 * 6144;
            const f32x4* sh = (const f32x4*)(MODN + (size_t)mr * 6144 + 0 * 1024) + F.lane; const f32x4* sc = (const f32x4*)(MODN + (size_t)mr * 6144 + 1 * 1024) + F.lane;
            const f32x4* gg = (const f32x4*)(a.in[I_N1G] + (layer + 1) * 1024) + F.lane;
            v2u* o8 = (v2u*)((bf16*)(a.ws + WS_H) + (size_t)row * 1024) + F.lane;
#pragma unroll
            for (int j = 0; j < 4; ++j) { const f32x4 hh = v[j] * rstd * gg[64 * j] * (sc[64 * j] + 1.0f) + sh[64 * j]; v2u w; w.x = pk2(hh.x, hh.y); w.y = pk2(hh.z, hh.w); o8[64 * j] = w; }
        } else {
            const float rstd = rsqrtf(wave_sum(ss) * (1.f / 1024.f) + NORM_EPS);
            const f32x4* gg = (const f32x4*)a.in[I_FNG] + F.lane; f32x4* o = (f32x4*)(a.out + (size_t)row * 1024) + F.lane;
#pragma unroll
            for (int j = 0; j < 4; ++j) o[64 * j] = v[j] * rstd * gg[64 * j];
        }
    }
}
__device__ __forceinline__ int scan_row(bool perm, int b, int dir, int p) {
    if (p < CTXL) return NLAT + b * CTXL + (dir ? CTXL - 1 - p : p);
    int q = p - CTXL; if (dir) q = SEQ - 1 - q;
    const int t = perm ? ((q & 63) * 64 + (q >> 6)) : q;
    return b * SEQ + t;
}
__device__ __forceinline__ int scan_pos(bool perm, int row, int dir) {
    if (row >= NLAT) { const int t = (row - NLAT) & (CTXL - 1); return dir ? CTXL - 1 - t : t; }
    const int t = row & (SEQ - 1), q = perm ? ((t & 63) * 64 + (t >> 6)) : t;
    return CTXL + (dir ? SEQ - 1 - q : q);
}
#define CHUNK_ROWS(perm, b, dir, p0) const int row0_ = scan_row(perm, b, dir, (p0)), rstr_ = scan_row(perm, b, dir, (p0) + 1) - row0_;
constexpr int SC_QT = 0, SC_KT = 8704, SC_VT = 17408  , SC_TOT = 37888, SC_RF = 39936, SC_RAW = 41984  ;
template <int KIND> struct GlaCfg { static constexpr int LDP = KIND == 0 ? N_HG : N_GLA, NV = KIND == 0 ? 128 : 256, NVT = NV / 128, NH = KIND == 0 ? 8 : 4,
    REC_KHT = 8192, REC_VT = 16384, REC_DEC = 16384 + NV * 64, REC_X = REC_DEC + 512, REC_BYTES = REC_X + 2048, NUNITS = NB * NH * 2 * 136; };

template <int KIND  >
__device__ __forceinline__ void ph_s1_gla(const Args& a, const Frame& F) {
    typedef GlaCfg<KIND> C; constexpr int LDP = C::LDP, NVT = C::NVT;
    const bf16* P = (const bf16*)(a.ws + WS_P); bf16* OI = (bf16*)(a.ws + WS_OI); unsigned char* REC = a.ws + WS_REC;
    LAS bf16* QT = (LAS bf16*)(F.lds + SC_QT); LAS bf16* KT = (LAS bf16*)(F.lds + SC_KT); LAS bf16* VT = (LAS bf16*)(F.lds + SC_VT);
    LAS float* TOT = (LAS float*)(F.lds + SC_TOT); LAS float* RF = (LAS float*)(F.lds + SC_RF); LAS bf16* RAW = (LAS bf16*)(F.lds + SC_RAW);
    const int c = F.tid & 127, rq = F.tid >> 7, g = F.lane >> 4, i16 = F.lane & 15, w = F.wave, lr = F.tid >> 4, lcg = F.tid & 15;
    v4u wq, wk, wv[NVT]; unsigned short rrf = 0;
#define S1_DECODE(unit) const int chunk = (unit) % 136, cid = (unit) / 136, b = cid / (2 * C::NH), h = (cid >> 1) % C::NH, dir = cid & 1, p0 = chunk * 32; \
        const int qcol = h * 128, kcol = KIND == 0 ? 1024 + dir * 1024 + h * 128 : 512 + h * 128, vcol = KIND == 0 ? 3072 + h * 128 : 1024 + h * 256, ocol = h * C::NV;
#define S1_LOAD(unit) do { S1_DECODE(unit) (void)ocol; CHUNK_ROWS(KIND == 1, b, dir, p0) \
        { const bf16* pr = P + (size_t)(row0_ + lr * rstr_) * LDP + 8 * lcg; wq = *(const v4u*)(pr + qcol); wk = *(const v4u*)(pr + kcol); \
          if (dir == 0) { _Pragma("unroll") for (int vt = 0; vt < NVT; ++vt) wv[vt] = *(const v4u*)(pr + vcol + vt * 128); } } \
        if (KIND == 1) { const size_t ro = (size_t)(row0_ + (F.tid >> 4) * rstr_) * LDP; rrf = P[ro + 3072 + dir * 16 + (F.tid & 15)]; } } while (0)
    if (F.bid < C::NUNITS) S1_LOAD(F.bid);
    for (int unit = F.bid; unit < C::NUNITS; unit += F.G) {
        S1_DECODE(unit)
        (void)qcol; (void)kcol; (void)vcol; (void)ocol;
        unsigned char* rec = REC + (size_t)unit * C::REC_BYTES;
        float lbv = 0.f, w2[16], gkb = 0.f;
        if (KIND == 0) lbv = ((const float*)(a.ws + WS_LB))[h * 128 + c];
        else { gkb = a.in[I_GLA_GKB][dir * 512 + h * 128 + c];
#pragma unroll
            for (int r = 0; r < 16; ++r) w2[r] = a.in[I_GLA_W2][(dir * 16 + r) * 512 + h * 128 + c]; }
        *(LAS v4u*)(RAW + lr * 136 + 8 * lcg) = wq; *(LAS v4u*)(RAW + 4352 + lr * 136 + 8 * lcg) = wk;
        if (dir == 0) {
#pragma unroll
            for (int vt = 0; vt < NVT; ++vt) *(LAS v4u*)(RAW + (2 + vt) * 4352 + lr * 136 + 8 * lcg) = wv[vt]; }
        if (KIND == 1) RF[F.tid] = bf2f(rrf);
        BSYNC();
        unsigned short rq_[8], rk_[8], rv_[8 * NVT];
#pragma unroll
        for (int j = 0; j < 8; ++j) { const int ro = (8 * rq + j) * 136 + c; rq_[j] = RAW[ro]; rk_[j] = RAW[4352 + ro];
#pragma unroll
            for (int vt = 0; vt < NVT; ++vt) rv_[vt * 8 + j] = RAW[(2 + vt) * 4352 + ro]; }
        float qv[8], kv[8], G[8];
        {   float run = 0.f;
#pragma unroll
            for (int j = 0; j < 8; ++j) {
                float gj;
                if (KIND == 0) { const float fr = bf2f(rk_[j]); qv[j] = siluf_(bf2f(rq_[j])) * 0.08838834764831845f;
                    const float sg = sigmoidf_(fr), f = lbv + (1.0f - lbv) * sg; kv[j] = (1.0f - lbv) * (1.0f - sg); gj = __logf(f); }
                else { qv[j] = bf2f(rq_[j]) * 0.08838834764831845f; kv[j] = bf2f(rk_[j]);
                    float x = gkb; const LAS f32x4* rf = (const LAS f32x4*)(RF + (8 * rq + j) * 16);
#pragma unroll
                    for (int r4 = 0; r4 < 4; ++r4) { const f32x4 v = rf[r4]; x += v.x * w2[4 * r4] + v.y * w2[4 * r4 + 1] + v.z * w2[4 * r4 + 2] + v.w * w2[4 * r4 + 3]; }
                    gj = (fminf(x, 0.f) - __logf(1.0f + __expf(-fabsf(x)))) * (1.0f / 16.0f); }
                run += gj; G[j] = run; }
            TOT[rq * 128 + c] = run; }
        if (dir == 0) {
#pragma unroll
        for (int vt = 0; vt < NVT; ++vt) {
            v4u wv2; wv2.x = rv_[vt * 8 + 0] | ((unsigned)rv_[vt * 8 + 1] << 16); wv2.y = rv_[vt * 8 + 2] | ((unsigned)rv_[vt * 8 + 3] << 16); wv2.z = rv_[vt * 8 + 4] | ((unsigned)rv_[vt * 8 + 5] << 16); wv2.w = rv_[vt * 8 + 6] | ((unsigned)rv_[vt * 8 + 7] << 16);
            *(LAS v4u*)(VT + (vt * 128 + c) * 40 + 8 * rq) = wv2; *(v4u*)(rec + C::REC_VT + (vt * 128 + c) * 64 + rq * 16) = wv2; } }
        BSYNC();
        {   const float t0 = TOT[c], t1 = TOT[128 + c], t2 = TOT[256 + c], t3 = TOT[384 + c];
            const float pre = (rq > 0 ? t0 : 0.f) + (rq > 1 ? t1 : 0.f) + (rq > 2 ? t2 : 0.f), gend = (t0 + t1) + (t2 + t3);
            unsigned kh[8];
#pragma unroll
            for (int j = 0; j < 8; ++j) { const float Gj = pre + G[j]; const int r = 8 * rq + j;
                QT[r * 136 + c] = (bf16)f2bf(qv[j] * __expf(Gj)); KT[r * 136 + c] = (bf16)f2bf(kv[j] * __expf(fminf(-Gj, 80.f))); kh[j] = f2bf(kv[j] * __expf(gend - Gj)); }
            v4u wk2; wk2.x = kh[0] | (kh[1] << 16); wk2.y = kh[2] | (kh[3] << 16); wk2.z = kh[4] | (kh[5] << 16); wk2.w = kh[6] | (kh[7] << 16);
            *(v4u*)(rec + C::REC_KHT + c * 64 + rq * 16) = wk2;
            if (rq == 0) *(float*)(rec + C::REC_DEC + c * 4) = __expf(gend); }
        BSYNC();
        if (unit + F.G < C::NUNITS) S1_LOAD(unit + F.G);
        { const int row = F.tid >> 4, ch = F.tid & 15; *(v4u*)(rec + row * 256 + ch * 16) = *(const LAS v4u*)(QT + row * 136 + ch * 8); }
        f32x4 X00 = {0.f, 0.f, 0.f, 0.f}, X01 = X00, X11 = X00;
#pragma unroll
        for (int ks = 0; ks < 4; ++ks) {
            const bf16x8 k0 = *(const LAS bf16x8*)(KT + i16 * 136 + ks * 32 + g * 8), k1 = *(const LAS bf16x8*)(KT + (16 + i16) * 136 + ks * 32 + g * 8);
            const bf16x8 q0 = *(const LAS bf16x8*)(QT + i16 * 136 + ks * 32 + g * 8), q1 = *(const LAS bf16x8*)(QT + (16 + i16) * 136 + ks * 32 + g * 8);
            X00 = MFMA16(k0, q0, X00); X01 = MFMA16(k0, q1, X01); X11 = MFMA16(k1, q1, X11);
        }
#pragma unroll
        for (int r = 0; r < 4; ++r) if (4 * g + r > i16) { X00[r] = 0.f; X11[r] = 0.f; }
        const bf16x8 xa0 = pack8(X00, (f32x4){0.f, 0.f, 0.f, 0.f}), xa1 = pack8(X01, X11);
        if (w == 0) { v4u* xr = (v4u*)(rec + C::REC_X + F.lane * 32); xr[0] = __builtin_bit_cast(v4u, xa0); xr[1] = __builtin_bit_cast(v4u, xa1); }
        BSYNC();
    }
#undef S1_LOAD
#undef S1_DECODE
}

__device__ __forceinline__ unsigned swap16(unsigned u) { return __builtin_amdgcn_alignbit(u, u, 16); }
__device__ __forceinline__ bf16x4 rev4(v2u a) { return __builtin_bit_cast(bf16x4, (v2u){swap16(a.y), swap16(a.x)}); }
__device__ __forceinline__ bf16x8 rev8(v4u a) { return __builtin_bit_cast(bf16x8, (v4u){swap16(a.w), swap16(a.z), swap16(a.y), swap16(a.x)}); }
constexpr int S2_QT = 0, S2_KHT = 8704, S2_VT = 18944, S2_DEC = 29184, S2_XS = 29696, S2_IMG = 31744, S2_SLOT = 32768, S2_OB = 4 * 32768, S2_OBSZ = 8704;
#define S2_WAITV(n) asm volatile("s_waitcnt vmcnt(" #n ")" ::: "memory")
template <int KIND, int VAR = 0  >
__device__ __forceinline__ void ph_s2_gla(const Args& a, const Frame& F) {
    typedef GlaCfg<KIND> C;
    bf16* O = (bf16*)(a.ws + (VAR ? WS_A2 : WS_O_GLA)); const unsigned char* REC = a.ws + WS_REC;
    const int g = F.lane >> 4, i16 = F.lane & 15, w = F.wave;
    for (int chain = F.bid; chain < 128; chain += F.G) {
        int cid, vh = 0; if (KIND == 0) cid = chain; else { cid = chain >> 1; vh = chain & 1; }
        const int dir = cid & 1;
        const unsigned char* rec0 = REC + (size_t)cid * 136 * C::REC_BYTES;
        unsigned soff[8]; unsigned vmask = 0u;
        const unsigned char* recv0 = REC + (size_t)(cid & ~1) * 136 * C::REC_BYTES;
#pragma unroll
        for (int j = 0; j < 8; ++j) { const int q = 16 * ((8 * (w & 3) + j) * 64 + F.lane); int src;
            if (q < S2_KHT) { const int row = q / 272, cb = q % 272; src = row * 256 + (cb < 256 ? cb : 0); }
            else if (q < S2_VT) { const int q2 = q - S2_KHT, row = q2 / 80, cb = q2 % 80; src = C::REC_KHT + row * 64 + (cb < 64 ? cb : 0); }
            else if (q < S2_DEC) { const int q2 = q - S2_VT, row = q2 / 80, cb = q2 % 80; src = C::REC_VT + vh * 8192 + row * 64 + (cb < 64 ? cb : 0); vmask |= 1u << j; }
            else if (q < S2_XS) src = C::REC_DEC + (q - S2_DEC);
            else if (q < S2_IMG) src = C::REC_X + (q - S2_XS);
            else src = 0;
            soff[j] = (unsigned)src; }
        f32x4 S[8];
#pragma unroll
        for (int m = 0; m < 8; ++m) S[m] = (f32x4){0.f, 0.f, 0.f, 0.f};
#define S2_DMA(step) do { if (w < 4 && !(VAR & 1)) { const int st_ = (step) < 136 ? (step) : 135; const unsigned char* rc = rec0 + (size_t)st_ * C::REC_BYTES; LAS unsigned char* dst = F.lds + ((step) & 3) * S2_SLOT + w * 8192; \
        const unsigned char* rcv = dir ? recv0 + (size_t)(st_ < 8 ? 7 - st_ : 143 - st_) * C::REC_BYTES : rc;     \
        _Pragma("unroll") for (int j = 0; j < 8; ++j) __builtin_amdgcn_global_load_lds((const unsigned*)(((vmask >> j) & 1u ? rcv : rc) + soff[j]), (LAS unsigned*)(dst + j * 1024), 16, 0, 0); } } while (0)
#define S2_OSTORE(step) do { if (w >= 4 && !(VAR & 2)) { const LAS unsigned char* obuf = F.lds + S2_OB + ((step) & 1) * S2_OBSZ; \
        _Pragma("unroll") for (int k = 0; k < 2; ++k) { const int idx = (F.tid - 256) + 256 * k, row = idx >> 4, ch = idx & 15; \
            *(v4u*)(O + ((size_t)(cid * 136 + (step)) * 32 + row) * C::NV + vh * 128 + ch * 8) = *(const LAS v4u*)(obuf + row * 272 + ch * 16); } } } while (0)
#define S2_STEP(step) do { \
        S2_DMA((step) + 3); \
        if ((step) > 0) S2_OSTORE((step) - 1); \
        const LAS unsigned char* im = F.lds + ((step) & 3) * S2_SLOT; const LAS bf16* QT = (const LAS bf16*)(im + S2_QT); const LAS bf16* KHT = (const LAS bf16*)(im + S2_KHT); \
        const LAS bf16* VT = (const LAS bf16*)(im + S2_VT); const LAS float* DEC = (const LAS float*)(im + S2_DEC); \
        f32x4 O0 = {0.f, 0.f, 0.f, 0.f}, O1 = O0; \
        _Pragma("unroll") for (int ks = 0; ks < 4; ++ks) { const bf16x8 sb = pack8(S[2 * ks], S[2 * ks + 1]); \
            const bf16x8 a0 = cat8(*(const LAS bf16x4*)(QT + i16 * 136 + 32 * ks + 4 * g), *(const LAS bf16x4*)(QT + i16 * 136 + 32 * ks + 16 + 4 * g)); \
            const bf16x8 a1 = cat8(*(const LAS bf16x4*)(QT + (16 + i16) * 136 + 32 * ks + 4 * g), *(const LAS bf16x4*)(QT + (16 + i16) * 136 + 32 * ks + 16 + 4 * g)); \
            O0 = MFMA16(sb, a0, O0); O1 = MFMA16(sb, a1, O1); } \
        { const bf16x8 vbp = dir ? cat8(rev4(*(const LAS v2u*)(VT + (16 * w + i16) * 40 + 28 - 4 * g)), rev4(*(const LAS v2u*)(VT + (16 * w + i16) * 40 + 12 - 4 * g))) \
                                 : cat8(*(const LAS bf16x4*)(VT + (16 * w + i16) * 40 + 4 * g), *(const LAS bf16x4*)(VT + (16 * w + i16) * 40 + 16 + 4 * g)); \
          const LAS v4u* xs = (const LAS v4u*)(im + S2_XS + F.lane * 32); \
          O0 = MFMA16(vbp, __builtin_bit_cast(bf16x8, xs[0]), O0); O1 = MFMA16(vbp, __builtin_bit_cast(bf16x8, xs[1]), O1); }     \
        { LAS unsigned char* obuf = F.lds + S2_OB + ((step) & 1) * S2_OBSZ + (16 * w + 4 * g) * 2; \
          *(LAS v2u*)(obuf + i16 * 272) = (v2u){pk2(O0[0], O0[1]), pk2(O0[2], O0[3])}; *(LAS v2u*)(obuf + (16 + i16) * 272) = (v2u){pk2(O1[0], O1[1]), pk2(O1[2], O1[3])}; } \
        { const bf16x8 vb2 = dir ? rev8(*(const LAS v4u*)(VT + (16 * w + i16) * 40 + 24 - 8 * g)) : *(const LAS bf16x8*)(VT + (16 * w + i16) * 40 + 8 * g); \
          _Pragma("unroll") for (int m = 0; m < 8; ++m) { const f32x4 dec = *(const LAS f32x4*)(DEC + 16 * m + 4 * g); const bf16x8 ka = *(const LAS bf16x8*)(KHT + (16 * m + i16) * 40 + 8 * g); \
              S[m] = MFMA16(ka, vb2, S[m] * dec); } } \
        asm volatile("s_waitcnt lgkmcnt(0)" ::: "memory"); if (w < 4) S2_WAITV(16); if (!(VAR & 4)) __builtin_amdgcn_s_barrier(); asm volatile("" ::: "memory"); } while (0)
        S2_DMA(0); S2_DMA(1); S2_DMA(2); if (w < 4) S2_WAITV(16); __builtin_amdgcn_s_barrier(); asm volatile("" ::: "memory");
        for (int step = 0; step < 136; ++step) S2_STEP(step);
        S2_OSTORE(135);
        if (w < 4) S2_WAITV(0); BSYNC();
#undef S2_STEP
#undef S2_OSTORE
#undef S2_DMA
    }
}
constexpr int MS_CT = 0, MS_BT = 8704, MS_XT = 17408, MS_LL = 37888, MS_DTL = 38400;
constexpr int MREC_XT = 8192, MREC_EL = 24576, MREC_WS = 25088, MREC_DEND = 25600, MREC_W = 25664, MREC_BYTES = 25664 + 8192, M_NUNITS = NB * 8 * 2 * 136;
__device__ __forceinline__ void ph_s1_mamba(const Args& a, const Frame& F) {
    const bf16* XBC = (const bf16*)(a.ws + WS_XBC); const float* DT = (const float*)(a.ws + WS_DT); unsigned char* REC = a.ws + WS_REC_MB;
    LAS bf16* CT = (LAS bf16*)(F.lds + MS_CT); LAS bf16* BT = (LAS bf16*)(F.lds + MS_BT); LAS bf16* XT = (LAS bf16*)(F.lds + MS_XT);
    LAS float* LL = (LAS float*)(F.lds + MS_LL); LAS float* DTL = (LAS float*)(F.lds + MS_DTL);
    const int c = F.tid & 127, rq = F.tid >> 7, xc = F.tid & 255, rh = F.tid >> 8, g = F.lane >> 4, i16 = F.lane & 15, w = F.wave, hg = w >> 1, ph = w & 1, th = (F.tid >> 5) & 3;
    unsigned short rc_[8], rb_[8], rx_[16]; float rdt = 0.f;
#define M1_DECODE(unit) const int chunk = (unit) % 136, cid = (unit) / 136, b = cid >> 4, grp = (cid >> 1) & 7, dir = cid & 1, p0 = chunk * 32;
#define M1_LOAD(unit) do { M1_DECODE(unit) CHUNK_ROWS(false, b, dir, p0) \
        _Pragma("unroll") for (int j = 0; j < 8; ++j) { const size_t ro = (size_t)(row0_ + (8 * rq + j) * rstr_) * 4096; rb_[j] = XBC[ro + 2048 + grp * 128 + c]; rc_[j] = XBC[ro + 3072 + grp * 128 + c]; } \
        _Pragma("unroll") for (int j = 0; j < 16; ++j) { const size_t ro = (size_t)(row0_ + (16 * rh + j) * rstr_) * 4096; rx_[j] = XBC[ro + grp * 256 + xc]; } \
        if (F.tid < 128) rdt = DT[(size_t)(row0_ + (F.tid & 31) * rstr_) * 64 + dir * 32 + grp * 4 + th]; } while (0)
    if (F.bid < M_NUNITS) M1_LOAD(F.bid);
    for (int unit = F.bid; unit < M_NUNITS; unit += F.G) {
        M1_DECODE(unit)
        unsigned char* rec = REC + (size_t)unit * MREC_BYTES;
        if (F.tid < 128) {
            const float aval = -__expf(a.in[I_MB_ALOG][dir * 32 + grp * 4 + th]);
            float l = rdt * aval;
#pragma unroll
            for (int o = 1; o < 32; o <<= 1) { const float t = __shfl_up(l, o, 32); if ((F.tid & 31) >= o) l += t; }
            LL[F.tid] = l; DTL[F.tid] = rdt;
            *(float*)(rec + MREC_EL + F.tid * 4) = __expf(l);
            { const float lend_ = __shfl(l, 31, 32); *(float*)(rec + MREC_WS + F.tid * 4) = __expf(lend_ - l) * rdt; }
            if ((F.tid & 31) == 31) *(float*)(rec + MREC_DEND + th * 4) = __expf(l);
        }
        {   v4u wb;
            wb.x = rb_[0] | ((unsigned)rb_[1] << 16); wb.y = rb_[2] | ((unsigned)rb_[3] << 16); wb.z = rb_[4] | ((unsigned)rb_[5] << 16); wb.w = rb_[6] | ((unsigned)rb_[7] << 16);
            *(v4u*)(rec + c * 64 + rq * 16) = wb;
#pragma unroll
            for (int j = 0; j < 8; ++j) { BT[(8 * rq + j) * 136 + c] = rb_[j]; CT[(8 * rq + j) * 136 + c] = rc_[j]; } }
        BSYNC();
        {   unsigned xw[16];
#pragma unroll
            for (int j = 0; j < 16; ++j) xw[j] = rx_[j];
#pragma unroll
            for (int q = 0; q < 2; ++q) { v4u u0;
                u0.x = xw[8 * q] | (xw[8 * q + 1] << 16); u0.y = xw[8 * q + 2] | (xw[8 * q + 3] << 16); u0.z = xw[8 * q + 4] | (xw[8 * q + 5] << 16); u0.w = xw[8 * q + 6] | (xw[8 * q + 7] << 16);
                *(v4u*)(rec + MREC_XT + xc * 64 + rh * 32 + q * 16) = u0; } }
        BSYNC();
        if (unit + F.G < M_NUNITS) M1_LOAD(unit + F.G);
        f32x4 X00 = {0.f, 0.f, 0.f, 0.f}, X01 = X00, X11 = X00;
#pragma unroll
        for (int ks = 0; ks < 4; ++ks) {
            const bf16x8 b0 = *(const LAS bf16x8*)(BT + i16 * 136 + ks * 32 + g * 8), b1 = *(const LAS bf16x8*)(BT + (16 + i16) * 136 + ks * 32 + g * 8);
            const bf16x8 c0 = *(const LAS bf16x8*)(CT + i16 * 136 + ks * 32 + g * 8), c1 = *(const LAS bf16x8*)(CT + (16 + i16) * 136 + ks * 32 + g * 8);
            X00 = MFMA16(b0, c0, X00); X01 = MFMA16(b0, c1, X01); X11 = MFMA16(b1, c1, X11);
        }
        {   const LAS float* ll = LL + hg * 32; const LAS float* dl = DTL + hg * 32;
            const float lt0 = ll[i16], lt1 = ll[16 + i16];
            const f32x4 ls0 = *(const LAS f32x4*)(ll + 4 * g), ls1 = *(const LAS f32x4*)(ll + 16 + 4 * g), ds0 = *(const LAS f32x4*)(dl + 4 * g), ds1 = *(const LAS f32x4*)(dl + 16 + 4 * g);
#pragma unroll
            for (int r = 0; r < 4; ++r) {
                X00[r] = (4 * g + r <= i16) ? X00[r] * __expf(lt0 - ls0[r]) * ds0[r] : 0.f;
                X01[r] = X01[r] * __expf(lt1 - ls0[r]) * ds0[r];
                X11[r] = (4 * g + r <= i16) ? X11[r] * __expf(lt1 - ls1[r]) * ds1[r] : 0.f; } }
        {   const bf16x8 w0 = pack8(X00, (f32x4){0.f, 0.f, 0.f, 0.f}), w1 = pack8(X01, X11);
            if (ph == 0) { v4u* wr = (v4u*)(rec + MREC_W + hg * 2048 + F.lane * 32); wr[0] = __builtin_bit_cast(v4u, w0); wr[1] = __builtin_bit_cast(v4u, w1); } }
        BSYNC();
    }
#undef M1_LOAD
#undef M1_DECODE
}
constexpr int M2_CT = 0, M2_BTT = 8704, M2_XT = 18944, M2_EL = 39424, M2_WS = 39936, M2_DEND = 40448, M2_W = 40512, M2_IMG = 48704, M2_SLOT = 49152;
__device__ __forceinline__ void ph_s2_mamba(const Args& a, const Frame& F) {
    const bf16* XBC = (const bf16*)(a.ws + WS_XBC); bf16* O = (bf16*)(a.ws + WS_O_MB); const unsigned char* REC = a.ws + WS_REC_MB;
    const int g = F.lane >> 4, i16 = F.lane & 15, w = F.wave, hg = w >> 1, ph = w & 1;
    for (int chain = F.bid; chain < 128; chain += F.G) {
        const int b = chain >> 4, grp = (chain >> 1) & 7, dir = chain & 1;
        const unsigned char* rec0 = REC + (size_t)chain * 136 * MREC_BYTES;
        const unsigned char* xbc0 = (const unsigned char*)(XBC + 3072 + grp * 128);
        unsigned soff[12]; int crow[12];
#pragma unroll
        for (int j = 0; j < 12; ++j) { const int q = 16 * ((12 * (w & 3) + j) * 64 + F.lane); int src, cr = -1;
            if (q < M2_BTT) { cr = q / 272; const int cb = q % 272; src = cb < 256 ? cb : 0; }
            else if (q < M2_XT) { const int q2 = q - M2_BTT, row = q2 / 80, cb = q2 % 80; src = row * 64 + (cb < 64 ? cb : 0); }
            else if (q < M2_EL) { const int q2 = q - M2_XT, row = q2 / 80, cb = q2 % 80; src = MREC_XT + row * 64 + (cb < 64 ? cb : 0); }
            else if (q < M2_DEND) src = MREC_EL + (q - M2_EL);
            else if (q < M2_W) src = MREC_DEND + (q - M2_DEND);
            else if (q < M2_IMG) src = MREC_W + (q - M2_W);
            else src = 0;
            soff[j] = (unsigned)src; crow[j] = cr; }
        f32x4 S[8][2];
#pragma unroll
        for (int m = 0; m < 8; ++m) { S[m][0] = (f32x4){0.f, 0.f, 0.f, 0.f}; S[m][1] = S[m][0]; }
#define M2_DMA(step) do { if (w < 4) { const int st_ = (step) < 136 ? (step) : 135; const unsigned char* rc = rec0 + (size_t)st_ * MREC_BYTES; CHUNK_ROWS(false, b, dir, st_ * 32) \
        LAS unsigned char* dst = F.lds + ((step) % 3) * M2_SLOT + w * 12288; \
        _Pragma("unroll") for (int j = 0; j < 12; ++j) { const unsigned char* sp = crow[j] >= 0 ? xbc0 + (size_t)(row0_ + crow[j] * rstr_) * 8192 + soff[j] : rc + soff[j]; \
            __builtin_amdgcn_global_load_lds((const unsigned*)sp, (LAS unsigned*)(dst + j * 1024), 16, 0, 0); } } } while (0)
#define M2_STEP(step, NW) do { \
        M2_DMA((step) + 2); \
        const LAS unsigned char* im = F.lds + ((step) % 3) * M2_SLOT; const LAS bf16* CT = (const LAS bf16*)(im + M2_CT); const LAS bf16* BTT = (const LAS bf16*)(im + M2_BTT); \
        const LAS bf16* XT = (const LAS bf16*)(im + M2_XT); const LAS float* EL = (const LAS float*)(im + M2_EL) + hg * 32; const LAS float* WSC = (const LAS float*)(im + M2_WS) + hg * 32; \
        const float dend = ((const LAS float*)(im + M2_DEND))[hg]; \
        f32x4 Y[2][2]; \
        _Pragma("unroll") for (int ti = 0; ti < 2; ++ti) { Y[ti][0] = (f32x4){0.f, 0.f, 0.f, 0.f}; Y[ti][1] = Y[ti][0]; } \
        _Pragma("unroll") for (int ks = 0; ks < 4; ++ks) { \
            const bf16x8 a0 = cat8(*(const LAS bf16x4*)(CT + i16 * 136 + 32 * ks + 4 * g), *(const LAS bf16x4*)(CT + i16 * 136 + 32 * ks + 16 + 4 * g)); \
            const bf16x8 a1 = cat8(*(const LAS bf16x4*)(CT + (16 + i16) * 136 + 32 * ks + 4 * g), *(const LAS bf16x4*)(CT + (16 + i16) * 136 + 32 * ks + 16 + 4 * g)); \
            _Pragma("unroll") for (int nt = 0; nt < 2; ++nt) { const bf16x8 sb = pack8(S[2 * ks][nt], S[2 * ks + 1][nt]); Y[0][nt] = MFMA16(sb, a0, Y[0][nt]); Y[1][nt] = MFMA16(sb, a1, Y[1][nt]); } } \
        { const float e0 = EL[i16], e1 = EL[16 + i16]; \
          const LAS v4u* wt = (const LAS v4u*)(im + M2_W + hg * 2048 + F.lane * 32); const bf16x8 w0 = __builtin_bit_cast(bf16x8, wt[0]), w1 = __builtin_bit_cast(bf16x8, wt[1]); \
          bf16* ob = O + (size_t)(chain * 136 + (step)) * 32 * 256 + hg * 64 + ph * 32 + 4 * g; \
          _Pragma("unroll") for (int nt = 0; nt < 2; ++nt) { const LAS bf16* xr = XT + (hg * 64 + ph * 32 + nt * 16 + i16) * 40; \
              const bf16x8 vbp = cat8(*(const LAS bf16x4*)(xr + 4 * g), *(const LAS bf16x4*)(xr + 16 + 4 * g)); \
              const f32x4 y0 = MFMA16(vbp, w0, Y[0][nt] * e0), y1 = MFMA16(vbp, w1, Y[1][nt] * e1);        \
              *(v2u*)(ob + (size_t)i16 * 256 + 16 * nt) = (v2u){pk2(y0[0], y0[1]), pk2(y0[2], y0[3])}; \
              *(v2u*)(ob + (size_t)(16 + i16) * 256 + 16 * nt) = (v2u){pk2(y1[0], y1[1]), pk2(y1[2], y1[3])}; } } \
        { const f32x4 ws0 = *(const LAS f32x4*)(WSC + 8 * g), ws1 = *(const LAS f32x4*)(WSC + 8 * g + 4); \
          _Pragma("unroll") for (int nt = 0; nt < 2; ++nt) { const v4u xv = *(const LAS v4u*)(XT + (hg * 64 + ph * 32 + nt * 16 + i16) * 40 + 8 * g); \
            v4u xs; xs.x = pk2(bflo(xv.x) * ws0.x, bfhi(xv.x) * ws0.y); xs.y = pk2(bflo(xv.y) * ws0.z, bfhi(xv.y) * ws0.w); xs.z = pk2(bflo(xv.z) * ws1.x, bfhi(xv.z) * ws1.y); xs.w = pk2(bflo(xv.w) * ws1.z, bfhi(xv.w) * ws1.w); \
            const bf16x8 vb2 = __builtin_bit_cast(bf16x8, xs);                                              \
            _Pragma("unroll") for (int m = 0; m < 8; ++m) { const bf16x8 ba = *(const LAS bf16x8*)(BTT + (16 * m + i16) * 40 + 8 * g); S[m][nt] = MFMA16(ba, vb2, S[m][nt] * dend); } } } \
        asm volatile("s_waitcnt lgkmcnt(0)" ::: "memory"); if (w < 4) S2_WAITV(NW); __builtin_amdgcn_s_barrier(); asm volatile("" ::: "memory"); } while (0)
        M2_DMA(0); M2_DMA(1); if (w < 4) S2_WAITV(12); __builtin_amdgcn_s_barrier(); asm volatile("" ::: "memory");
        M2_STEP(0, 16);
        for (int step = 1; step < 136; ++step) M2_STEP(step, 20);
        if (w < 4) S2_WAITV(0); BSYNC();
#undef M2_STEP
#undef M2_DMA
    }
}
template <int HV  >
__device__ __forceinline__ void ph_post_gla(const Args& a, const Frame& F, const float* gain, int ldp, int ogcol0) {
    constexpr int NH = 1024 / HV; constexpr bool PERMUTED = HV == 256;
    const bf16* P = (const bf16*)(a.ws + WS_P); const bf16* O = (const bf16*)(a.ws + WS_O_GLA); bf16* A2 = (bf16*)(a.ws + WS_A2);
    const int gw = F.bid * NWAVES + F.wave, NGW = F.G * NWAVES;
    const int h = (16 * F.lane) / HV, cih = (16 * F.lane) % HV;
    float gn[16];
#pragma unroll
    for (int i = 0; i < 16; ++i) gn[i] = gain[cih + i];
    for (int row = gw; row < MROWS; row += NGW) {
        const int b = row < NLAT ? (row >> 12) : ((row - NLAT) >> 8);
        const int pf = scan_pos(PERMUTED, row, 0), pb = scan_pos(PERMUTED, row, 1);
        const size_t of_ = ((size_t)(((b * NH + h) * 2 + 0) * 136 + (pf >> 5)) * 32 + (pf & 31)) * HV + cih, ob_ = ((size_t)(((b * NH + h) * 2 + 1) * 136 + (pb >> 5)) * 32 + (pb & 31)) * HV + cih;
        const v4u* of = (const v4u*)(O + of_); const v4u* ob = (const v4u*)(O + ob_);
        const v4u* og = (const v4u*)(P + (size_t)row * ldp + ogcol0) + 2 * F.lane;
        float o[16], gte[16];
#pragma unroll
        for (int hh = 0; hh < 2; ++hh) { const v4u wf = of[hh], wb = ob[hh], wg = og[hh];
#pragma unroll
            for (int q = 0; q < 4; ++q) { o[8 * hh + 2 * q] = bflo(wf[q]) + bflo(wb[q]); o[8 * hh + 2 * q + 1] = bfhi(wf[q]) + bfhi(wb[q]);
                gte[8 * hh + 2 * q] = bflo(wg[q]); gte[8 * hh + 2 * q + 1] = bfhi(wg[q]); } }
        float ss = 0.f;
#pragma unroll
        for (int i = 0; i < 16; ++i) ss += o[i] * o[i];
#pragma unroll
        for (int m = 1; m < HV / 16; m <<= 1) ss += __shfl_xor(ss, m);
        const float rstd = rsqrtf(ss * (1.f / HV) + NORM_EPS);
        v4u w[2];
#pragma unroll
        for (int hh = 0; hh < 2; ++hh)
#pragma unroll
            for (int q = 0; q < 4; ++q) { const int i = 8 * hh + 2 * q; w[hh][q] = pk2(o[i] * rstd * gn[i] * siluf_(gte[i]), o[i + 1] * rstd * gn[i + 1] * siluf_(gte[i + 1])); }
        v4u* dst = (v4u*)(A2 + (size_t)row * 1024) + 2 * F.lane; dst[0] = w[0]; dst[1] = w[1];
    }
}
__device__ __forceinline__ void ph_mamba_conv(const Args& a, const Frame& F) {
    const bf16* P = (const bf16*)(a.ws + WS_P); bf16* XBC = (bf16*)(a.ws + WS_XBC); float* DT = (float*)(a.ws + WS_DT);
    const float* cw = a.in[I_MB_CW]; const float* cb = a.in[I_MB_CB]; const float* dtb = a.in[I_MB_DTB];
    const int c0 = F.tid * 8;
    float kw[5][8], bias[8];
#pragma unroll
    for (int j = 0; j < 5; ++j) { const f32x4 k0 = *(const f32x4*)(cw + j * 4096 + c0), k1 = *(const f32x4*)(cw + j * 4096 + c0 + 4);
        kw[j][0] = k0.x; kw[j][1] = k0.y; kw[j][2] = k0.z; kw[j][3] = k0.w; kw[j][4] = k1.x; kw[j][5] = k1.y; kw[j][6] = k1.z; kw[j][7] = k1.w; }
#pragma unroll
    for (int i = 0; i < 8; ++i) bias[i] = cb[c0 + i];
    const int per = (MROWS + F.G - 1) / F.G, r0 = F.bid * per, r1 = (r0 + per < MROWS) ? r0 + per : MROWS;
    if (r0 >= MROWS) return;
#define MC_LOAD(r) (*(const v4u*)(P + (size_t)((r) < 0 ? 0 : ((r) >= MROWS ? MROWS - 1 : (r))) * N_MBP + c0))
    for (int rc = r0; rc < r1; rc += 8) {
        v4u wv[12];
#pragma unroll
        for (int i = 0; i < 12; ++i) wv[i] = MC_LOAD(rc - 2 + i);
#pragma unroll
        for (int i = 0; i < 8; ++i) { const int row = rc + i; if (row >= r1) break;
            int t, L; if (row < NLAT) { t = row & (SEQ - 1); L = SEQ; } else { t = (row - NLAT) & (CTXL - 1); L = CTXL; }
            float acc[8];
#pragma unroll
            for (int e = 0; e < 8; ++e) acc[e] = bias[e];
#pragma unroll
            for (int j = 0; j < 5; ++j) if (t + j - 2 >= 0 && t + j - 2 < L) { const v4u VV = wv[i + j];
                acc[0] += bflo(VV[0]) * kw[j][0]; acc[1] += bfhi(VV[0]) * kw[j][1]; acc[2] += bflo(VV[1]) * kw[j][2]; acc[3] += bfhi(VV[1]) * kw[j][3];
                acc[4] += bflo(VV[2]) * kw[j][4]; acc[5] += bfhi(VV[2]) * kw[j][5]; acc[6] += bflo(VV[3]) * kw[j][6]; acc[7] += bfhi(VV[3]) * kw[j][7]; }
            v4u o; o.x = pk2(siluf_(acc[0]), siluf_(acc[1])); o.y = pk2(siluf_(acc[2]), siluf_(acc[3])); o.z = pk2(siluf_(acc[4]), siluf_(acc[5])); o.w = pk2(siluf_(acc[6]), siluf_(acc[7]));
            *(v4u*)(XBC + (size_t)row * 4096 + c0) = o;
            if (c0 < 64) {
#pragma unroll
                for (int e = 0; e < 8; ++e) { const float x = bf2f(P[(size_t)row * N_MBP + 4096 + c0 + e]) + dtb[c0 + e];
                    DT[(size_t)row * 64 + c0 + e] = x > 20.f ? x : log1pf(__expf(x)); }
            }
        }
    }
#undef MC_LOAD
}
__device__ __forceinline__ void ph_post_mamba(const Args& a, const Frame& F) {
    const bf16* ZB = (const bf16*)(a.ws + WS_ZB); const bf16* XBC = (const bf16*)(a.ws + WS_XBC); const bf16* O = (const bf16*)(a.ws + WS_O_MB); bf16* A2 = (bf16*)(a.ws + WS_A2);
    const float* ng = a.in[I_MB_NG]; const float dsk = a.in[I_MB_D][F.lane >> 1];
    const int gw = F.bid * NWAVES + F.wave, NGW = F.G * NWAVES;
    for (int row = gw; row < MROWS; row += NGW) {
        const int b = row < NLAT ? (row >> 12) : ((row - NLAT) >> 8), grp = F.lane >> 3, cig = (32 * F.lane) & 255;
        const int pf = scan_pos(false, row, 0), pb = scan_pos(false, row, 1);
        const size_t of_ = ((size_t)(((b * 8 + grp) * 2 + 0) * 136 + (pf >> 5)) * 32 + (pf & 31)) * 256 + cig, ob_ = ((size_t)(((b * 8 + grp) * 2 + 1) * 136 + (pb >> 5)) * 32 + (pb & 31)) * 256 + cig;
        const v4u* yf = (const v4u*)(O + of_); const v4u* yb = (const v4u*)(O + ob_);
        const v4u* xs = (const v4u*)(XBC + (size_t)row * 4096) + 4 * F.lane; const v4u* zz = (const v4u*)(ZB + (size_t)row * 2048) + 4 * F.lane;
        float y[32]; float ss = 0.f;
#pragma unroll
        for (int h = 0; h < 4; ++h) { const v4u wf = yf[h], wb = yb[h], wx = xs[h], wz = zz[h];
#pragma unroll
            for (int q = 0; q < 4; ++q) { const int i = 8 * h + 2 * q;
                y[i] = ((bflo(wf[q]) + bflo(wb[q])) + dsk * bflo(wx[q])) * siluf_(bflo(wz[q])); y[i + 1] = ((bfhi(wf[q]) + bfhi(wb[q])) + dsk * bfhi(wx[q])) * siluf_(bfhi(wz[q]));
                ss += y[i] * y[i] + y[i + 1] * y[i + 1]; } }
        ss += __shfl_xor(ss, 1); ss += __shfl_xor(ss, 2); ss += __shfl_xor(ss, 4);
        const float rstd = rsqrtf(ss * (1.f / 256.f) + NORM_EPS);
        const f32x4* gp = (const f32x4*)(ng + 32 * F.lane);
        v4u* dst = (v4u*)(A2 + (size_t)row * 2048) + 4 * F.lane;
#pragma unroll
        for (int h = 0; h < 4; ++h) { const f32x4 g0 = gp[2 * h], g1 = gp[2 * h + 1]; const int i = 8 * h;
            v4u w; w.x = pk2(y[i] * rstd * g0.x, y[i + 1] * rstd * g0.y); w.y = pk2(y[i + 2] * rstd * g0.z, y[i + 3] * rstd * g0.w);
            w.z = pk2(y[i + 4] * rstd * g1.x, y[i + 5] * rstd * g1.y); w.w = pk2(y[i + 6] * rstd * g1.z, y[i + 7] * rstd * g1.w); dst[h] = w; }
    }
}
constexpr int FFT_N = 8192;
constexpr int HY_DATA = 0, HY_Z1 = 69632;
__device__ __forceinline__ f32x2 cmul(f32x2 a, f32x2 b) { return (f32x2){a.x * b.x - a.y * b.y, a.x * b.y + a.y * b.x}; }
__device__ __forceinline__ f32x2 cmulc(f32x2 a, f32x2 b) { return (f32x2){a.x * b.x + a.y * b.y, a.y * b.x - a.x * b.y}; }
__device__ __forceinline__ f32x2 cw(float turns) { float s, c; sincospif(2.0f * turns, &s, &c); return (f32x2){c, -s}; }
__device__ __forceinline__ constexpr int FP(int i) { return i + (i >> 4); }
#define C16R(q) ((q) == 0 ? 1.0f : (q) == 1 ? 0.9238795325112867f : (q) == 2 ? 0.7071067811865476f : (q) == 3 ? 0.3826834323650898f : (q) == 4 ? 0.0f : (q) == 5 ? -0.3826834323650898f : (q) == 6 ? -0.7071067811865476f : -0.9238795325112867f)
#define C16I(q) ((q) == 0 ? 0.0f : (q) == 1 ? -0.3826834323650898f : (q) == 2 ? -0.7071067811865476f : (q) == 3 ? -0.9238795325112867f : (q) == 4 ? -1.0f : (q) == 5 ? -0.9238795325112867f : (q) == 6 ? -0.7071067811865476f : -0.3826834323650898f)
template <bool INV>
__device__ __forceinline__ void r16_pure(f32x2 (&v)[16]) {
#pragma unroll
    for (int tt = 0; tt < 4; ++tt) { const int t = INV ? 3 - tt : tt, h = 8 >> t;
#pragma unroll
        for (int k = 0; k < 16; ++k) { if (k & h) continue; const int q = (k & (h - 1)) * (8 / h);
            const f32x2 T = (f32x2){C16R(q), C16I(q)};
            if (!INV) { const f32x2 a = v[k], b = v[k + h], d = a - b; v[k] = a + b;
                v[k + h] = (q == 0) ? d : (q == 4) ? (f32x2){d.y, -d.x} : (q == 2) ? (f32x2){(d.x + d.y) * 0.7071067811865476f, (d.y - d.x) * 0.7071067811865476f}
                         : (q == 6) ? (f32x2){(d.y - d.x) * 0.7071067811865476f, -(d.x + d.y) * 0.7071067811865476f} : cmul(d, T); }
            else { const f32x2 a = v[k], u = v[k + h];
                const f32x2 b = (q == 0) ? u : (q == 4) ? (f32x2){-u.y, u.x} : (q == 2) ? (f32x2){(u.x - u.y) * 0.7071067811865476f, (u.x + u.y) * 0.7071067811865476f}
                              : (q == 6) ? (f32x2){-(u.x + u.y) * 0.7071067811865476f, (u.x - u.y) * 0.7071067811865476f} : cmulc(u, T);
                v[k] = a + b; v[k + h] = a - b; } } }
}
constexpr int HY_TW256 = 102400, HY_TW16 = 102400 + 32768;
__device__ __forceinline__ void fft_build_tw(const Frame& F) {
    LAS f32x2* t256 = (LAS f32x2*)(F.lds + HY_TW256); LAS f32x2* t16 = (LAS f32x2*)(F.lds + HY_TW16);
    for (int i = F.tid; i < 16 * 256; i += NT) { const int k = i >> 8, lo = i & 255, f = ((k & 1) << 3) | ((k & 2) << 1) | ((k & 4) >> 1) | ((k & 8) >> 3); t256[i] = cw((float)(lo * f) * (1.0f / 4096.0f)); }
    if (F.tid < 256) { const int k = F.tid >> 4, lo = F.tid & 15, f = ((k & 1) << 3) | ((k & 2) << 1) | ((k & 4) >> 1) | ((k & 8) >> 3); t16[F.tid] = cw((float)(lo * f) * (1.0f / 256.0f)); }
    BSYNC();
}
template <int S, bool INV>
__device__ __forceinline__ void fft_pass(LAS f32x2* x, int tid) {
    const int half = tid >> 8, r = tid & 255; int g0;
    const LAS f32x2* tw = S == 256 ? (const LAS f32x2*)((LAS unsigned char*)x + HY_TW256) + r : (const LAS f32x2*)((LAS unsigned char*)x + HY_TW16) + (r & 15);
    constexpr int TS = S == 256 ? 256 : 16;
    if (S == 256) { g0 = r; } else if (S == 16) { g0 = (r >> 4) * 256 + (r & 15); } else { g0 = r * 16; }
    LAS f32x2* p = x + FP(half * 4096 + g0); constexpr int PS = S == 256 ? 272 : (S == 16 ? 17 : 1);
    f32x2 v[16];
#pragma unroll
    for (int k = 0; k < 16; ++k) v[k] = p[PS * k];
    if (INV && S != 1) {
#pragma unroll
        for (int k = 1; k < 16; ++k) v[k] = cmulc(v[k], tw[k * TS]); }
    r16_pure<INV>(v);
    if (!INV && S != 1) {
#pragma unroll
        for (int k = 1; k < 16; ++k) v[k] = cmul(v[k], tw[k * TS]); }
#pragma unroll
    for (int k = 0; k < 16; ++k) p[PS * k] = v[k];
}
__device__ __forceinline__ void fft_pass1_mul(LAS f32x2* x, const unsigned* sp, int tid) {
    const int half = tid >> 8, r = tid & 255, g0 = half * 4096 + r * 16;
    LAS f32x2* p = x + FP(g0); const v4u* s4 = (const v4u*)(sp + g0);
    f32x2 v[16];
#pragma unroll
    for (int k = 0; k < 16; ++k) v[k] = p[k];
    r16_pure<false>(v);
#pragma unroll
    for (int k = 0; k < 4; ++k) { const v4u s = s4[k];
#pragma unroll
        for (int e = 0; e < 4; ++e) v[4 * k + e] = cmul(v[4 * k + e], (f32x2){bflo(s[e]), bfhi(s[e])}); }
    r16_pure<true>(v);
#pragma unroll
    for (int k = 0; k < 16; ++k) p[k] = v[k];
}
__device__ __forceinline__ float block_sum(float v, LAS float* red, const Frame& F) {
    v = wave_sum(v); if (F.lane == 0) red[F.wave] = v; BSYNC();
    float s = 0.f;
#pragma unroll
    for (int w = 0; w < NWAVES; ++w) s += red[w];
    BSYNC(); return s;
}
__device__ __forceinline__ void ph_hy_mlp(const Args& a, const Frame& F) {
    float* A3G = (float*)(a.ws + WS_A3G);
    const float* w1 = a.in[I_HY_W1]; const float* b1 = a.in[I_HY_B1]; const float* w2 = a.in[I_HY_W2]; const float* b2 = a.in[I_HY_B2];
    const float* w3 = a.in[I_HY_W3]; const float* b3 = a.in[I_HY_B3]; const float* fq = a.in[I_HY_FREQ];
    const int j = F.lane; const float freq = fq[j];
    LAS float* W1 = (LAS float*)(F.lds + 65536); LAS float* W2 = W1 + 33 * 64; LAS float* W3 = W2 + 64 * 64;
    for (int i = F.tid; i < 33 * 64; i += NT) W1[i] = w1[i];
    for (int i = F.tid; i < 64 * 64; i += NT) { W2[i] = w2[i]; W3[i] = w3[i]; }
    BSYNC();
    for (int pos = F.bid * NWAVES + F.wave; pos < SEQ + CTXL; pos += F.G * NWAVES) {
        const bool isx = pos < SEQ; const int L = isx ? SEQ : CTXL, l = isx ? pos : pos - SEQ;
        const float t = (float)l / (float)(L - 1), wl = 6.283185307179586f * (float)l / (float)L;
        float z = 0.f;
        if (j == 0) z = t; else if (j <= 16) z = cosf((1e-4f + (float)(j - 1) * ((15.0f - 1e-4f) / 15.0f)) * wl); else if (j <= 32) z = -sinf((1e-4f + (float)(j - 17) * ((15.0f - 1e-4f) / 15.0f)) * wl);
        float h = b1[j];
#pragma unroll
        for (int i = 0; i < 33; ++i) h += __shfl(z, i) * W1[i * 64 + j];
        const float a1 = sinf(freq * h);
        h = b2[j];
#pragma unroll 16
        for (int i = 0; i < 64; ++i) h += __shfl(a1, i) * W2[i * 64 + j];
        const float a2 = sinf(freq * h);
        h = b3[j];
#pragma unroll 16
        for (int i = 0; i < 64; ++i) h += __shfl(a2, i) * W3[i * 64 + j];
        A3G[(size_t)pos * 64 + j] = sinf(freq * h);
    }
}
__device__ __forceinline__ void ph_hy_filters(const Args& a, const Frame& F, int u0, int ustride, int uend) {
    float* HFT = (float*)(a.ws + WS_HFT); float* HFC = (float*)(a.ws + WS_HFC); const float* A3G = (const float*)(a.ws + WS_A3G);
    LAS float* A3 = (LAS float*)F.lds;
    typedef const __attribute__((address_space(4))) f32x4 cf32x4;
    const cf32x4* w4 = (const cf32x4*)(unsigned long long)a.in[I_HY_W4];
    for (int unit = u0; unit < uend; unit += ustride) {
        const int pb = unit >> 3, c8 = unit & 7; const bool isx = pb < 64; const int L = isx ? SEQ : CTXL, l0 = isx ? pb * 64 : (pb - 64) * 64, pos0 = pb * 64;
#pragma unroll
        for (int k = 0; k < 8; ++k) { const int idx = F.tid + NT * k; A3[(idx >> 6) * 68 + (idx & 63)] = A3G[(size_t)pos0 * 64 + idx]; }
        BSYNC();
        {
            const int l = l0 + F.lane; const float t = (float)l / (float)(L - 1);
            const int o = c8 >> 2, side = (c8 >> 1) & 1;
            for (int k = 0; k < 64; k += 4) {
                const int ch = c8 * 512 + F.wave * 64 + k, d = ch & 1023;
                f32x4 acc = {0.f, 0.f, 0.f, 0.f};
#pragma unroll 4
                for (int i = 0; i < 64; i += 4) { const f32x4 av = *(const LAS f32x4*)(A3 + F.lane * 68 + i);
                    acc += w4[(i * 4096 + ch) >> 2] * av.x; acc += w4[((i + 1) * 4096 + ch) >> 2] * av.y; acc += w4[((i + 2) * 4096 + ch) >> 2] * av.z; acc += w4[((i + 3) * 4096 + ch) >> 2] * av.w; }
#pragma unroll
                for (int e = 0; e < 4; ++e) { const float delta = fabsf(-3.0701134573253945f + (float)(d + e) * ((-15.350567286626973f + 3.0701134573253945f) / 1023.0f));
                    const float v = acc[e] * __expf(-t * delta);
                    if (isx) HFT[(((size_t)((o * 2 + side) * 64 + (l >> 6)) * 1024) + d + e) * 64 + (l & 63)] = v; else HFC[(((size_t)((o * 2 + side) * 4 + (l >> 6)) * 1024) + d + e) * 64 + (l & 63)] = v; }
            }
        }
        BSYNC();
    }
}
__device__ __forceinline__ void ph_hy_spectra(const Args& a, const Frame& F, int u0, int ustride) {
    const float* HFT = (const float*)(a.ws + WS_HFT); unsigned* SPEC = (unsigned*)(a.ws + WS_SPEC);
    LAS f32x2* x = (LAS f32x2*)(F.lds + HY_DATA); LAS float* red = (LAS float*)(F.lds + HY_Z1);
    const f32x2 wt = cw((float)F.tid * (1.0f / FFT_N)), dummy_ = (f32x2){0.f, 0.f}; (void)dummy_; fft_build_tw(F);
    for (int unit = u0; unit < 2048; unit += ustride) {
        const int o = unit >> 10, d = unit & 1023;
#define HFT_AT(side_, l_) HFT[(((size_t)((o * 2 + (side_)) * 64 + ((l_) >> 6)) * 1024) + d) * 64 + ((l_) & 63)]
        float sa = 0.f;
#pragma unroll
        for (int r = 0; r < 8; ++r) { const int i = F.tid + NT * r; const float vf = HFT_AT(0, i), vb0 = HFT_AT(1, i), vb = i ? HFT_AT(1, 4096 - i) : 0.f; sa += fabsf(vf) + fabsf(vb0);
            x[FP(i)] = (f32x2){vf + vb, 0.f}; x[FP(4096 + i)] = cmul(wt, (f32x2){C16R(r), C16I(r)}) * (vf - vb); }
        const float inv = 1.0f / block_sum(sa, red, F);
        fft_pass<256, false>(x, F.tid); BSYNC();
        fft_pass<16, false>(x, F.tid); BSYNC();
        fft_pass<1, false>(x, F.tid); BSYNC();
        unsigned* sp = SPEC + (size_t)unit * FFT_N;
#pragma unroll
        for (int r = 0; r < 16; ++r) { const int i = F.tid + NT * r; const f32x2 v = x[FP(i)] * inv; sp[i] = pk2(v.x, v.y); }
        BSYNC();
    }
#undef HFT_AT
}
__device__ __forceinline__ void ph_hy_conv(const Args& a, const Frame& F) {
    const bf16* P = (const bf16*)(a.ws + WS_P); bf16* UT = (bf16*)(a.ws + WS_UT); bf16* UTC = (bf16*)(a.ws + WS_UTC);
    const float* sw = a.in[I_HY_SW]; const float* sb = a.in[I_HY_SB];
    LAS float* tile = (LAS float*)F.lds;
    constexpr int NU = 3 * 16 * 272;
    v4u raw[3];
#define HYC_DECODE(unit) const int tix = (unit) % 272, dt = ((unit) / 272) & 15, wh = (unit) / (272 * 16), d0 = dt * 64; int b, t0, L, rowb; \
        if (tix < 256) { b = tix >> 5; t0 = (tix & 31) * 128; L = SEQ; rowb = b * SEQ; } else { b = (tix - 256) >> 1; t0 = ((tix - 256) & 1) * 128; L = CTXL; rowb = NLAT + b * CTXL; }
#define HYC_LOAD(unit) do { HYC_DECODE(unit) \
        _Pragma("unroll") for (int k = 0; k < 3; ++k) { const int idx = F.tid + NT * k, r = idx >> 3, ch = idx & 7, t = t0 - 1 + r; \
            raw[k] = (idx < 1040 && t >= 0 && t < L) ? *(const v4u*)(P + (size_t)(rowb + t) * N_HY + wh * 1024 + d0 + 8 * ch) : (v4u){0u, 0u, 0u, 0u}; } } while (0)
    if (F.bid < NU) HYC_LOAD(F.bid);
    for (int unit = F.bid; unit < NU; unit += F.G) {
        HYC_DECODE(unit)
        (void)L; (void)rowb;
#pragma unroll
        for (int k = 0; k < 3; ++k) { const int idx = F.tid + NT * k, r = idx >> 3, ch = idx & 7;
            if (idx < 1040) { LAS float* tp = tile + r * 65 + 8 * ch;
                tp[0] = bflo(raw[k].x); tp[1] = bfhi(raw[k].x); tp[2] = bflo(raw[k].y); tp[3] = bfhi(raw[k].y); tp[4] = bflo(raw[k].z); tp[5] = bfhi(raw[k].z); tp[6] = bflo(raw[k].w); tp[7] = bfhi(raw[k].w); } }
        BSYNC();
        if (unit + F.G < NU) HYC_LOAD(unit + F.G);
        {   const int dd = F.tid >> 3, tq = F.tid & 7, col = wh * 1024 + d0 + dd;
            const float k0 = sw[col], k1 = sw[3072 + col], k2 = sw[6144 + col], bb = sb[col];
            float x0 = tile[(16 * tq) * 65 + dd], x1 = tile[(16 * tq + 1) * 65 + dd]; unsigned w[8];
#pragma unroll
            for (int j = 0; j < 16; j += 2) { const float x2 = tile[(16 * tq + j + 2) * 65 + dd], x3 = tile[(16 * tq + j + 3) * 65 + dd];
                w[j >> 1] = pk2(x0 * k0 + x1 * k1 + x2 * k2 + bb, x1 * k0 + x2 * k1 + x3 * k2 + bb); x0 = x2; x1 = x3; }
            bf16* dst = (tix < 256) ? UT + ((size_t)(wh * 8 + b) * 1024 + d0 + dd) * SEQ + t0 + 16 * tq : UTC + ((size_t)(wh * 8 + b) * 1024 + d0 + dd) * CTXL + t0 + 16 * tq;
            ((v4u*)dst)[0] = (v4u){w[0], w[1], w[2], w[3]}; ((v4u*)dst)[1] = (v4u){w[4], w[5], w[6], w[7]}; }
        BSYNC();
    }
#undef HYC_LOAD
#undef HYC_DECODE
}
__device__ __forceinline__ void ph_hy_fftconv(const Args& a, const Frame& F) {
    const bf16* UT = (const bf16*)(a.ws + WS_UT); const bf16* UTC = (const bf16*)(a.ws + WS_UTC); const unsigned* SPEC = (const unsigned*)(a.ws + WS_SPEC);
    const float* HFC = (const float*)(a.ws + WS_HFC); bf16* ZT = (bf16*)(a.ws + WS_ZT); bf16* ZTC = (bf16*)(a.ws + WS_ZTC); const float* fb = a.in[I_HY_FBIAS];
    LAS f32x2* x = (LAS f32x2*)(F.lds + HY_DATA); LAS f32x2* z1 = (LAS f32x2*)(F.lds + HY_Z1);
    const f32x2 wt4 = cw((float)F.tid * (4.0f / FFT_N)), dummy_ = (f32x2){0.f, 0.f}; (void)dummy_; fft_build_tw(F);
#define HY_TW(r2, e) cmul((r2) ? (f32x2){wt4.y, -wt4.x} : wt4, (f32x2){(e) == 0 ? 1.0f : (e) == 1 ? 0.9999997058628822f : (e) == 2 ? 0.9999988234517019f : 0.9999973527669782f, \
                                                                     (e) == 0 ? 0.0f : (e) == 1 ? -0.0007669903187427045f : (e) == 2 ? -0.0015339801862847655f : -0.0023009691514258070f})
#define HY_LD4(p, t0, out) do { const v2u w_ = *(const v2u*)((p) + (t0)); out[0] = bflo(w_.x); out[1] = bfhi(w_.x); out[2] = bflo(w_.y); out[3] = bfhi(w_.y); } while (0)
    for (int d = F.bid; d < 1024; d += F.G) {
        const float bias0 = fb[d], bias1 = fb[1024 + d]; const float invn = 1.0f / FFT_N;
        const unsigned* sp0 = SPEC + (size_t)(0 * 1024 + d) * FFT_N; const unsigned* sp1 = SPEC + (size_t)(1 * 1024 + d) * FFT_N;
#pragma unroll 1
        for (int pr = 0; pr < 4; ++pr) {
            const int b1 = 2 * pr, b2 = 2 * pr + 1;
            const bf16* v1 = UT + ((size_t)(2 * 8 + b1) * 1024 + d) * SEQ; const bf16* v2 = UT + ((size_t)(2 * 8 + b2) * 1024 + d) * SEQ;
            const bf16* g1a = UT + ((size_t)(0 * 8 + b1) * 1024 + d) * SEQ; const bf16* g1b = UT + ((size_t)(0 * 8 + b2) * 1024 + d) * SEQ;
            const bf16* g2a = UT + ((size_t)(1 * 8 + b1) * 1024 + d) * SEQ; const bf16* g2b = UT + ((size_t)(1 * 8 + b2) * 1024 + d) * SEQ;
#pragma unroll
            for (int r2 = 0; r2 < 2; ++r2) { const int t0 = 4 * (F.tid + NT * r2); float a1[4], a2[4]; HY_LD4(v1, t0, a1); HY_LD4(v2, t0, a2);
#pragma unroll
                for (int e = 0; e < 4; ++e) { const f32x2 z0 = (f32x2){a1[e], a2[e]}; x[FP(t0 + e)] = z0; x[FP(t0 + e + SEQ)] = cmul(z0, HY_TW(r2, e)); } }
            BSYNC();
            fft_pass<256, false>(x, F.tid); BSYNC();
            fft_pass<16, false>(x, F.tid); BSYNC();
            fft_pass1_mul(x, sp0, F.tid); BSYNC();
            fft_pass<16, true>(x, F.tid); BSYNC();
            fft_pass<256, true>(x, F.tid); BSYNC();
#pragma unroll
            for (int r2 = 0; r2 < 2; ++r2) { const int t0 = 4 * (F.tid + NT * r2); float a1[4], a2[4], ga[4], gb[4]; HY_LD4(v1, t0, a1); HY_LD4(v2, t0, a2); HY_LD4(g1a, t0, ga); HY_LD4(g1b, t0, gb);
#pragma unroll
                for (int e = 0; e < 4; ++e) { const f32x2 wr = HY_TW(r2, e); const int t = t0 + e;
                    const f32x2 y = (x[FP(t)] + cmulc(x[FP(t + SEQ)], wr)) * invn;
                    const f32x2 zz = (f32x2){ga[e], gb[e]} * (y + (f32x2){a1[e], a2[e]} * bias0); z1[t] = zz; x[FP(t)] = zz; x[FP(t + SEQ)] = cmul(zz, wr); } }
            BSYNC();
            fft_pass<256, false>(x, F.tid); BSYNC();
            fft_pass<16, false>(x, F.tid); BSYNC();
            fft_pass1_mul(x, sp1, F.tid); BSYNC();
            fft_pass<16, true>(x, F.tid); BSYNC();
            fft_pass<256, true>(x, F.tid); BSYNC();
            bf16* o1 = ZT + ((size_t)b1 * 1024 + d) * SEQ; bf16* o2 = ZT + ((size_t)b2 * 1024 + d) * SEQ;
#pragma unroll
            for (int r2 = 0; r2 < 2; ++r2) { const int t0 = 4 * (F.tid + NT * r2); float ga[4], gb[4], za[4], zb[4]; HY_LD4(g2a, t0, ga); HY_LD4(g2b, t0, gb);
#pragma unroll
                for (int e = 0; e < 4; ++e) { const f32x2 wr = HY_TW(r2, e); const int t = t0 + e;
                    const f32x2 y = (x[FP(t)] + cmulc(x[FP(t + SEQ)], wr)) * invn;
                    const f32x2 zz = (f32x2){ga[e], gb[e]} * (y + z1[t] * bias1); za[e] = zz.x; zb[e] = zz.y; }
                *(v2u*)(o1 + t0) = (v2u){pk2(za[0], za[1]), pk2(za[2], za[3])}; *(v2u*)(o2 + t0) = (v2u){pk2(zb[0], zb[1]), pk2(zb[2], zb[3])}; }
        }
        BSYNC();
        {   LAS float* hh = (LAS float*)(F.lds + HY_DATA);
            LAS float* zc = hh + 1028;
            LAS float* zc1 = zc + 2048;
            LAS float* red = zc1 + 2048;
            { const int side = F.tid >> 8, l = F.tid & 255;
              const float h0 = HFC[(((size_t)((0 * 2 + side) * 4 + (l >> 6)) * 1024) + d) * 64 + (l & 63)], h1 = HFC[(((size_t)((1 * 2 + side) * 4 + (l >> 6)) * 1024) + d) * 64 + (l & 63)];
              const float n0 = block_sum(fabsf(h0), red, F), n1 = block_sum(fabsf(h1), red, F);
              if (side == 0) { hh[1 + 255 + l] = h0 / n0; hh[514 + 1 + 255 + l] = h1 / n1; } else if (l > 0) { hh[1 + 255 - l] = h0 / n0; hh[514 + 1 + 255 - l] = h1 / n1; }
              if (F.tid == 0) { hh[0] = 0.f; hh[514] = 0.f; } }
            for (int i = F.tid; i < 2048; i += NT) zc[i] = bf2f(UTC[((size_t)(2 * 8 + (i >> 8)) * 1024 + d) * 256 + (i & 255)]);
            BSYNC();
            const int b = F.tid >> 6, t0 = 4 * (F.tid & 63);
#pragma unroll
            for (int o = 0; o < 2; ++o) {
                const LAS float* hp = hh + o * 514 + 1 + 255 + t0; const LAS float* zin = (o == 0 ? zc : zc1) + b * 256;
                float h0 = hp[0], h1 = hp[1], h2 = hp[2], h3 = hp[3], y0 = 0.f, y1 = 0.f, y2 = 0.f, y3 = 0.f;
#pragma unroll 4
                for (int s = 0; s < 256; ++s) { const float zv = zin[s]; y0 += h0 * zv; y1 += h1 * zv; y2 += h2 * zv; y3 += h3 * zv; h3 = h2; h2 = h1; h1 = h0; h0 = hp[-1 - s]; }
                const float bias = o == 0 ? bias0 : bias1; const float yy[4] = {y0, y1, y2, y3};
                const bf16* gp = UTC + ((size_t)(o * 8 + b) * 1024 + d) * 256 + t0;
                float zz[4];
#pragma unroll
                for (int e = 0; e < 4; ++e) zz[e] = bf2f(gp[e]) * (yy[e] + zin[t0 + e] * bias);
                if (o == 0) {
#pragma unroll
                    for (int e = 0; e < 4; ++e) zc1[b * 256 + t0 + e] = zz[e]; }
                else { v2u w; w.x = pk2(zz[0], zz[1]); w.y = pk2(zz[2], zz[3]); *(v2u*)(ZTC + ((size_t)b * 1024 + d) * 256 + t0) = w; }
                BSYNC();
            }
        }
    }
}
__device__ __forceinline__ void ph_hy_transpose(const Args& a, const Frame& F) {
    const bf16* ZT = (const bf16*)(a.ws + WS_ZT); const bf16* ZTC = (const bf16*)(a.ws + WS_ZTC); bf16* A2 = (bf16*)(a.ws + WS_HYA2);
    LAS bf16* tile = (LAS bf16*)F.lds;
    for (int unit = F.bid; unit < 16 * 272; unit += F.G) {
        const int tix = unit % 272, dt = unit / 272, d0 = dt * 64;
        int b, t0, rowb; const bf16* src; int lsrc;
        if (tix < 256) { b = tix >> 5; t0 = (tix & 31) * 128; rowb = b * SEQ; src = ZT + ((size_t)b * 1024 + d0) * SEQ + t0; lsrc = SEQ; }
        else { b = (tix - 256) >> 1; t0 = ((tix - 256) & 1) * 128; rowb = NLAT + b * CTXL; src = ZTC + ((size_t)b * 1024 + d0) * CTXL + t0; lsrc = CTXL; }
#pragma unroll
        for (int k = 0; k < 2; ++k) { const int idx = F.tid + NT * k, dd = idx >> 4, ch = idx & 15; const v4u w = *(const v4u*)(src + (size_t)dd * lsrc + 8 * ch);
            LAS unsigned* tp = (LAS unsigned*)(tile + dd * 130 + 8 * ch); tp[0] = w.x; tp[1] = w.y; tp[2] = w.z; tp[3] = w.w; }
        BSYNC();
#pragma unroll
        for (int k = 0; k < 2; ++k) { const int idx = F.tid + NT * k, tt = idx >> 3, dq = idx & 7; const LAS bf16* s = tile + (8 * dq) * 130 + tt;
            v4u o; o.x = s[0] | ((unsigned)s[130] << 16); o.y = s[260] | ((unsigned)s[390] << 16); o.z = s[520] | ((unsigned)s[650] << 16); o.w = s[780] | ((unsigned)s[910] << 16);
            *(v4u*)(A2 + (size_t)(rowb + t0 + tt) * 1024 + d0 + 8 * dq) = o; }
        BSYNC();
    }
}
__device__ __forceinline__ void moe_gemm1(const Args& a, const Frame& F, int nM) {
    pg8::Gemm g{(const pg8::bf16_t*)(a.ws + WS_H), (const pg8::bf16_t*)(a.ws + WS_WGU), MG, NE * 4096, 1024, (const int*)(a.ws + WS_SRCROW)};
    GroupedOrder S{16, F.G, F.bid, nM}; EpiSwiGLU E{(bf16*)(a.ws + WS_HID)};
    pg8::gemm_phase<EpiSwiGLU, GroupedOrder, true, true, true>(F.lds, g, S, E);
}
__device__ __forceinline__ void moe_gemm2(const Args& a, const Frame& F, bool with_ctx) {
    {   pg8::Gemm g{(const pg8::bf16_t*)(a.ws + WS_HID), (const pg8::bf16_t*)(a.ws + WS_WDN), MG, NE * 1024, 2048};
        GroupedOrder S{4, F.G, F.bid, 16}; EpiDown E{(bf16*)(a.ws + WS_YE), (const float*)(a.ws + WS_GATE)};
        pg8::gemm_phase<EpiDown, GroupedOrder, true, true>(F.lds, g, S, E); }
    if (with_ctx) { pg8::Gemm g{(const pg8::bf16_t*)(a.ws + WS_HID), (const pg8::bf16_t*)(a.ws + WS_WDN), MG, NE * 1024, 512, nullptr, 2048};
        CtxQuarterOrder S{F.G, F.bid}; EpiDownPart E{(bf16*)(a.ws + WS_YEP), (const float*)(a.ws + WS_GATE)};
        pg8::gemm_phase<EpiDownPart, CtxQuarterOrder, true, true>(F.lds, g, S, E); }
}
__device__ __forceinline__ void gemm_in(const Args& a, const Frame& F, int N, const float* bias, bool mamba_split = false) {
    pg8::Gemm g{(const pg8::bf16_t*)(a.ws + WS_H), (const pg8::bf16_t*)(a.ws + WS_WIN), MROWS, N, 1024};
    pg8::StaticOrder S; S.init(MROWS, N, F.G, F.bid);
    EpiStoreBf16 E{(bf16*)(a.ws + WS_P), mamba_split ? N_MBP : N, bias, (bf16*)(a.ws + WS_ZB), 2048, mamba_split ? 8 : 0};
    pg8::gemm_phase<EpiStoreBf16, pg8::StaticOrder, true, true>(F.lds, g, S, E);
}
__device__ __forceinline__ void gemm_out(const Args& a, const Frame& F, int layer, size_t a2off, int K, const float* bias, int M = MROWS) {
    pg8::Gemm g{(const pg8::bf16_t*)(a.ws + a2off), (const pg8::bf16_t*)(a.ws + WS_WOUT), M, 1024, K};
    pg8::StaticOrder S; S.init(M, 1024, F.G, F.bid);
    EpiResid E{(float*)(a.ws + WS_X), (const float*)(a.ws + WS_MOD) + (size_t)layer * 9 * 6144 + 2 * 1024, bias, layer == 0 ? a.in[I_X] : nullptr, layer == 0 ? a.in[I_CTX] : nullptr};
    pg8::gemm_phase<EpiResid, pg8::StaticOrder, true, true>(F.lds, g, S, E);
}

constexpr int NPHASES = 43;
__global__ void __launch_bounds__(NT, 2) fwd_kernel(Args a0) {
    extern __shared__ __attribute__((aligned(16))) unsigned char lds_raw[];
    Frame F; F.lds = (LAS unsigned char*)lds_raw + LDSCTL_BYTES; F.tid = threadIdx.x; F.lane = F.tid & 63; F.wave = __builtin_amdgcn_readfirstlane(F.tid >> 6); F.G = gridDim.x; F.bid = blockIdx.x;
    volatile LAS unsigned* MISC = (volatile LAS unsigned*)((LAS unsigned char*)lds_raw + MISC_OFF);
    for (int u = F.tid; u < LDSCTL_BYTES / 4; u += NT) ((LAS unsigned*)lds_raw)[u] = 0u;
    __syncthreads();
    const int lo = a0.ph_lo, hi = a0.ph_hi; int rep = 0; (void)rep;
    XcdBarrier bar; bar.bar = (unsigned*)(a0.ws + WS_CTL) + CW_BAR; bar.x = 0; bar.st = nullptr;
    if (hi - lo > 1) bar = xcd_barrier_post((unsigned*)(a0.ws + WS_CTL) + CW_BAR, MISC + 8);
#ifndef PH_LO
#define PH_LO 0
#define PH_HI 1000
#endif
#ifndef PH_LO
#define PH_LO 0
#define PH_HI 1000
#endif
#ifdef DUP_LO
#ifndef S2VAR
#define S2VAR 0
#endif
#define PH(k, body) if ((k) >= PH_LO && (k) <= PH_HI && lo <= (k) && (k) < hi) { Args a = a0; { GAS unsigned char* wsg_ = (GAS unsigned char*)a0.ws; asm volatile("" : "+s"(wsg_)); a.ws = (unsigned char*)wsg_; } rep = 0; body; if ((k) >= DUP_LO && (k) <= DUP_HI) { xcd_barrier(bar); rep = 1; body; } if ((k) + 1 < hi) xcd_barrier(bar); }
#define PH4_S2() do { if (rep == 0) ph_s2_gla<0>(a, F); else (ph_s2_gla<0, S2VAR>)(a, F); } while (0)
#else
#define PH(k, body) if ((k) >= PH_LO && (k) <= PH_HI && lo <= (k) && (k) < hi) { Args a = a0; { GAS unsigned char* wsg_ = (GAS unsigned char*)a0.ws; asm volatile("" : "+s"(wsg_)); a.ws = (unsigned char*)wsg_; } body; if ((k) + 1 < hi) xcd_barrier(bar); }
#define PH4_S2() ph_s2_gla<0>(a, F)
#endif

    PH(0, { ph_prologue(a, F); ph_hy_mlp(a, F); BSYNC();
            cvt_plain(F, a.in[I_HG_WIN], 1024, N_HG, (bf16*)(a.ws + WS_WIN), N_HG); cvt_plain(F, a.in[I_HG_WOUT], 1024, 1024, (bf16*)(a.ws + WS_WOUT), 1024); });
    PH(1, ph_norm1(a, F, 0));
    PH(2, gemm_in(a, F, N_HG, nullptr));
    PH(3, { ph_s1_gla<0>(a, F); ph_hy_filters(a, F, F.bid, F.G, 544); });
    PH(4, { if (F.bid < 128 || F.G <= 128) PH4_S2(); if (rep == 0) { if (F.G < 256) ph_hy_spectra(a, F, F.bid, F.G); else if (F.bid >= 128) ph_hy_spectra(a, F, F.bid - 128, F.G - 128); } BSYNC(); cvt_moe_dyn(a, F, 0, 0); });
    PH(5, ph_post_gla<128>(a, F, a.in[I_HG_ONG], N_HG, 4096));
    PH(6, gemm_out(a, F, 0, WS_A2, 1024, nullptr));
    PH(7, ph_norm2_router(a, F, 0, false));
    PH(8, ph_select_gather(a, F, false));
    PH(9, moe_gemm1(a, F, 17));
    PH(10, moe_gemm2(a, F, true));
    PH(11, { ph_combine(a, F, 0, false); cvt_plain(F, a.in[I_HY_WIN], 1024, N_HY, (bf16*)(a.ws + WS_WIN), N_HY); cvt_plain(F, a.in[I_HY_WOUT], 1024, 1024, (bf16*)(a.ws + WS_WOUT), 1024); cvt_moe(a, F, 1, 0, 0, F.G); cvt_moe(a, F, 1, 1, 0, F.G); });
    PH(12, gemm_in(a, F, N_HY, a.in[I_HY_BIN]));
    PH(13, ph_hy_conv(a, F));
    PH(14, ph_hy_fftconv(a, F));
    PH(15, ph_hy_transpose(a, F));
    PH(16, gemm_out(a, F, 1, WS_HYA2, 1024, a.in[I_HY_BOUT]));
    PH(17, ph_norm2_router(a, F, 1, false));
    PH(18, ph_select_gather(a, F, false));
    PH(19, moe_gemm1(a, F, 17));
    PH(20, moe_gemm2(a, F, true));
    PH(21, { ph_combine(a, F, 1, false); cvt_plain(F, a.in[I_MB_WIN], 1024, N_MB_REAL, (bf16*)(a.ws + WS_WIN), N_MB); cvt_plain(F, a.in[I_MB_WOUT], 2048, 1024, (bf16*)(a.ws + WS_WOUT), 1024); });
    PH(22, gemm_in(a, F, N_MB, nullptr, true));
    PH(23, ph_mamba_conv(a, F));
    PH(24, ph_s1_mamba(a, F));
    PH(25, { ph_s2_mamba(a, F); if (F.G >= 256) { cvt_moe(a, F, 2, 0, 128, F.G - 128, 0, 7); cvt_moe(a, F, 2, 1, 128, F.G - 128, 0, 7); cvt_moe(a, F, 2, 0, 0, 128, 7, 8); cvt_moe(a, F, 2, 1, 0, 128, 7, 8); } else { cvt_moe(a, F, 2, 0, 0, F.G); cvt_moe(a, F, 2, 1, 0, F.G); } });
    PH(26, ph_post_mamba(a, F));
    PH(27, gemm_out(a, F, 2, WS_A2, 2048, nullptr));
    PH(28, ph_norm2_router(a, F, 2, false));
    PH(29, ph_select_gather(a, F, false));
    PH(30, moe_gemm1(a, F, 17));
    PH(31, moe_gemm2(a, F, true));
    PH(32, { ph_combine(a, F, 2, false); cvt_plain(F, a.in[I_GLA_WIN], 1024, N_GLA_REAL, (bf16*)(a.ws + WS_WIN), N_GLA); cvt_plain(F, a.in[I_GLA_WOUT], 1024, 1024, (bf16*)(a.ws + WS_WOUT), 1024); });
    PH(33, gemm_in(a, F, N_GLA, nullptr));
    PH(34, ph_s1_gla<1>(a, F));
    PH(35, { ph_s2_gla<1>(a, F); if (F.G >= 256) { cvt_moe(a, F, 3, 0, 128, F.G - 128, 0, 7); cvt_moe(a, F, 3, 1, 128, F.G - 128, 0, 7); cvt_moe(a, F, 3, 0, 0, 128, 7, 8); cvt_moe(a, F, 3, 1, 0, 128, 7, 8); } else { cvt_moe(a, F, 3, 0, 0, F.G); cvt_moe(a, F, 3, 1, 0, F.G); } });
    PH(36, ph_post_gla<256>(a, F, a.in[I_GLA_ONG], N_GLA, 2048));
    PH(37, gemm_out(a, F, 3, WS_A2, 1024, nullptr, NLAT));
    PH(38, ph_norm2_router(a, F, 3, true));
    PH(39, ph_select_gather(a, F, true));
    PH(40, moe_gemm1(a, F, 16));
    PH(41, moe_gemm2(a, F, false));
    PH(42, ph_combine(a, F, 3, true));
#undef PH
}

#ifndef N_LAUNCH_MODE
#define N_LAUNCH_MODE 0
#endif
extern "C" void kernel_launch(void* const* d_in, const int* in_sizes, int n_in, void* d_out, int out_size, void* d_ws, size_t ws_size, hipStream_t stream) {
    static int grid = 0;
    if (grid == 0) {
        if (n_in != N_IN || out_size != NLAT * D || ws_size < WS_END) { fprintf(stderr, "kernel_launch: unexpected shapes (n_in %d, out %d, ws %zu)\n", n_in, out_size, ws_size); grid = -1; return; }
        int dev = 0, cus = 0, per_cu = 0;
        if (hipGetDevice(&dev) != hipSuccess || hipDeviceGetAttribute(&cus, hipDeviceAttributeMultiprocessorCount, dev) != hipSuccess) { grid = -1; return; }
        if (hipFuncSetAttribute((const void*)fwd_kernel, hipFuncAttributeMaxDynamicSharedMemorySize, LDS_BYTES) != hipSuccess) { fprintf(stderr, "kernel_launch: hipFuncSetAttribute failed\n"); grid = -1; return; }
        if (hipOccupancyMaxActiveBlocksPerMultiprocessor(&per_cu, (const void*)fwd_kernel, NT, LDS_BYTES) != hipSuccess || per_cu < 1) { fprintf(stderr, "kernel_launch: occupancy query reports %d\n", per_cu); }
        (void)hipGetLastError();
        grid = cus;
    }
    if (grid < 0) return;
    (void)in_sizes;
    if (hipMemsetAsync((char*)d_ws + WS_CTL, 0, CTL_ZERO_BYTES, stream) != hipSuccess) return;
    Args a{};
    for (int i = 0; i < N_IN; ++i) a.in[i] = (const float*)d_in[i];
    a.out = (float*)d_out; a.ws = (unsigned char*)d_ws;
#if N_LAUNCH_MODE == 0
    a.ph_lo = 0; a.ph_hi = NPHASES;
    hipLaunchKernelGGL(fwd_kernel, dim3(grid), dim3(NT), LDS_BYTES, stream, a);
#else
    for (int p = 0; p < NPHASES; ++p) { a.ph_lo = p; a.ph_hi = p + 1; hipLaunchKernelGGL(fwd_kernel, dim3(grid), dim3(NT), LDS_BYTES, stream, a); }
#endif
}
```

```cpp
#include <hip/hip_runtime.h>
#include <cstdio>
#include <cstdint>
#define N_LAUNCH_MODE 0
namespace pg8 {
#define PG8_LAS __attribute__((address_space(3)))
typedef unsigned short bf16_t;
typedef short bf16x8 __attribute__((ext_vector_type(8)));
typedef float f32x4 __attribute__((ext_vector_type(4)));
typedef unsigned u32x4 __attribute__((ext_vector_type(4)));
constexpr int BM = 256, BK = 64, HALF = 128, HTB = HALF * BK * 2  , STAGE_BYTES = 8 * HTB, NXCD = 8, WGM = 4;

__host__ __device__ __forceinline__ int lds_byte(int r, int c) { const int st = (r >> 4) * 2 + (c >> 5), rr = r & 15, cc = c & 31, ob = rr * 64 + cc * 2; return st * 1024 + (ob ^ (((ob >> 9) & 1) << 5)); }
__host__ __device__ __forceinline__ void stage_rc(int b, int& R, int& C) { const int st = b / 1024, sb = b % 1024, swz = sb ^ (((sb >> 9) & 1) << 5); R = (st >> 1) * 16 + swz / 64; C = (st & 1) * 32 + (swz % 64) / 2; }
__host__ __device__ __forceinline__ int perm32(int rho) { const int n = rho >> 4, i = rho & 15; return 8 * (i >> 2) + 4 * n + (i & 3); }

struct Unit { int pm, pn; int kq = 0; };
struct Gemm { const bf16_t* A; const bf16_t* Bt; int M, N, K; const int* rowmap; int lda; };

struct StaticOrder {
    int nM, nN, nwg, G, c;
    __host__ __device__ void init(int M, int N, int G_, int c_) { nM = M / BM; nN = N / BM; nwg = nM * nN; G = G_; c = c_; }
    __host__ __device__ bool next(int i, Unit& u) const {
        const long L = (long)i * G + c; if (L >= nwg) return false;
        int wgid = (int)L; { const int q = nwg / NXCD, r = nwg % NXCD, xcd = wgid % NXCD, off = wgid / NXCD; wgid = (xcd < r ? xcd * (q + 1) : r * (q + 1) + (xcd - r) * q) + off; }
        const int nig = WGM * nN, gid = wgid / nig, fm = gid * WGM, gsz = (nM - fm) < WGM ? (nM - fm) : WGM;
        u.pm = fm + ((wgid % nig) % gsz); u.pn = (wgid % nig) / gsz; return true;
    }
    __device__ __forceinline__ void a_ready(const Unit&) const {}
    __device__ __forceinline__ void done(const Unit&) const {}
};

__device__ __forceinline__ unsigned cvt_pk_bf16(float lo, float hi) { unsigned r; asm volatile("v_cvt_pk_bf16_f32 %0, %1, %2" : "=v"(r) : "v"(lo), "v"(hi)); return r; }

template <class Epi, class Sched, bool ALIGN_EPI = false, bool SP2 = false, bool GATHER = false>
__device__ __forceinline__ void gemm_phase(PG8_LAS unsigned char* lds, const Gemm g, const Sched& S, const Epi& E) {
    const int tid = threadIdx.x, wid = __builtin_amdgcn_readfirstlane(tid >> 6), lane = tid & 63, wr = wid >> 2, wc = wid & 3, fr = lane & 15, fq = lane >> 4;
    const int K = g.K, nt = K / BK, LD = g.lda ? g.lda : g.K;
    unsigned voffA[2], voffB[2];
#pragma unroll
    for (int i = 0; i < 2; ++i) { int R, C; stage_rc(tid * 16 + i * 8192, R, C); const int Rb = Epi::PERM ? ((R & ~31) + perm32(R & 31)) : R;
        voffA[i] = (unsigned)(R * LD + C) * 2u; voffB[i] = (unsigned)(Rb * LD + C) * 2u; }
    const size_t kstep = (size_t)(BK * 2);
    const size_t hstep = (size_t)HALF * LD * 2;
    const size_t tstep = 2 * hstep;
    const unsigned ldsw = (unsigned)wid * 1024u;
    const int aoff = lds_byte(wr * 64 + fr, fq * 8), boff = lds_byte(wc * 32 + fr, fq * 8);
#define PG8_SA(b, h) (((b) * 2 + (h)) * HTB)
#define PG8_SB(b, h) ((4 + (b) * 2 + (h)) * HTB)
#define PG8_STAGE(bufoff, gbase, voff) do { _Pragma("unroll") for (int _i = 0; _i < 2; ++_i) \
        __builtin_amdgcn_global_load_lds((const unsigned*)((const char*)(gbase) + (voff)[_i]), (PG8_LAS unsigned*)(lds + (bufoff) + ldsw + _i * 8192), 16, 0, 0); } while (0)
#define PG8_LDA(dst, b, h) do { _Pragma("unroll") for (int m = 0; m < 4; ++m) _Pragma("unroll") for (int k = 0; k < 2; ++k) dst[m][k] = *(const PG8_LAS bf16x8*)(lds + PG8_SA(b, h) + aoff + m * 2048 + k * 1024); } while (0)
#define PG8_LDB(dst, b, h) do { _Pragma("unroll") for (int n = 0; n < 2; ++n) _Pragma("unroll") for (int k = 0; k < 2; ++k) dst[n][k] = *(const PG8_LAS bf16x8*)(lds + PG8_SB(b, h) + boff + n * 2048 + k * 1024); } while (0)
#define PG8_MMA(ai, bj, At, Bt) do { __builtin_amdgcn_s_setprio(1); _Pragma("unroll") for (int m = 0; m < 4; ++m) _Pragma("unroll") for (int n = 0; n < 2; ++n) _Pragma("unroll") for (int k = 0; k < 2; ++k) \
        acc[ai][bj][m][n] = __builtin_amdgcn_mfma_f32_16x16x32_bf16(Bt[n][k], At[m][k], acc[ai][bj][m][n], 0, 0, 0); __builtin_amdgcn_s_setprio(0); } while (0)
#define PG8_WAIT_V(n) asm volatile("s_waitcnt vmcnt(" #n ")" ::: "memory")
#define PG8_WAIT_L(n) asm volatile("s_waitcnt lgkmcnt(" #n ")" ::: "memory")
#define PG8_BAR __builtin_amdgcn_s_barrier()
#define PG8_SCHED __builtin_amdgcn_sched_barrier(0)
    Unit cur, nxt; int ui = 0;
    if (!S.next(0, cur)) return;
    f32x4 acc[2][2][4][2];
#pragma unroll
    for (int a = 0; a < 2; ++a)
#pragma unroll
        for (int b = 0; b < 2; ++b)
#pragma unroll
            for (int m = 0; m < 4; ++m)
#pragma unroll
                for (int n = 0; n < 2; ++n) acc[a][b][m][n] = (f32x4){0.f, 0.f, 0.f, 0.f};
    bf16x8 At[4][2], B0[2][2], B1[2][2];
    const char* cA = (const char*)g.A + (GATHER ? (size_t)0 : (size_t)cur.pm * tstep) + (size_t)cur.kq * K * 2; const char* cB = (const char*)g.Bt + (size_t)cur.pn * tstep + (size_t)cur.kq * K * 2;
    unsigned voffGC[2][2], voffGN[2][2];
#define PG8_GOFF(dst, unit) do { _Pragma("unroll") for (int h_ = 0; h_ < 2; ++h_) _Pragma("unroll") for (int i_ = 0; i_ < 2; ++i_) { int R_, C_; stage_rc(tid * 16 + i_ * 8192, R_, C_); \
        dst[h_][i_] = (unsigned)(g.rowmap[(unit).pm * BM + h_ * HALF + R_] * LD + C_) * 2u; } } while (0)
    if constexpr (GATHER) { PG8_GOFF(voffGC, cur); _Pragma("unroll") for (int h_ = 0; h_ < 2; ++h_) { voffGN[h_][0] = voffGC[h_][0]; voffGN[h_][1] = voffGC[h_][1]; } }
#define PG8_STAGE_A(bufoff, ptr, h, isnext) do { if constexpr (GATHER) { const unsigned vs_[2] = {(isnext) ? voffGN[h][0] : voffGC[h][0], (isnext) ? voffGN[h][1] : voffGC[h][1]}; PG8_STAGE(bufoff, ptr, vs_); } \
        else { PG8_STAGE(bufoff, (ptr) + (h) * hstep, voffA); } } while (0)
    S.a_ready(cur);
    if constexpr (SP2) {
        PG8_STAGE(PG8_SB(0, 0), cB, voffB); PG8_STAGE(PG8_SB(0, 1), cB + hstep, voffB); PG8_STAGE_A(PG8_SA(0, 0), cA, 0, false); PG8_STAGE_A(PG8_SA(0, 1), cA, 1, false);
        if (wr == 1) PG8_BAR;
        PG8_WAIT_V(2); PG8_BAR;
        PG8_STAGE(PG8_SB(1, 0), cB + kstep, voffB); PG8_STAGE_A(PG8_SA(1, 0), cA + kstep, 0, false); PG8_STAGE(PG8_SB(1, 1), cB + hstep + kstep, voffB);
        PG8_WAIT_V(6); PG8_BAR;
    } else {
        PG8_STAGE(PG8_SB(0, 0), cB, voffB); PG8_STAGE_A(PG8_SA(0, 0), cA, 0, false); PG8_STAGE(PG8_SB(0, 1), cB + hstep, voffB); PG8_STAGE_A(PG8_SA(0, 1), cA, 1, false);
        if (wr == 1) PG8_BAR;
        PG8_WAIT_V(4); PG8_BAR;
        PG8_STAGE(PG8_SB(1, 0), cB + kstep, voffB); PG8_STAGE_A(PG8_SA(1, 0), cA + kstep, 0, false); PG8_STAGE(PG8_SB(1, 1), cB + hstep + kstep, voffB);
        PG8_WAIT_V(6); PG8_BAR;
    }
    for (;;) {
        const bool has_next = S.next(ui + 1, nxt);
        const char* nA = GATHER ? cA : (has_next ? (const char*)g.A + (size_t)nxt.pm * tstep + (size_t)nxt.kq * K * 2 : cA);
        if constexpr (GATHER) { if (has_next) PG8_GOFF(voffGN, nxt); } const char* nB = has_next ? (const char*)g.Bt + (size_t)nxt.pn * tstep + (size_t)nxt.kq * K * 2 : cB;
        for (int t = 0; t < nt; t += 2) {
            const bool last = (t == nt - 2);
            const char* a1 = cA + (size_t)(t + 1) * kstep;
            const char* a2 = last ? nA : cA + (size_t)(t + 2) * kstep; const char* b2 = last ? nB : cB + (size_t)(t + 2) * kstep;
            const char* a3 = a2 + kstep; const char* b3 = b2 + kstep;
            if (last && has_next) S.a_ready(nxt);
            if constexpr (SP2) {
            PG8_LDB(B0, 0, 0); PG8_LDB(B1, 0, 1); PG8_SCHED; PG8_LDA(At, 0, 0); PG8_STAGE_A(PG8_SA(1, 1), a1, 1, false);
            PG8_WAIT_V(8); PG8_WAIT_L(0); PG8_BAR; PG8_MMA(0, 0, At, B0); PG8_MMA(0, 1, At, B1); PG8_BAR; PG8_SCHED;
            PG8_LDA(At, 0, 1); PG8_STAGE(PG8_SB(0, 0), b2, voffB); PG8_STAGE(PG8_SB(0, 1), b2 + hstep, voffB); PG8_STAGE_A(PG8_SA(0, 0), a2, 0, last);
            PG8_WAIT_V(8); PG8_WAIT_L(0); PG8_BAR; PG8_MMA(1, 0, At, B0); PG8_MMA(1, 1, At, B1); PG8_BAR; PG8_SCHED;
            PG8_LDB(B0, 1, 0); PG8_LDB(B1, 1, 1); PG8_SCHED; PG8_LDA(At, 1, 0); PG8_STAGE_A(PG8_SA(0, 1), a2, 1, last);
            PG8_WAIT_V(8); PG8_WAIT_L(0); PG8_BAR; PG8_MMA(0, 0, At, B0); PG8_MMA(0, 1, At, B1); PG8_BAR; PG8_SCHED;
            PG8_LDA(At, 1, 1); PG8_STAGE(PG8_SB(1, 0), b3, voffB); PG8_STAGE(PG8_SB(1, 1), b3 + hstep, voffB); PG8_STAGE_A(PG8_SA(1, 0), a3, 0, last);
            PG8_WAIT_V(8); PG8_WAIT_L(0); PG8_BAR; PG8_MMA(1, 0, At, B0); PG8_MMA(1, 1, At, B1); PG8_BAR; PG8_SCHED;
            } else {
            PG8_LDB(B0, 0, 0); PG8_SCHED; PG8_LDA(At, 0, 0); PG8_STAGE_A(PG8_SA(1, 1), a1, 1, false);
            PG8_WAIT_L(8); PG8_BAR; PG8_WAIT_L(0); PG8_MMA(0, 0, At, B0); PG8_BAR; PG8_SCHED;
            PG8_LDB(B1, 0, 1); PG8_STAGE(PG8_SB(0, 0), b2, voffB);
            PG8_BAR; PG8_WAIT_L(0); PG8_MMA(0, 1, At, B1); PG8_BAR;
            PG8_LDA(At, 0, 1); PG8_STAGE_A(PG8_SA(0, 0), a2, 0, last);
            PG8_BAR; PG8_WAIT_L(0); PG8_MMA(1, 0, At, B0); PG8_BAR; PG8_SCHED;
            PG8_STAGE(PG8_SB(0, 1), b2 + hstep, voffB);
            PG8_WAIT_V(6); PG8_BAR; PG8_MMA(1, 1, At, B1); PG8_BAR;
            PG8_LDB(B0, 1, 0); PG8_SCHED; PG8_LDA(At, 1, 0); PG8_STAGE_A(PG8_SA(0, 1), a2, 1, last);
            PG8_WAIT_L(8); PG8_BAR; PG8_WAIT_L(0); PG8_MMA(0, 0, At, B0); PG8_BAR; PG8_SCHED;
            PG8_LDB(B1, 1, 1); PG8_STAGE(PG8_SB(1, 0), b3, voffB);
            PG8_BAR; PG8_WAIT_L(0); PG8_MMA(0, 1, At, B1); PG8_BAR;
            PG8_LDA(At, 1, 1); PG8_STAGE_A(PG8_SA(1, 0), a3, 0, last);
            PG8_BAR; PG8_WAIT_L(0); PG8_MMA(1, 0, At, B0); PG8_BAR; PG8_SCHED;
            PG8_STAGE(PG8_SB(1, 1), b3 + hstep, voffB);
            PG8_WAIT_V(6); PG8_BAR; PG8_MMA(1, 1, At, B1); PG8_BAR;
            }
        }
        if constexpr (ALIGN_EPI) { if (wr == 0) PG8_BAR; }
        if constexpr (!Epi::AFTER_DRAIN) { E(acc, cur, wr, wc, fr, fq); S.done(cur); }
        if (!has_next) break;
#pragma unroll
        for (int a = 0; a < 2; ++a)
#pragma unroll
            for (int b = 0; b < 2; ++b)
#pragma unroll
                for (int m = 0; m < 4; ++m)
#pragma unroll
                    for (int n = 0; n < 2; ++n) acc[a][b][m][n] = (f32x4){0.f, 0.f, 0.f, 0.f};
        cur = nxt; cA = nA; cB = nB; ++ui;
        if constexpr (GATHER) { _Pragma("unroll") for (int h_ = 0; h_ < 2; ++h_) { voffGC[h_][0] = voffGN[h_][0]; voffGC[h_][1] = voffGN[h_][1]; } }
        if constexpr (ALIGN_EPI) { if (wr == 1) PG8_BAR; }
    }
    PG8_WAIT_V(0);
    if constexpr (!ALIGN_EPI) { if (wr == 0) PG8_BAR; }
    PG8_BAR;
    if constexpr (Epi::AFTER_DRAIN) { E.fused(acc, cur, wr, wc, fr, fq, lds, wid, lane); S.done(cur); }
#undef PG8_SA
#undef PG8_SB
#undef PG8_STAGE
#undef PG8_STAGE_A
#undef PG8_GOFF
#undef PG8_LDA
#undef PG8_LDB
#undef PG8_MMA
#undef PG8_WAIT_V
#undef PG8_WAIT_L
#undef PG8_BAR
#undef PG8_SCHED
}
}
#define GAS __attribute__((address_space(1)))
#define LAS __attribute__((address_space(3)))
typedef unsigned short bf16;
typedef unsigned v4u __attribute__((ext_vector_type(4)));
typedef unsigned v2u __attribute__((ext_vector_type(2)));
typedef float f32x4 __attribute__((ext_vector_type(4)));
typedef float f32x2 __attribute__((ext_vector_type(2)));
typedef short bf16x8 __attribute__((ext_vector_type(8)));
typedef short bf16x4 __attribute__((ext_vector_type(4)));
#define RLX_AGENT __ATOMIC_RELAXED, __HIP_MEMORY_SCOPE_AGENT
#define LDS_WAIT() asm volatile("s_waitcnt lgkmcnt(0)" ::: "memory")
#define VM_WAIT() asm volatile("s_waitcnt vmcnt(0)" ::: "memory")

constexpr int NT = 512, NWAVES = 8;
constexpr int D = 1024, NB = 8, SEQ = 4096, CTXL = 256;
constexpr int NLAT = NB * SEQ, NCTX = NB * CTXL, MROWS = NLAT + NCTX;
constexpr int NE = 16, FF = 2048, CAPX = 512, CAPC = 32, ROWS_E = NB * CAPX + NB * CAPC  , MG = NE * ROWS_E  ;
constexpr float NORM_EPS = 1e-6f;
constexpr int N_HG = 5120, N_HY = 3072, N_MB = 6400  , N_MB_REAL = 6208, N_MBP = 4352  , N_GLA = 3328  , N_GLA_REAL = 3104;

enum { I_X = 0, I_C, I_CTX, I_CCTX, I_ADA_W, I_ADA_B, I_N1G, I_N2G, I_HG_WIN, I_HG_LB, I_HG_ONG, I_HG_WOUT,
       I_HY_WIN, I_HY_BIN, I_HY_SW, I_HY_SB, I_HY_W1, I_HY_B1, I_HY_W2, I_HY_B2, I_HY_W3, I_HY_B3, I_HY_W4, I_HY_FREQ, I_HY_FBIAS, I_HY_WOUT, I_HY_BOUT,
       I_MB_WIN, I_MB_CW, I_MB_CB, I_MB_DTB, I_MB_ALOG, I_MB_D, I_MB_NG, I_MB_WOUT,
       I_GLA_WIN, I_GLA_W2, I_GLA_GKB, I_GLA_ONG, I_GLA_WOUT, I_ROUTER, I_MOE_G, I_MOE_U, I_MOE_D, I_FNG, N_IN };

constexpr size_t MiB = 1ull << 20;
constexpr size_t WS_CTL = 0, CTL_ZERO_BYTES = 1 * MiB;
constexpr size_t WS_MOD = 1 * MiB;
constexpr size_t WS_LB = WS_MOD + 4ull * 9 * 6144 * 4;
constexpr size_t WS_X = 2 * MiB;
constexpr size_t WS_H = 138 * MiB;
constexpr size_t WS_WIN = 206 * MiB;
constexpr size_t WS_WOUT = 219 * MiB;
constexpr size_t WS_WGU = 223 * MiB;
constexpr size_t WS_WDN = 351 * MiB;
constexpr size_t WS_AFF = 415 * MiB;
constexpr size_t WS_SLOT = 418 * MiB;
constexpr size_t WS_GATE = 421 * MiB;
constexpr size_t WS_SRCROW = 422 * MiB;
constexpr size_t WS_BIG = 424 * MiB;
constexpr size_t WS_P = WS_BIG;
constexpr size_t WS_XBC = WS_BIG + 426 * MiB;
constexpr size_t WS_REC = WS_BIG + 426 * MiB;
constexpr size_t WS_REC_MB = WS_BIG + 837 * MiB;
constexpr size_t WS_O_MB = WS_BIG;
constexpr size_t WS_ZB = WS_BIG + 700 * MiB;
constexpr size_t WS_O = WS_BIG + 850 * MiB;
constexpr size_t WS_OI = WS_BIG + 1124 * MiB;
constexpr size_t WS_O_GLA = WS_BIG + 1124 * MiB;
constexpr size_t WS_A2 = WS_BIG + 1400 * MiB;
constexpr size_t WS_DT = WS_BIG + 1540 * MiB;
constexpr size_t WS_UT = WS_BIG + 426 * MiB;
constexpr size_t WS_UTC = WS_BIG + 810 * MiB;
constexpr size_t WS_HFT = WS_BIG + 1552 * MiB;
constexpr size_t WS_HFC = WS_BIG + 1616 * MiB;
constexpr size_t WS_A3G = WS_BIG + 1620 * MiB;
constexpr size_t WS_SPEC = WS_BIG + 1270 * MiB;
constexpr size_t WS_ZT = WS_BIG + 1040 * MiB;
constexpr size_t WS_ZTC = WS_BIG + 1168 * MiB;
constexpr size_t WS_HYA2 = WS_BIG + 1180 * MiB;
constexpr size_t WS_YEP = WS_BIG;
constexpr size_t WS_HID = WS_BIG + 136 * MiB;
constexpr size_t WS_YE = WS_BIG + 408 * MiB;
constexpr size_t WS_END = WS_BIG + 1624 * MiB;

constexpr int CW_CVT = 1024;
constexpr int CW_BAR = 4096;

constexpr int LDS_BYTES = 163840, LDSCTL_BYTES = 512, MISC_OFF = 320;

__device__ __forceinline__ unsigned f2bf(float f) { return (unsigned)__builtin_bit_cast(unsigned short, (__bf16)f); }
typedef __bf16 bf16x2_t __attribute__((ext_vector_type(2)));
__device__ __forceinline__ unsigned pk2(float lo, float hi) { const f32x2 v = {lo, hi}; return __builtin_bit_cast(unsigned, __builtin_convertvector(v, bf16x2_t)); }
__device__ __forceinline__ float bf2f(unsigned b) { return __builtin_bit_cast(float, b << 16); }
__device__ __forceinline__ float bflo(unsigned w) { return __builtin_bit_cast(float, w << 16); }
__device__ __forceinline__ float bfhi(unsigned w) { return __builtin_bit_cast(float, w & 0xffff0000u); }
__device__ __forceinline__ float sigmoidf_(float x) { return __builtin_amdgcn_rcpf(1.0f + __expf(-x)); }
__device__ __forceinline__ float siluf_(float x) { return x * __builtin_amdgcn_rcpf(1.0f + __expf(-x)); }
__device__ __forceinline__ float wave_sum(float v) {
#pragma unroll
    for (int o = 1; o < 64; o <<= 1) v += __shfl_xor(v, o);
    return v;
}
__device__ __forceinline__ bf16x8 pack8(f32x4 a, f32x4 b) {
    v4u w; w.x = pk2(a[0], a[1]); w.y = pk2(a[2], a[3]); w.z = pk2(b[0], b[1]); w.w = pk2(b[2], b[3]);
    return __builtin_bit_cast(bf16x8, w);
}
__device__ __forceinline__ bf16x8 cat8(bf16x4 lo, bf16x4 hi) { return __builtin_shufflevector(lo, hi, 0, 1, 2, 3, 4, 5, 6, 7); }
#define MFMA16(a, b, c) __builtin_amdgcn_mfma_f32_16x16x32_bf16((a), (b), (c), 0, 0, 0)

struct Args { const float* in[N_IN]; float* out; unsigned char* ws; int ph_lo, ph_hi; };
struct Frame { LAS unsigned char* lds; int tid, lane, wave, G, bid; };

struct EpiStoreBf16 {
    static constexpr bool PERM = true, AFTER_DRAIN = false;
    bf16* O; int ldc; const float* bias; bf16* O2; int ldc2, split_pn;
    __device__ __forceinline__ void operator()(const pg8::f32x4 (&acc)[2][2][4][2], const pg8::Unit& u, int wr, int wc, int fr, int fq) const {
        const int row0 = u.pm * 256 + wr * 64 + fr, col0 = u.pn * 256 + wc * 32 + 8 * fq;
        const bool lo = u.pn < split_pn; bf16* base = lo ? O2 : O; const int ld = lo ? ldc2 : ldc, ocol0 = lo ? col0 : col0 - 256 * split_pn;
        f32x4 bv[2][2];
#pragma unroll
        for (int bj = 0; bj < 2; ++bj)
#pragma unroll
            for (int n = 0; n < 2; ++n) bv[bj][n] = bias ? *(const f32x4*)(bias + col0 + bj * 128 + 4 * n) : (f32x4){0.f, 0.f, 0.f, 0.f};
#pragma unroll
        for (int ai = 0; ai < 2; ++ai)
#pragma unroll
            for (int m = 0; m < 4; ++m) { bf16* rowp = base + (size_t)(row0 + ai * 128 + m * 16) * ld + ocol0;
#pragma unroll
                for (int bj = 0; bj < 2; ++bj) { const f32x4 v0 = acc[ai][bj][m][0] + bv[bj][0], v1 = acc[ai][bj][m][1] + bv[bj][1];
                    v4u w; w.x = pk2(v0[0], v0[1]); w.y = pk2(v0[2], v0[3]); w.z = pk2(v1[0], v1[1]); w.w = pk2(v1[2], v1[3]);
                    *(v4u*)(rowp + bj * 128) = w; } }
    }
};
struct EpiResid {
    static constexpr bool PERM = false, AFTER_DRAIN = false;
    bf16* X; const float* gate  ; const float* bias; const float* xin; const float* cin;
    __device__ __forceinline__ void operator()(const pg8::f32x4 (&acc)[2][2][4][2], const pg8::Unit& u, int wr, int wc, int fr, int fq) const {
        const int row0 = u.pm * 256 + wr * 64 + fr, col0 = u.pn * 256 + wc * 32 + 4 * fq;
        const int modrow = u.pm < 128 ? (u.pm >> 4) : 8;
        const float* gp = gate + (size_t)modrow * 6144 + col0;
        f32x4 gv[2][2], bv[2][2];
#pragma unroll
        for (int bj = 0; bj < 2; ++bj)
#pragma unroll
            for (int n = 0; n < 2; ++n) { gv[bj][n] = *(const f32x4*)(gp + bj * 128 + n * 16); bv[bj][n] = bias ? *(const f32x4*)(bias + col0 + bj * 128 + n * 16) : (f32x4){0.f, 0.f, 0.f, 0.f}; }
#pragma unroll
        for (int ai = 0; ai < 2; ++ai)
#pragma unroll
            for (int m = 0; m < 4; ++m) { const int r = row0 + ai * 128 + m * 16; bf16* rowp = X + (size_t)r * 1024 + col0;
                const float* srcp = xin ? (u.pm < 128 ? xin + (size_t)r * 1024 + col0 : cin + (size_t)(r - NLAT) * 1024 + col0) : nullptr;
#pragma unroll
                for (int bj = 0; bj < 2; ++bj)
#pragma unroll
                    for (int n = 0; n < 2; ++n) { f32x4 res;
                        if (xin) res = *(const f32x4*)(srcp + bj * 128 + n * 16);
                        else { const v2u w = *(const v2u*)(rowp + bj * 128 + n * 16); res = (f32x4){bflo(w.x), bfhi(w.x), bflo(w.y), bfhi(w.y)}; }
                        const f32x4 o = res + gv[bj][n] * (acc[ai][bj][m][n] + bv[bj][n]);
                        v2u wo; wo.x = pk2(o[0], o[1]); wo.y = pk2(o[2], o[3]); *(v2u*)(rowp + bj * 128 + n * 16) = wo; } }
    }
};
struct EpiSwiGLU {
    static constexpr bool PERM = true, AFTER_DRAIN = false;
    bf16* HID;
    __device__ __forceinline__ void operator()(const pg8::f32x4 (&acc)[2][2][4][2], const pg8::Unit& u, int wr, int wc, int fr, int fq) const {
        const int row0 = u.pm * 256 + wr * 64 + fr, col0 = (u.pn & 15) * 128 + wc * 32 + 8 * fq;
#pragma unroll
        for (int ai = 0; ai < 2; ++ai)
#pragma unroll
            for (int m = 0; m < 4; ++m) { bf16* rowp = HID + (size_t)(row0 + ai * 128 + m * 16) * 2048 + col0;
                f32x4 h0, h1;
#pragma unroll
                for (int j = 0; j < 4; ++j) { h0[j] = siluf_(acc[ai][0][m][0][j]) * acc[ai][1][m][0][j]; h1[j] = siluf_(acc[ai][0][m][1][j]) * acc[ai][1][m][1][j]; }
                v4u w; w.x = pk2(h0[0], h0[1]); w.y = pk2(h0[2], h0[3]); w.z = pk2(h1[0], h1[1]); w.w = pk2(h1[2], h1[3]);
                *(v4u*)rowp = w; }
    }
};
struct EpiDown {
    static constexpr bool PERM = true, AFTER_DRAIN = false;
    bf16* YE; const float* GATE;
    __device__ __forceinline__ void operator()(const pg8::f32x4 (&acc)[2][2][4][2], const pg8::Unit& u, int wr, int wc, int fr, int fq) const {
        const int row0 = u.pm * 256 + wr * 64 + fr, col0 = (u.pn & 3) * 256 + wc * 32 + 8 * fq;
#pragma unroll
        for (int ai = 0; ai < 2; ++ai)
#pragma unroll
            for (int m = 0; m < 4; ++m) { const int r = row0 + ai * 128 + m * 16; const float gt = GATE[r]; bf16* rowp = YE + (size_t)r * 1024 + col0;
#pragma unroll
                for (int bj = 0; bj < 2; ++bj) { const f32x4 v0 = acc[ai][bj][m][0] * gt, v1 = acc[ai][bj][m][1] * gt;
                    v4u w; w.x = pk2(v0[0], v0[1]); w.y = pk2(v0[2], v0[3]); w.z = pk2(v1[0], v1[1]); w.w = pk2(v1[2], v1[3]);
                    *(v4u*)(rowp + bj * 128) = w; } }
    }
};
struct EpiDownPart {
    static constexpr bool PERM = true, AFTER_DRAIN = false;
    bf16* YEP; const float* GATE;
    __device__ __forceinline__ void operator()(const pg8::f32x4 (&acc)[2][2][4][2], const pg8::Unit& u, int wr, int wc, int fr, int fq) const {
        const int e = u.pn >> 2, lrow0 = wr * 64 + fr, col0 = (u.pn & 3) * 256 + wc * 32 + 8 * fq;
#pragma unroll
        for (int ai = 0; ai < 2; ++ai)
#pragma unroll
            for (int m = 0; m < 4; ++m) { const int lr = lrow0 + ai * 128 + m * 16; const float gt = GATE[u.pm * 256 + lr]; bf16* rowp = YEP + ((size_t)(u.kq * NE + e) * 256 + lr) * 1024 + col0;
#pragma unroll
                for (int bj = 0; bj < 2; ++bj) { const f32x4 v0 = acc[ai][bj][m][0] * gt, v1 = acc[ai][bj][m][1] * gt;
                    v4u w; w.x = pk2(v0[0], v0[1]); w.y = pk2(v0[2], v0[3]); w.z = pk2(v1[0], v1[1]); w.w = pk2(v1[2], v1[3]);
                    *(v4u*)(rowp + bj * 128) = w; } }
    }
};
struct CtxQuarterOrder {
    int G, c;
    __device__ __forceinline__ bool next(int i, pg8::Unit& u) const {
        const int L = i * G + c; if (L >= 256) return false;
        const int e = L >> 4, r = L & 15; u.pm = e * 17 + 16; u.pn = e * 4 + (r >> 2); u.kq = r & 3; return true;
    }
    __device__ __forceinline__ void a_ready(const pg8::Unit&) const {}
    __device__ __forceinline__ void done(const pg8::Unit&) const {}
};
struct GroupedOrder {
    int nN, G, c, nM;
    __device__ __forceinline__ bool next(int i, pg8::Unit& u) const {
        const int nwg = NE * nM * nN; int L = i * G + c; if (L >= nwg) return false;
        { const int q = nwg / 8, r = nwg % 8, xcd = L % 8, off = L / 8; L = (xcd < r ? xcd * (q + 1) : r * (q + 1) + (xcd - r) * q) + off; }
        const int per = nM * nN, e = L / per, r = L % per; int jn, im;
        if (nN == 16) { const int jg = r / (8 * nM), r2 = r % (8 * nM); im = r2 >> 3; jn = jg * 8 + (r2 & 7); }
        else { im = r / nN; jn = r % nN; }
        u.pm = e * 17 + im; u.pn = e * nN + jn; u.kq = 0; return true;
    }
    __device__ __forceinline__ void a_ready(const pg8::Unit&) const {}
    __device__ __forceinline__ void done(const pg8::Unit&) const {}
};
#define XB_TMO      128
#define XB_XCNT(j)  (256  + 64 * (j))
#define XB_XSUB(j)  (1280 + 64 * (j))
#define XB_XGEN(j)  (2304 + 64 * (j))
#define XB_TOP      3328
#define XB_TOPGEN   3392
#define XCD_BAR_WORDS 3456
#define XB_SPIN_CAP (1u << 18)

__device__ __forceinline__ unsigned xb_ld(unsigned* p)              { return __hip_atomic_load(p, __ATOMIC_RELAXED, __HIP_MEMORY_SCOPE_AGENT); }
__device__ __forceinline__ unsigned xb_add(unsigned* p, unsigned v) { return __hip_atomic_fetch_add(p, v, __ATOMIC_RELAXED, __HIP_MEMORY_SCOPE_AGENT); }
__device__ __forceinline__ unsigned xb_xcc_id() { return (unsigned)__builtin_amdgcn_s_getreg((3 << 11) | 20) & 0xFu; }
#define XB_SPIN(cond, bar) do { unsigned _sp = 0; while (cond) { __builtin_amdgcn_s_sleep(1); \
    if ((++_sp & 255u) == 0u) { if (xb_ld(&(bar)[XB_TMO])) break; if (_sp > XB_SPIN_CAP) { atomicAdd(&(bar)[XB_TMO], 1u); break; } } } } while (0)

struct XcdBarrier {
    unsigned* bar; unsigned x;
    volatile LAS unsigned* st;
};

__device__ __forceinline__ XcdBarrier xcd_barrier_post(unsigned* bar, volatile LAS unsigned* st) {
    XcdBarrier b; b.bar = bar; b.x = xb_xcc_id(); b.st = st;
    if (threadIdx.x == 0) (void)xb_add(&bar[XB_XCNT(b.x)], 1u);
    return b;
}
__device__ __forceinline__ void xcd_barrier_complete(unsigned* bar, unsigned x, unsigned& nloc, unsigned& nx) {
    const unsigned G = gridDim.x * gridDim.y * gridDim.z;
    unsigned sum, cnt, mine, sp = 0u;
    for (;;) {
        sum = 0u; cnt = 0u; mine = 0u;
#pragma unroll
        for (unsigned j = 0; j < 16; ++j) { const unsigned c = xb_ld(&bar[XB_XCNT(j)]); sum += c; cnt += (c > 0u) ? 1u : 0u; mine = (j == x) ? c : mine; }
        if (sum == G) break;
        __builtin_amdgcn_s_sleep(1);
        if ((++sp & 255u) == 0u) { if (xb_ld(&bar[XB_TMO])) break; if (sp > XB_SPIN_CAP) { atomicAdd(&bar[XB_TMO], 1u); break; } }
    }
    nloc = mine > 0u ? mine : 1u; nx = cnt > 0u ? cnt : 1u;
}

__device__ __forceinline__ void xcd_barrier(const XcdBarrier& b) {
    asm volatile("s_waitcnt vmcnt(0)" ::: "memory");
    __syncthreads();
    if (threadIdx.x == 0) {
        unsigned* bar = b.bar;
        __builtin_amdgcn_s_waitcnt(0);
        unsigned nloc = b.st[0], nx = b.st[1];
        if (nloc == 0u) { xcd_barrier_complete(bar, b.x, nloc, nx); b.st[0] = nloc; b.st[1] = nx; }
        const unsigned old = xb_add(&bar[XB_XSUB(b.x)], 1u);
        const unsigned gen = old / nloc;
        if (old + 1u == (gen + 1u) * nloc) {
            __builtin_amdgcn_fence(__ATOMIC_RELEASE, "agent");
            asm volatile("s_waitcnt vmcnt(0)" ::: "memory");
            const unsigned og = xb_add(&bar[XB_TOP], 1u);
            const unsigned tg = og / nx;
            if (og + 1u == (tg + 1u) * nx) xb_add(&bar[XB_TOPGEN], 1u);
            else XB_SPIN(xb_ld(&bar[XB_TOPGEN]) == tg, bar);
            __builtin_amdgcn_fence(__ATOMIC_ACQUIRE, "agent");
            xb_add(&bar[XB_XGEN(b.x)], 1u);
            asm volatile("s_waitcnt vmcnt(0)" ::: "memory");
        } else {
            XB_SPIN(xb_ld(&bar[XB_XGEN(b.x)]) == gen, bar);
            __builtin_amdgcn_fence(__ATOMIC_ACQUIRE, "agent");
            asm volatile("s_waitcnt vmcnt(0)" ::: "memory");
        }
    }
    __syncthreads();
}
#define BSYNC() __syncthreads()

__device__ __forceinline__ void ph_prologue(const Args& a, const Frame& F) {
    LAS float* sc = (LAS float*)F.lds;
    LAS float* part = sc + 9 * 1024;
    for (int j = F.tid; j < 9 * 1024; j += NT) { const int r = j >> 10, k = j & 1023; const float v = r < 8 ? a.in[I_C][r * 1024 + k] : a.in[I_CCTX][k]; sc[j] = siluf_(v); }
    BSYNC();
    float* MOD = (float*)(a.ws + WS_MOD);
    for (int unit = F.bid; unit < 4 * 48; unit += F.G) {
        const int l = unit / 48, ch = unit % 48, cn = F.tid & 127, kq = F.tid >> 7;
        const float* W = a.in[I_ADA_W] + (size_t)l * 1024 * 6144 + ch * 128 + cn;
        float acc[9];
#pragma unroll
        for (int j = 0; j < 9; ++j) acc[j] = 0.f;
        for (int k = kq * 256; k < kq * 256 + 256; ++k) { const float w = W[(size_t)k * 6144];
#pragma unroll
            for (int j = 0; j < 9; ++j) acc[j] += sc[j * 1024 + k] * w; }
#pragma unroll
        for (int j = 0; j < 9; ++j) part[(kq * 9 + j) * 128 + cn] = acc[j];
        BSYNC();
        for (int o = F.tid; o < 9 * 128; o += NT) { const int j = o >> 7, cc = o & 127, n = ch * 128 + cc;
            const float s = (part[(0 * 9 + j) * 128 + cc] + part[(1 * 9 + j) * 128 + cc]) + (part[(2 * 9 + j) * 128 + cc] + part[(3 * 9 + j) * 128 + cc]);
            MOD[(size_t)(l * 9 + j) * 6144 + n] = s + a.in[I_ADA_B][l * 6144 + n]; }
        BSYNC();
    }
    if (F.bid == F.G - 1) {
        float* LB = (float*)(a.ws + WS_LB);
        for (int d = F.tid; d < 1024; d += NT) { float v[5], mx = -1e30f;
#pragma unroll
            for (int r = 0; r < 5; ++r) { v[r] = a.in[I_HG_LB][r * 1024 + d]; mx = fmaxf(mx, v[r]); }
            float s = 0.f;
#pragma unroll
            for (int r = 0; r < 5; ++r) { v[r] = expf(v[r] - mx); s += v[r]; }
            LB[d] = v[0] / s; }
    }
}

__device__ __forceinline__ void transpose_item(const float* W, int K, int N, bf16* WT, int dst_row0, int k0, int n0, LAS float* scr, int lane) {
#pragma unroll 8
    for (int i = 0; i < 32; ++i) { const int kk = 2 * i + (lane >> 5); scr[kk * 33 + (lane & 31)] = __builtin_nontemporal_load(&W[(size_t)(k0 + kk) * N + n0 + (lane & 31)]); }
    LDS_WAIT(); asm volatile("" ::: "memory");
    const int c = lane & 7;
#pragma unroll
    for (int j = 0; j < 4; ++j) { const int n = (lane >> 3) + 8 * j; const LAS float* s = scr + (8 * c) * 33 + n;
        v4u o; o.x = pk2(s[0 * 33], s[1 * 33]); o.y = pk2(s[2 * 33], s[3 * 33]); o.z = pk2(s[4 * 33], s[5 * 33]); o.w = pk2(s[6 * 33], s[7 * 33]);
        *(v4u*)(WT + (size_t)(dst_row0 + n) * K + k0 + 8 * c) = o; }
    LDS_WAIT(); asm volatile("" ::: "memory");
}
__device__ __forceinline__ void cvt_plain(const Frame& F, const float* W, int K, int N, bf16* WT, int Npad, int b0 = 0, int nb = 0) {
    if (nb == 0) nb = F.G;
    if (F.bid < b0 || F.bid >= b0 + nb) return;
    LAS float* scr = (LAS float*)(F.lds + F.wave * 8448);
    const int gw = (F.bid - b0) * NWAVES + F.wave, NGW = nb * NWAVES, nnb = N / 32, items = (K / 64) * nnb;
    for (int it = gw; it < items; it += NGW) { const int kb = it / nnb, nb_ = it % nnb; transpose_item(W, K, N, WT, nb_ * 32, kb * 64, nb_ * 32, scr, F.lane); }
    const int padv = (Npad - N) * K / 8;
    for (int i = (F.bid - b0) * NT + F.tid; i < padv; i += nb * NT) ((v4u*)(WT + (size_t)N * K))[i] = (v4u){0u, 0u, 0u, 0u};
}
__device__ __forceinline__ void cvt_moe(const Args& a, const Frame& F, int layer, int which, int b0, int nb, int f0 = 0, int f1 = 8) {
    if (F.bid < b0 || F.bid >= b0 + nb) return;
    LAS float* scr = (LAS float*)(F.lds + F.wave * 8448);
    const int gw = (F.bid - b0) * NWAVES + F.wave, NGW = nb * NWAVES;
    if (which == 0) { bf16* WGU = (bf16*)(a.ws + WS_WGU);
        for (int it = 4096 * f0 + gw; it < 4096 * f1; it += NGW) {
            const int wh = it >> 14, e = (it >> 10) & 15, r = it & 1023, kb = r >> 6, nb_ = r & 63, n0 = nb_ * 32;
            const float* W = a.in[wh ? I_MOE_U : I_MOE_G] + (size_t)(layer * 16 + e) * 1024 * 2048;
            transpose_item(W, 1024, 2048, WGU, e * 4096 + (n0 >> 7) * 256 + wh * 128 + (n0 & 127), kb * 64, n0, scr, F.lane); } }
    else { bf16* WDN = (bf16*)(a.ws + WS_WDN);
        for (int it = 2048 * f0 + gw; it < 2048 * f1; it += NGW) {
            const int e = it >> 10, r = it & 1023, kb = r >> 5, nb_ = r & 31, n0 = nb_ * 32;
            const float* W = a.in[I_MOE_D] + (size_t)(layer * 16 + e) * 2048 * 1024;
            transpose_item(W, 2048, 1024, WDN, e * 1024 + n0, kb * 64, n0, scr, F.lane); } }
}

__device__ __forceinline__ void cvt_moe_dyn(const Args& a, const Frame& F, int layer, int ctr_idx) {
    LAS float* scr = (LAS float*)(F.lds + F.wave * 8448);
    unsigned* ctr = (unsigned*)(a.ws + WS_CTL) + CW_CVT + 64 * ctr_idx;
    bf16* WGU = (bf16*)(a.ws + WS_WGU); bf16* WDN = (bf16*)(a.ws + WS_WDN);
    constexpr unsigned NGU = 4096 * 8, NTOT = NGU + 2048 * 8;
    unsigned curv = 0; if (F.lane == 0) curv = __hip_atomic_fetch_add(ctr, 8u, __ATOMIC_RELAXED, __HIP_MEMORY_SCOPE_AGENT);
    unsigned cur = __builtin_amdgcn_readfirstlane(curv);
    while (cur < NTOT) {
        unsigned nxtv = 0; if (F.lane == 0) nxtv = __hip_atomic_fetch_add(ctr, 8u, __ATOMIC_RELAXED, __HIP_MEMORY_SCOPE_AGENT);
        if (cur < NGU) {
            for (int q = 0; q < 8; ++q) { const int it = cur + q;
                const int wh = it >> 14, e = (it >> 10) & 15, r = it & 1023, kb = r >> 6, nb_ = r & 63, n0 = nb_ * 32;
                const float* W = a.in[wh ? I_MOE_U : I_MOE_G] + (size_t)(layer * 16 + e) * 1024 * 2048;
                transpose_item(W, 1024, 2048, WGU, e * 4096 + (n0 >> 7) * 256 + wh * 128 + (n0 & 127), kb * 64, n0, scr, F.lane); }
        } else {
            for (int q = 0; q < 8; ++q) { const int it = cur - NGU + q;
                const int e = it >> 10, r = it & 1023, kb = r >> 5, nb_ = r & 31, n0 = nb_ * 32;
                const float* W = a.in[I_MOE_D] + (size_t)(layer * 16 + e) * 2048 * 1024;
                transpose_item(W, 2048, 1024, WDN, e * 1024 + n0, kb * 64, n0, scr, F.lane); }
        }
        cur = __builtin_amdgcn_readfirstlane(nxtv);
    }
}

__device__ __forceinline__ void ph_norm1(const Args& a, const Frame& F, int layer) {
    const float* X = (const float*)(a.ws + WS_X); bf16* H = (bf16*)(a.ws + WS_H);
    const float* MOD = (const float*)(a.ws + WS_MOD) + (size_t)layer * 9 * 6144;
    const float* g = a.in[I_N1G] + layer * 1024;
    const int gw = F.bid * NWAVES + F.wave, NGW = F.G * NWAVES;
    for (int row = gw; row < MROWS; row += NGW) {
        const f32x4* xr = (const f32x4*)(layer == 0 ? (row < NLAT ? a.in[I_X] + (size_t)row * 1024 : a.in[I_CTX] + (size_t)(row - NLAT) * 1024) : X + (size_t)row * 1024) + F.lane;
        f32x4 v[4]; float ss = 0.f;
#pragma unroll
        for (int j = 0; j < 4; ++j) { v[j] = xr[64 * j]; ss += (v[j].x * v[j].x + v[j].y * v[j].y) + (v[j].z * v[j].z + v[j].w * v[j].w); }
        const float rstd = rsqrtf(wave_sum(ss) * (1.f / 1024.f) + NORM_EPS);
        const int mr = row < NLAT ? (row >> 12) : 8;
        const f32x4* sh = (const f32x4*)(MOD + (size_t)mr * 6144 + 0 * 1024) + F.lane; const f32x4* sc = (const f32x4*)(MOD + (size_t)mr * 6144 + 1 * 1024) + F.lane;
        const f32x4* gg = (const f32x4*)g + F.lane;
        v2u* o8 = (v2u*)(H + (size_t)row * 1024) + F.lane;
#pragma unroll
        for (int j = 0; j < 4; ++j) { const f32x4 h = v[j] * rstd * gg[64 * j] * (sc[64 * j] + 1.0f) + sh[64 * j]; v2u w; w.x = pk2(h.x, h.y); w.y = pk2(h.z, h.w); o8[64 * j] = w; }
    }
}
__device__ __forceinline__ void ph_norm2_router(const Args& a, const Frame& F, int layer, bool skip_ctx) {
    const bf16* X = (const bf16*)(a.ws + WS_X); bf16* H = (bf16*)(a.ws + WS_H); float* AFF = (float*)(a.ws + WS_AFF);
    const float* MOD = (const float*)(a.ws + WS_MOD) + (size_t)layer * 9 * 6144;
    const float* g = a.in[I_N2G] + layer * 1024;
    LAS float* RWt = (LAS float*)F.lds;
    { const float* rw = a.in[I_ROUTER] + (size_t)layer * 1024 * 16; for (int i = F.tid; i < 16384; i += NT) RWt[(i & 15) * 1024 + (i >> 4)] = rw[i]; }
    BSYNC();
    const int gw = F.bid * NWAVES + F.wave, NGW = F.G * NWAVES, nrows = skip_ctx ? NLAT : MROWS;
    for (int row = gw; row < nrows; row += NGW) {
        const v2u* xr = (const v2u*)(X + (size_t)row * 1024) + F.lane;
        f32x4 v[4]; float ss = 0.f;
#pragma unroll
        for (int j = 0; j < 4; ++j) { const v2u xw = xr[64 * j]; v[j] = (f32x4){bflo(xw.x), bfhi(xw.x), bflo(xw.y), bfhi(xw.y)}; ss += (v[j].x * v[j].x + v[j].y * v[j].y) + (v[j].z * v[j].z + v[j].w * v[j].w); }
        const float rstd = rsqrtf(wave_sum(ss) * (1.f / 1024.f) + NORM_EPS);
        const int mr = row < NLAT ? (row >> 12) : 8;
        const f32x4* sh = (const f32x4*)(MOD + (size_t)mr * 6144 + 3 * 1024) + F.lane; const f32x4* sc = (const f32x4*)(MOD + (size_t)mr * 6144 + 4 * 1024) + F.lane;
        const f32x4* gg = (const f32x4*)g + F.lane;
        v2u* o8 = (v2u*)(H + (size_t)row * 1024) + F.lane;
        f32x4 h[4];
#pragma unroll
        for (int j = 0; j < 4; ++j) { h[j] = v[j] * rstd * gg[64 * j] * (sc[64 * j] + 1.0f) + sh[64 * j]; v2u w; w.x = pk2(h[j].x, h[j].y); w.y = pk2(h[j].z, h[j].w); o8[64 * j] = w; }
        float p[16];
#pragma unroll
        for (int e = 0; e < 16; ++e) { float acc = 0.f;
#pragma unroll
            for (int j = 0; j < 4; ++j) { const f32x4 r = *(const LAS f32x4*)(RWt + e * 1024 + 4 * F.lane + 256 * j); acc += (h[j].x * r.x + h[j].y * r.y) + (h[j].z * r.z + h[j].w * r.w); }
            p[e] = acc; if ((e & 3) == 3) __builtin_amdgcn_sched_barrier(0); }
        float q8[8], q4[4], q2[2], mine;
        { const bool hi = F.lane & 1;
#pragma unroll
          for (int i = 0; i < 8; ++i) { const float send = hi ? p[i] : p[i + 8], keep = hi ? p[i + 8] : p[i]; q8[i] = keep + __shfl_xor(send, 1); } }
        { const bool hi = F.lane & 2;
#pragma unroll
          for (int i = 0; i < 4; ++i) { const float send = hi ? q8[i] : q8[i + 4], keep = hi ? q8[i + 4] : q8[i]; q4[i] = keep + __shfl_xor(send, 2); } }
        { const bool hi = F.lane & 4;
#pragma unroll
          for (int i = 0; i < 2; ++i) { const float send = hi ? q4[i] : q4[i + 2], keep = hi ? q4[i + 2] : q4[i]; q2[i] = keep + __shfl_xor(send, 4); } }
        { const bool hi = F.lane & 8; const float send = hi ? q2[0] : q2[1], keep = hi ? q2[1] : q2[0]; mine = keep + __shfl_xor(send, 8); }
        mine += __shfl_xor(mine, 16); mine += __shfl_xor(mine, 32);
        float mx = mine;
#pragma unroll
        for (int m = 1; m < 16; m <<= 1) mx = fmaxf(mx, __shfl_xor(mx, m));
        const float ex = expf(mine - mx); float s = ex;
#pragma unroll
        for (int m = 1; m < 16; m <<= 1) s += __shfl_xor(s, m);
        mine = ex / s;
        const int eidx = ((F.lane & 1) << 3) | ((F.lane & 2) << 1) | ((F.lane & 4) >> 1) | ((F.lane & 8) >> 3);
        if (F.lane < 16) AFF[(size_t)row * 16 + eidx] = mine;
    }
}

__device__ __forceinline__ int wave_incl_scan(int v, int lane) {
#pragma unroll
    for (int o = 1; o < 64; o <<= 1) { const int t = __shfl_up(v, o); if (lane >= o) v += t; }
    return v;
}
__device__ __forceinline__ int block_excl_scan(int v, LAS int* tmp, const Frame& F, int& total) {
    const int incl = wave_incl_scan(v, F.lane);
    if (F.lane == 63) tmp[F.wave] = incl;
    BSYNC();
    int base = 0, tot = 0;
#pragma unroll
    for (int w = 0; w < NWAVES; ++w) { const int t = tmp[w]; base += (w < F.wave) ? t : 0; tot += t; }
    BSYNC();
    total = tot; return base + incl - v;
}
__device__ __forceinline__ void ph_select_gather(const Args& a, const Frame& F, bool skip_ctx) {
    const float* AFF = (const float*)(a.ws + WS_AFF); int* SLOT = (int*)(a.ws + WS_SLOT); float* GATE = (float*)(a.ws + WS_GATE);

    LAS int* hist = (LAS int*)F.lds;
    LAS int* tmp = hist + 256;
    LAS int* res = tmp + 16;
    LAS int* selrow = res + 16;
    int* SRCROW = (int*)(a.ws + WS_SRCROW);
    const int nprob = skip_ctx ? 128 : 256;
    for (int prob = F.bid; prob < nprob; prob += F.G) {
        const bool isx = prob < 128; const int pb = isx ? prob : prob - 128, b = pb >> 4, e = pb & 15;
        const int n = isx ? SEQ : CTXL, kcap = isx ? CAPX : CAPC, row0 = isx ? b * SEQ : NLAT + b * CTXL, slot0 = e * ROWS_E + (isx ? b * CAPX : NB * CAPX + b * CAPC);
        unsigned key[8];
#pragma unroll
        for (int j = 0; j < 8; ++j) { const int t = 8 * F.tid + j; key[j] = t < n ? __builtin_bit_cast(unsigned, AFF[(size_t)(row0 + t) * 16 + e]) : 0u; }
        unsigned prefix = 0u, mask = 0u; int rem = kcap;
        for (int pass = 3; pass >= 0; --pass) {
            const int shift = pass * 8;
            if (F.tid < 256) hist[F.tid] = 0;
            BSYNC();
#pragma unroll
            for (int j = 0; j < 8; ++j) if (8 * F.tid + j < n && (key[j] & mask) == prefix) __hip_atomic_fetch_add(&hist[(key[j] >> shift) & 255u], 1, __ATOMIC_RELAXED, __HIP_MEMORY_SCOPE_WORKGROUP);
            BSYNC();
            if (F.wave == 0) {
                const int h0 = hist[4 * F.lane], h1 = hist[4 * F.lane + 1], h2 = hist[4 * F.lane + 2], h3 = hist[4 * F.lane + 3];
                int S = h0 + h1 + h2 + h3;
#pragma unroll
                for (int o = 1; o < 64; o <<= 1) { const int t = __shfl_down(S, o); if (F.lane + o < 64) S += t; }
                const unsigned long long bal = __ballot(S >= rem);
                const int Ls = 63 - __builtin_clzll(bal);
                const int above0 = __shfl_down(S, 1);
                if (F.lane == Ls) { int above = (F.lane == 63) ? 0 : above0; int bin;
                    if (above + h3 >= rem) bin = 3; else { above += h3; if (above + h2 >= rem) bin = 2; else { above += h2; if (above + h1 >= rem) bin = 1; else { above += h1; bin = 0; } } }
                    res[0] = 4 * F.lane + bin; res[1] = rem - above; }
            }
            BSYNC();
            prefix |= (unsigned)res[0] << shift; mask |= 255u << shift; rem = res[1];
            BSYNC();
        }
        int ceq = 0;
#pragma unroll
        for (int j = 0; j < 8; ++j) ceq += (8 * F.tid + j < n && key[j] == prefix) ? 1 : 0;
        int toteq; int eqbase = block_excl_scan(ceq, tmp, F, toteq);
        int csel = 0; unsigned selm = 0u;
#pragma unroll
        for (int j = 0; j < 8; ++j) { const bool valid = 8 * F.tid + j < n; bool s = valid && key[j] > prefix;
            if (valid && key[j] == prefix) { s = eqbase < rem; ++eqbase; }
            if (s) { selm |= 1u << j; ++csel; } }
        int totsel; int sb = block_excl_scan(csel, tmp, F, totsel);
#pragma unroll
        for (int j = 0; j < 8; ++j) { const int t = 8 * F.tid + j;
            if (t < n) { const int row = row0 + t; int sl = -1;
                if (selm & (1u << j)) { sl = slot0 + sb; SRCROW[sl] = row; GATE[sl] = __builtin_bit_cast(float, key[j]); ++sb; }
                SLOT[(size_t)row * 16 + e] = sl; } }
        BSYNC();
    }
}

__device__ __forceinline__ void ph_combine(const Args& a, const Frame& F, int layer, bool last) {
    bf16* X = (bf16*)(a.ws + WS_X); const int* SLOT = (const int*)(a.ws + WS_SLOT); const bf16* YE = (const bf16*)(a.ws + WS_YE); const bf16* YEP = (const bf16*)(a.ws + WS_YEP);
    const float* MOD = (const float*)(a.ws + WS_MOD) + (size_t)layer * 9 * 6144;
    const int gw = F.bid * NWAVES + F.wave, NGW = F.G * NWAVES, nrows = last ? NLAT : MROWS;
    int myslot = gw < nrows ? SLOT[(size_t)gw * 16 + (F.lane & 15)] : -1;
    for (int row = gw; row < nrows; row += NGW) {
        const int mr = row < NLAT ? (row >> 12) : 8;
        const f32x4* g2 = (const f32x4*)(MOD + (size_t)mr * 6144 + 5 * 1024) + F.lane;
        v2u* xr = (v2u*)(X + (size_t)row * 1024) + F.lane;
        v2u xw[4]; f32x4 gv[4];
#pragma unroll
        for (int j = 0; j < 4; ++j) { xw[j] = xr[64 * j]; gv[j] = g2[64 * j]; }
        const int curslot = myslot;
        if (row + NGW < nrows) myslot = SLOT[(size_t)(row + NGW) * 16 + (F.lane & 15)];
        f32x4 acc[4];
#pragma unroll
        for (int j = 0; j < 4; ++j) acc[j] = (f32x4){0.f, 0.f, 0.f, 0.f};
        unsigned sm = (unsigned)(__ballot(curslot >= 0) & 0xFFFFull);
        while (sm) {
            const int e0 = __builtin_ctz(sm); sm &= sm - 1; const bool two = sm != 0; const int e1 = two ? __builtin_ctz(sm) : e0; if (two) sm &= sm - 1;
            const int s0 = __shfl(curslot, e0), s1 = __shfl(curslot, e1);
            if (row < NLAT) {
                const v2u* y0 = (const v2u*)(YE + (size_t)s0 * 1024) + F.lane; const v2u* y1 = (const v2u*)(YE + (size_t)s1 * 1024) + F.lane;
                v2u w0[4], w1[4];
#pragma unroll
                for (int j = 0; j < 4; ++j) { w0[j] = y0[64 * j]; w1[j] = y1[64 * j]; }
#pragma unroll
                for (int j = 0; j < 4; ++j) { acc[j].x += bflo(w0[j].x); acc[j].y += bfhi(w0[j].x); acc[j].z += bflo(w0[j].y); acc[j].w += bfhi(w0[j].y); }
                if (two) {
#pragma unroll
                    for (int j = 0; j < 4; ++j) { acc[j].x += bflo(w1[j].x); acc[j].y += bfhi(w1[j].x); acc[j].z += bflo(w1[j].y); acc[j].w += bfhi(w1[j].y); } }
            } else {
#pragma unroll
                for (int which = 0; which < 2; ++which) { if (which == 1 && !two) break; const int sl = which ? s1 : s0;
                    const size_t pr = (size_t)(sl / ROWS_E) * 256 + (sl % ROWS_E - NB * CAPX);
#pragma unroll
                    for (int kq = 0; kq < 4; ++kq) { const v2u* yp = (const v2u*)(YEP + ((size_t)kq * NE * 256 + pr) * 1024) + F.lane;
#pragma unroll
                        for (int j = 0; j < 4; ++j) { const v2u w = yp[64 * j]; acc[j].x += bflo(w.x); acc[j].y += bfhi(w.x); acc[j].z += bflo(w.y); acc[j].w += bfhi(w.y); } } }
            }
        }
        f32x4 v[4]; float ss = 0.f;
#pragma unroll
        for (int j = 0; j < 4; ++j) { const f32x4 xv = (f32x4){bflo(xw[j].x), bfhi(xw[j].x), bflo(xw[j].y), bfhi(xw[j].y)}; v[j] = xv + gv[j] * acc[j]; ss += (v[j].x * v[j].x + v[j].y * v[j].y) + (v[j].z * v[j].z + v[j].w * v[j].w); }
        if (!last) {
#pragma unroll
            for (int j = 0; j < 4; ++j) { v2u w; w.x = pk2(v[j].x, v[j].y); w.y = pk2(v[j].z, v[j].w); xr[64 * j] = w; }
            const float rstd = rsqrtf(wave_sum(ss) * (1.f / 1024.f) + NORM_EPS);
            const float* MODN = MOD + 9 * 6144;
            const f32x4* sh = (const f32x4*)(MODN + (size_t)mr * 6144 + 0 * 1024) + F.lane; const f32x4* sc = (const f32x4*)(MODN + (size_t)mr * 6144 + 1 * 1024) + F.lane;
            const f32x4* gg = (const f32x4*)(a.in[I_N1G] + (layer + 1) * 1024) + F.lane;
            v2u* o8 = (v2u*)((bf16*)(a.ws + WS_H) + (size_t)row * 1024) + F.lane;
#pragma unroll
            for (int j = 0; j < 4; ++j) { const f32x4 hh = v[j] * rstd * gg[64 * j] * (sc[64 * j] + 1.0f) + sh[64 * j]; v2u w; w.x = pk2(hh.x, hh.y); w.y = pk2(hh.z, hh.w); o8[64 * j] = w; }
        } else {
            const float rstd = rsqrtf(wave_sum(ss) * (1.f / 1024.f) + NORM_EPS);
            const f32x4* gg = (const f32x4*)a.in[I_FNG] + F.lane; f32x4* o = (f32x4*)(a.out + (size_t)row * 1024) + F.lane;
#pragma unroll
            for (int j = 0; j < 4; ++j) o[64 * j] = v[j] * rstd * gg[64 * j];
        }
    }
}
__device__ __forceinline__ int scan_row(bool perm, int b, int dir, int p) {
    if (p < CTXL) return NLAT + b * CTXL + (dir ? CTXL - 1 - p : p);
    int q = p - CTXL; if (dir) q = SEQ - 1 - q;
    const int t = perm ? ((q & 63) * 64 + (q >> 6)) : q;
    return b * SEQ + t;
}
__device__ __forceinline__ int scan_pos(bool perm, int row, int dir) {
    if (row >= NLAT) { const int t = (row - NLAT) & (CTXL - 1); return dir ? CTXL - 1 - t : t; }
    const int t = row & (SEQ - 1), q = perm ? ((t & 63) * 64 + (t >> 6)) : t;
    return CTXL + (dir ? SEQ - 1 - q : q);
}
#define CHUNK_ROWS(perm, b, dir, p0) const int row0_ = scan_row(perm, b, dir, (p0)), rstr_ = scan_row(perm, b, dir, (p0) + 1) - row0_;
constexpr int SC_QT = 0, SC_KT = 8704, SC_VT = 17408  , SC_TOT = 37888, SC_RF = 39936, SC_RAW = 41984  ;
template <int KIND> struct GlaCfg { static constexpr int LDP = KIND == 0 ? N_HG : N_GLA, NV = KIND == 0 ? 128 : 256, NVT = NV / 128, NH = KIND == 0 ? 8 : 4,
    REC_KHT = 8192, REC_VT = 16384, REC_DEC = 16384 + NV * 64, REC_X = REC_DEC + 512, REC_BYTES = REC_X + 2048, NUNITS = NB * NH * 2 * 136; };

template <int KIND  >
__device__ __forceinline__ void ph_s1_gla(const Args& a, const Frame& F) {
    typedef GlaCfg<KIND> C; constexpr int LDP = C::LDP, NVT = C::NVT;
    const bf16* P = (const bf16*)(a.ws + WS_P); bf16* OI = (bf16*)(a.ws + WS_OI); unsigned char* REC = a.ws + WS_REC;
    LAS bf16* QT = (LAS bf16*)(F.lds + SC_QT); LAS bf16* KT = (LAS bf16*)(F.lds + SC_KT); LAS bf16* VT = (LAS bf16*)(F.lds + SC_VT);
    LAS float* TOT = (LAS float*)(F.lds + SC_TOT); LAS float* RF = (LAS float*)(F.lds + SC_RF); LAS bf16* RAW = (LAS bf16*)(F.lds + SC_RAW);
    const int c = F.tid & 127, rq = F.tid >> 7, g = F.lane >> 4, i16 = F.lane & 15, w = F.wave, lr = F.tid >> 4, lcg = F.tid & 15;
    v4u wq, wk, wv[NVT]; unsigned short rrf = 0;
#define S1_DECODE(unit) const int chunk = (unit) % 136, cid = (unit) / 136, b = cid / (2 * C::NH), h = (cid >> 1) % C::NH, dir = cid & 1, p0 = chunk * 32; \
        const int qcol = h * 128, kcol = KIND == 0 ? 1024 + dir * 1024 + h * 128 : 512 + h * 128, vcol = KIND == 0 ? 3072 + h * 128 : 1024 + h * 256, ocol = h * C::NV;
#define S1_LOAD(unit) do { S1_DECODE(unit) (void)ocol; CHUNK_ROWS(KIND == 1, b, dir, p0) \
        { const bf16* pr = P + (size_t)(row0_ + lr * rstr_) * LDP + 8 * lcg; wq = *(const v4u*)(pr + qcol); wk = *(const v4u*)(pr + kcol); \
          if (dir == 0) { _Pragma("unroll") for (int vt = 0; vt < NVT; ++vt) wv[vt] = *(const v4u*)(pr + vcol + vt * 128); } } \
        if (KIND == 1) { const size_t ro = (size_t)(row0_ + (F.tid >> 4) * rstr_) * LDP; rrf = P[ro + 3072 + dir * 16 + (F.tid & 15)]; } } while (0)
    if (F.bid < C::NUNITS) S1_LOAD(F.bid);
    for (int unit = F.bid; unit < C::NUNITS; unit += F.G) {
        S1_DECODE(unit)
        (void)qcol; (void)kcol; (void)vcol; (void)ocol;
        unsigned char* rec = REC + (size_t)unit * C::REC_BYTES;
        float lbv = 0.f, w2[16], gkb = 0.f;
        if (KIND == 0) lbv = ((const float*)(a.ws + WS_LB))[h * 128 + c];
        else { gkb = a.in[I_GLA_GKB][dir * 512 + h * 128 + c];
#pragma unroll
            for (int r = 0; r < 16; ++r) w2[r] = a.in[I_GLA_W2][(dir * 16 + r) * 512 + h * 128 + c]; }
        *(LAS v4u*)(RAW + lr * 136 + 8 * lcg) = wq; *(LAS v4u*)(RAW + 4352 + lr * 136 + 8 * lcg) = wk;
        if (dir == 0) {
#pragma unroll
            for (int vt = 0; vt < NVT; ++vt) *(LAS v4u*)(RAW + (2 + vt) * 4352 + lr * 136 + 8 * lcg) = wv[vt]; }
        if (KIND == 1) RF[F.tid] = bf2f(rrf);
        BSYNC();
        unsigned short rq_[8], rk_[8], rv_[8 * NVT];
#pragma unroll
        for (int j = 0; j < 8; ++j) { const int ro = (8 * rq + j) * 136 + c; rq_[j] = RAW[ro]; rk_[j] = RAW[4352 + ro];
#pragma unroll
            for (int vt = 0; vt < NVT; ++vt) rv_[vt * 8 + j] = RAW[(2 + vt) * 4352 + ro]; }
        float qv[8], kv[8], G[8];
        {   float run = 0.f;
#pragma unroll
            for (int j = 0; j < 8; ++j) {
                float gj;
                if (KIND == 0) { const float fr = bf2f(rk_[j]); qv[j] = siluf_(bf2f(rq_[j])) * 0.08838834764831845f;
                    const float sg = sigmoidf_(fr), f = lbv + (1.0f - lbv) * sg; kv[j] = (1.0f - lbv) * (1.0f - sg); gj = __logf(f); }
                else { qv[j] = bf2f(rq_[j]) * 0.08838834764831845f; kv[j] = bf2f(rk_[j]);
                    float x = gkb; const LAS f32x4* rf = (const LAS f32x4*)(RF + (8 * rq + j) * 16);
#pragma unroll
                    for (int r4 = 0; r4 < 4; ++r4) { const f32x4 v = rf[r4]; x += v.x * w2[4 * r4] + v.y * w2[4 * r4 + 1] + v.z * w2[4 * r4 + 2] + v.w * w2[4 * r4 + 3]; }
                    gj = (fminf(x, 0.f) - __logf(1.0f + __expf(-fabsf(x)))) * (1.0f / 16.0f); }
                run += gj; G[j] = run; }
            TOT[rq * 128 + c] = run; }
        if (dir == 0) {
#pragma unroll
        for (int vt = 0; vt < NVT; ++vt) {
            v4u wv2; wv2.x = rv_[vt * 8 + 0] | ((unsigned)rv_[vt * 8 + 1] << 16); wv2.y = rv_[vt * 8 + 2] | ((unsigned)rv_[vt * 8 + 3] << 16); wv2.z = rv_[vt * 8 + 4] | ((unsigned)rv_[vt * 8 + 5] << 16); wv2.w = rv_[vt * 8 + 6] | ((unsigned)rv_[vt * 8 + 7] << 16);
            *(LAS v4u*)(VT + (vt * 128 + c) * 40 + 8 * rq) = wv2; *(v4u*)(rec + C::REC_VT + (vt * 128 + c) * 64 + rq * 16) = wv2; } }
        BSYNC();
        {   const float t0 = TOT[c], t1 = TOT[128 + c], t2 = TOT[256 + c], t3 = TOT[384 + c];
            const float pre = (rq > 0 ? t0 : 0.f) + (rq > 1 ? t1 : 0.f) + (rq > 2 ? t2 : 0.f), gend = (t0 + t1) + (t2 + t3);
            unsigned kh[8];
#pragma unroll
            for (int j = 0; j < 8; ++j) { const float Gj = pre + G[j]; const int r = 8 * rq + j;
                QT[r * 136 + c] = (bf16)f2bf(qv[j] * __expf(Gj)); KT[r * 136 + c] = (bf16)f2bf(kv[j] * __expf(fminf(-Gj, 80.f))); kh[j] = f2bf(kv[j] * __expf(gend - Gj)); }
            v4u wk2; wk2.x = kh[0] | (kh[1] << 16); wk2.y = kh[2] | (kh[3] << 16); wk2.z = kh[4] | (kh[5] << 16); wk2.w = kh[6] | (kh[7] << 16);
            *(v4u*)(rec + C::REC_KHT + c * 64 + rq * 16) = wk2;
            if (rq == 0) *(float*)(rec + C::REC_DEC + c * 4) = __expf(gend); }
        BSYNC();
        if (unit + F.G < C::NUNITS) S1_LOAD(unit + F.G);
        { const int row = F.tid >> 4, ch = F.tid & 15; *(v4u*)(rec + row * 256 + ch * 16) = *(const LAS v4u*)(QT + row * 136 + ch * 8); }
        f32x4 X00 = {0.f, 0.f, 0.f, 0.f}, X01 = X00, X11 = X00;
#pragma unroll
        for (int ks = 0; ks < 4; ++ks) {
            const bf16x8 k0 = *(const LAS bf16x8*)(KT + i16 * 136 + ks * 32 + g * 8), k1 = *(const LAS bf16x8*)(KT + (16 + i16) * 136 + ks * 32 + g * 8);
            const bf16x8 q0 = *(const LAS bf16x8*)(QT + i16 * 136 + ks * 32 + g * 8), q1 = *(const LAS bf16x8*)(QT + (16 + i16) * 136 + ks * 32 + g * 8);
            X00 = MFMA16(k0, q0, X00); X01 = MFMA16(k0, q1, X01); X11 = MFMA16(k1, q1, X11);
        }
#pragma unroll
        for (int r = 0; r < 4; ++r) if (4 * g + r > i16) { X00[r] = 0.f; X11[r] = 0.f; }
        const bf16x8 xa0 = pack8(X00, (f32x4){0.f, 0.f, 0.f, 0.f}), xa1 = pack8(X01, X11);
        if (w == 0) { v4u* xr = (v4u*)(rec + C::REC_X + F.lane * 32); xr[0] = __builtin_bit_cast(v4u, xa0); xr[1] = __builtin_bit_cast(v4u, xa1); }
        BSYNC();
    }
#undef S1_LOAD
#undef S1_DECODE
}

__device__ __forceinline__ unsigned swap16(unsigned u) { return __builtin_amdgcn_alignbit(u, u, 16); }
__device__ __forceinline__ bf16x4 rev4(v2u a) { return __builtin_bit_cast(bf16x4, (v2u){swap16(a.y), swap16(a.x)}); }
__device__ __forceinline__ bf16x8 rev8(v4u a) { return __builtin_bit_cast(bf16x8, (v4u){swap16(a.w), swap16(a.z), swap16(a.y), swap16(a.x)}); }
constexpr int S2_QT = 0, S2_KHT = 8704, S2_VT = 18944, S2_DEC = 29184, S2_XS = 29696, S2_IMG = 31744, S2_SLOT = 32768, S2_OB = 4 * 32768, S2_OBSZ = 8704;
#define S2_WAITV(n) asm volatile("s_waitcnt vmcnt(" #n ")" ::: "memory")
template <int KIND, int VAR = 0  >
__device__ __forceinline__ void ph_s2_gla(const Args& a, const Frame& F) {
    typedef GlaCfg<KIND> C;
    bf16* O = (bf16*)(a.ws + (VAR ? WS_A2 : WS_O_GLA)); const unsigned char* REC = a.ws + WS_REC;
    const int g = F.lane >> 4, i16 = F.lane & 15, w = F.wave;
    for (int chain = F.bid; chain < 128; chain += F.G) {
        int cid, vh = 0; if (KIND == 0) cid = chain; else { cid = chain >> 1; vh = chain & 1; }
        const int dir = cid & 1;
        const unsigned char* rec0 = REC + (size_t)cid * 136 * C::REC_BYTES;
        unsigned soff[8]; unsigned vmask = 0u;
        const unsigned char* recv0 = REC + (size_t)(cid & ~1) * 136 * C::REC_BYTES;
#pragma unroll
        for (int j = 0; j < 8; ++j) { const int q = 16 * ((8 * (w & 3) + j) * 64 + F.lane); int src;
            if (q < S2_KHT) { const int row = q / 272, cb = q % 272; src = row * 256 + (cb < 256 ? cb : 0); }
            else if (q < S2_VT) { const int q2 = q - S2_KHT, row = q2 / 80, cb = q2 % 80; src = C::REC_KHT + row * 64 + (cb < 64 ? cb : 0); }
            else if (q < S2_DEC) { const int q2 = q - S2_VT, row = q2 / 80, cb = q2 % 80; src = C::REC_VT + vh * 8192 + row * 64 + (cb < 64 ? cb : 0); vmask |= 1u << j; }
            else if (q < S2_XS) src = C::REC_DEC + (q - S2_DEC);
            else if (q < S2_IMG) src = C::REC_X + (q - S2_XS);
            else src = 0;
            soff[j] = (unsigned)src; }
        f32x4 S[8];
#pragma unroll
        for (int m = 0; m < 8; ++m) S[m] = (f32x4){0.f, 0.f, 0.f, 0.f};
#define S2_DMA(step) do { if (w < 4 && !(VAR & 1)) { const int st_ = (step) < 136 ? (step) : 135; const unsigned char* rc = rec0 + (size_t)st_ * C::REC_BYTES; LAS unsigned char* dst = F.lds + ((step) & 3) * S2_SLOT + w * 8192; \
        const unsigned char* rcv = dir ? recv0 + (size_t)(st_ < 8 ? 7 - st_ : 143 - st_) * C::REC_BYTES : rc;     \
        _Pragma("unroll") for (int j = 0; j < 8; ++j) __builtin_amdgcn_global_load_lds((const unsigned*)(((vmask >> j) & 1u ? rcv : rc) + soff[j]), (LAS unsigned*)(dst + j * 1024), 16, 0, 0); } } while (0)
#define S2_OSTORE(step) do { if (w >= 4 && !(VAR & 2)) { const LAS unsigned char* obuf = F.lds + S2_OB + ((step) & 1) * S2_OBSZ; \
        _Pragma("unroll") for (int k = 0; k < 2; ++k) { const int idx = (F.tid - 256) + 256 * k, row = idx >> 4, ch = idx & 15; \
            *(v4u*)(O + ((size_t)(cid * 136 + (step)) * 32 + row) * C::NV + vh * 128 + ch * 8) = *(const LAS v4u*)(obuf + row * 272 + ch * 16); } } } while (0)
#define S2_STEP(step) do { \
        S2_DMA((step) + 3); \
        if ((step) > 0) S2_OSTORE((step) - 1); \
        const LAS unsigned char* im = F.lds + ((step) & 3) * S2_SLOT; const LAS bf16* QT = (const LAS bf16*)(im + S2_QT); const LAS bf16* KHT = (const LAS bf16*)(im + S2_KHT); \
        const LAS bf16* VT = (const LAS bf16*)(im + S2_VT); const LAS float* DEC = (const LAS float*)(im + S2_DEC); \
        f32x4 O0 = {0.f, 0.f, 0.f, 0.f}, O1 = O0; \
        _Pragma("unroll") for (int ks = 0; ks < 4; ++ks) { const bf16x8 sb = pack8(S[2 * ks], S[2 * ks + 1]); \
            const bf16x8 a0 = cat8(*(const LAS bf16x4*)(QT + i16 * 136 + 32 * ks + 4 * g), *(const LAS bf16x4*)(QT + i16 * 136 + 32 * ks + 16 + 4 * g)); \
            const bf16x8 a1 = cat8(*(const LAS bf16x4*)(QT + (16 + i16) * 136 + 32 * ks + 4 * g), *(const LAS bf16x4*)(QT + (16 + i16) * 136 + 32 * ks + 16 + 4 * g)); \
            O0 = MFMA16(sb, a0, O0); O1 = MFMA16(sb, a1, O1); } \
        { const bf16x8 vbp = dir ? cat8(rev4(*(const LAS v2u*)(VT + (16 * w + i16) * 40 + 28 - 4 * g)), rev4(*(const LAS v2u*)(VT + (16 * w + i16) * 40 + 12 - 4 * g))) \
                                 : cat8(*(const LAS bf16x4*)(VT + (16 * w + i16) * 40 + 4 * g), *(const LAS bf16x4*)(VT + (16 * w + i16) * 40 + 16 + 4 * g)); \
          const LAS v4u* xs = (const LAS v4u*)(im + S2_XS + F.lane * 32); \
          O0 = MFMA16(vbp, __builtin_bit_cast(bf16x8, xs[0]), O0); O1 = MFMA16(vbp, __builtin_bit_cast(bf16x8, xs[1]), O1); }     \
        { LAS unsigned char* obuf = F.lds + S2_OB + ((step) & 1) * S2_OBSZ + (16 * w + 4 * g) * 2; \
          *(LAS v2u*)(obuf + i16 * 272) = (v2u){pk2(O0[0], O0[1]), pk2(O0[2], O0[3])}; *(LAS v2u*)(obuf + (16 + i16) * 272) = (v2u){pk2(O1[0], O1[1]), pk2(O1[2], O1[3])}; } \
        { const bf16x8 vb2 = dir ? rev8(*(const LAS v4u*)(VT + (16 * w + i16) * 40 + 24 - 8 * g)) : *(const LAS bf16x8*)(VT + (16 * w + i16) * 40 + 8 * g); \
          _Pragma("unroll") for (int m = 0; m < 8; ++m) { const f32x4 dec = *(const LAS f32x4*)(DEC + 16 * m + 4 * g); const bf16x8 ka = *(const LAS bf16x8*)(KHT + (16 * m + i16) * 40 + 8 * g); \
              S[m] = MFMA16(ka, vb2, S[m] * dec); } } \
        asm volatile("s_waitcnt lgkmcnt(0)" ::: "memory"); if (w < 4) S2_WAITV(16); if (!(VAR & 4)) __builtin_amdgcn_s_barrier(); asm volatile("" ::: "memory"); } while (0)
        S2_DMA(0); S2_DMA(1); S2_DMA(2); if (w < 4) S2_WAITV(16); __builtin_amdgcn_s_barrier(); asm volatile("" ::: "memory");
        for (int step = 0; step < 136; ++step) S2_STEP(step);
        S2_OSTORE(135);
        if (w < 4) S2_WAITV(0); BSYNC();
#undef S2_STEP
#undef S2_OSTORE
#undef S2_DMA
    }
}
constexpr int MS_CT = 0, MS_BT = 8704, MS_XT = 17408, MS_LL = 37888, MS_DTL = 38400;
constexpr int MREC_XT = 8192, MREC_EL = 24576, MREC_WS = 25088, MREC_DEND = 25600, MREC_W = 25664, MREC_BYTES = 25664 + 8192, M_NUNITS = NB * 8 * 2 * 136;
__device__ __forceinline__ void ph_s1_mamba(const Args& a, const Frame& F) {
    const bf16* XBC = (const bf16*)(a.ws + WS_XBC); const float* DT = (const float*)(a.ws + WS_DT); unsigned char* REC = a.ws + WS_REC_MB;
    LAS bf16* CT = (LAS bf16*)(F.lds + MS_CT); LAS bf16* BT = (LAS bf16*)(F.lds + MS_BT); LAS bf16* XT = (LAS bf16*)(F.lds + MS_XT);
    LAS float* LL = (LAS float*)(F.lds + MS_LL); LAS float* DTL = (LAS float*)(F.lds + MS_DTL);
    const int c = F.tid & 127, rq = F.tid >> 7, xc = F.tid & 255, rh = F.tid >> 8, g = F.lane >> 4, i16 = F.lane & 15, w = F.wave, hg = w >> 1, ph = w & 1, th = (F.tid >> 5) & 3;
    unsigned short rc_[8], rb_[8], rx_[16]; float rdt = 0.f;
#define M1_DECODE(unit) const int chunk = (unit) % 136, cid = (unit) / 136, b = cid >> 4, grp = (cid >> 1) & 7, dir = cid & 1, p0 = chunk * 32;
#define M1_LOAD(unit) do { M1_DECODE(unit) CHUNK_ROWS(false, b, dir, p0) \
        _Pragma("unroll") for (int j = 0; j < 8; ++j) { const size_t ro = (size_t)(row0_ + (8 * rq + j) * rstr_) * 4096; rb_[j] = XBC[ro + 2048 + grp * 128 + c]; rc_[j] = XBC[ro + 3072 + grp * 128 + c]; } \
        _Pragma("unroll") for (int j = 0; j < 16; ++j) { const size_t ro = (size_t)(row0_ + (16 * rh + j) * rstr_) * 4096; rx_[j] = XBC[ro + grp * 256 + xc]; } \
        if (F.tid < 128) rdt = DT[(size_t)(row0_ + (F.tid & 31) * rstr_) * 64 + dir * 32 + grp * 4 + th]; } while (0)
    if (F.bid < M_NUNITS) M1_LOAD(F.bid);
    for (int unit = F.bid; unit < M_NUNITS; unit += F.G) {
        M1_DECODE(unit)
        unsigned char* rec = REC + (size_t)unit * MREC_BYTES;
        if (F.tid < 128) {
            const float aval = -__expf(a.in[I_MB_ALOG][dir * 32 + grp * 4 + th]);
            float l = rdt * aval;
#pragma unroll
            for (int o = 1; o < 32; o <<= 1) { const float t = __shfl_up(l, o, 32); if ((F.tid & 31) >= o) l += t; }
            LL[F.tid] = l; DTL[F.tid] = rdt;
            *(float*)(rec + MREC_EL + F.tid * 4) = __expf(l);
            { const float lend_ = __shfl(l, 31, 32); *(float*)(rec + MREC_WS + F.tid * 4) = __expf(lend_ - l) * rdt; }
            if ((F.tid & 31) == 31) *(float*)(rec + MREC_DEND + th * 4) = __expf(l);
        }
        {   v4u wb;
            wb.x = rb_[0] | ((unsigned)rb_[1] << 16); wb.y = rb_[2] | ((unsigned)rb_[3] << 16); wb.z = rb_[4] | ((unsigned)rb_[5] << 16); wb.w = rb_[6] | ((unsigned)rb_[7] << 16);
            *(v4u*)(rec + c * 64 + rq * 16) = wb;
#pragma unroll
            for (int j = 0; j < 8; ++j) { BT[(8 * rq + j) * 136 + c] = rb_[j]; CT[(8 * rq + j) * 136 + c] = rc_[j]; } }
        BSYNC();
        {   unsigned xw[16];
#pragma unroll
            for (int j = 0; j < 16; ++j) xw[j] = rx_[j];
#pragma unroll
            for (int q = 0; q < 2; ++q) { v4u u0;
                u0.x = xw[8 * q] | (xw[8 * q + 1] << 16); u0.y = xw[8 * q + 2] | (xw[8 * q + 3] << 16); u0.z = xw[8 * q + 4] | (xw[8 * q + 5] << 16); u0.w = xw[8 * q + 6] | (xw[8 * q + 7] << 16);
                *(v4u*)(rec + MREC_XT + xc * 64 + rh * 32 + q * 16) = u0; } }
        BSYNC();
        if (unit + F.G < M_NUNITS) M1_LOAD(unit + F.G);
        f32x4 X00 = {0.f, 0.f, 0.f, 0.f}, X01 = X00, X11 = X00;
#pragma unroll
        for (int ks = 0; ks < 4; ++ks) {
            const bf16x8 b0 = *(const LAS bf16x8*)(BT + i16 * 136 + ks * 32 + g * 8), b1 = *(const LAS bf16x8*)(BT + (16 + i16) * 136 + ks * 32 + g * 8);
            const bf16x8 c0 = *(const LAS bf16x8*)(CT + i16 * 136 + ks * 32 + g * 8), c1 = *(const LAS bf16x8*)(CT + (16 + i16) * 136 + ks * 32 + g * 8);
            X00 = MFMA16(b0, c0, X00); X01 = MFMA16(b0, c1, X01); X11 = MFMA16(b1, c1, X11);
        }
        {   const LAS float* ll = LL + hg * 32; const LAS float* dl = DTL + hg * 32;
            const float lt0 = ll[i16], lt1 = ll[16 + i16];
            const f32x4 ls0 = *(const LAS f32x4*)(ll + 4 * g), ls1 = *(const LAS f32x4*)(ll + 16 + 4 * g), ds0 = *(const LAS f32x4*)(dl + 4 * g), ds1 = *(const LAS f32x4*)(dl + 16 + 4 * g);
#pragma unroll
            for (int r = 0; r < 4; ++r) {
                X00[r] = (4 * g + r <= i16) ? X00[r] * __expf(lt0 - ls0[r]) * ds0[r] : 0.f;
                X01[r] = X01[r] * __expf(lt1 - ls0[r]) * ds0[r];
                X11[r] = (4 * g + r <= i16) ? X11[r] * __expf(lt1 - ls1[r]) * ds1[r] : 0.f; } }
        {   const bf16x8 w0 = pack8(X00, (f32x4){0.f, 0.f, 0.f, 0.f}), w1 = pack8(X01, X11);
            if (ph == 0) { v4u* wr = (v4u*)(rec + MREC_W + hg * 2048 + F.lane * 32); wr[0] = __builtin_bit_cast(v4u, w0); wr[1] = __builtin_bit_cast(v4u, w1); } }
        BSYNC();
    }
#undef M1_LOAD
#undef M1_DECODE
}
constexpr int M2_CT = 0, M2_BTT = 8704, M2_XT = 18944, M2_EL = 39424, M2_WS = 39936, M2_DEND = 40448, M2_W = 40512, M2_IMG = 48704, M2_SLOT = 49152;
__device__ __forceinline__ void ph_s2_mamba(const Args& a, const Frame& F) {
    const bf16* XBC = (const bf16*)(a.ws + WS_XBC); bf16* O = (bf16*)(a.ws + WS_O_MB); const unsigned char* REC = a.ws + WS_REC_MB;
    const int g = F.lane >> 4, i16 = F.lane & 15, w = F.wave, hg = w >> 1, ph = w & 1;
    for (int chain = F.bid; chain < 128; chain += F.G) {
        const int b = chain >> 4, grp = (chain >> 1) & 7, dir = chain & 1;
        const unsigned char* rec0 = REC + (size_t)chain * 136 * MREC_BYTES;
        const unsigned char* xbc0 = (const unsigned char*)(XBC + 3072 + grp * 128);
        unsigned soff[12]; int crow[12];
#pragma unroll
        for (int j = 0; j < 12; ++j) { const int q = 16 * ((12 * (w & 3) + j) * 64 + F.lane); int src, cr = -1;
            if (q < M2_BTT) { cr = q / 272; const int cb = q % 272; src = cb < 256 ? cb : 0; }
            else if (q < M2_XT) { const int q2 = q - M2_BTT, row = q2 / 80, cb = q2 % 80; src = row * 64 + (cb < 64 ? cb : 0); }
            else if (q < M2_EL) { const int q2 = q - M2_XT, row = q2 / 80, cb = q2 % 80; src = MREC_XT + row * 64 + (cb < 64 ? cb : 0); }
            else if (q < M2_DEND) src = MREC_EL + (q - M2_EL);
            else if (q < M2_W) src = MREC_DEND + (q - M2_DEND);
            else if (q < M2_IMG) src = MREC_W + (q - M2_W);
            else src = 0;
            soff[j] = (unsigned)src; crow[j] = cr; }
        f32x4 S[8][2];
#pragma unroll
        for (int m = 0; m < 8; ++m) { S[m][0] = (f32x4){0.f, 0.f, 0.f, 0.f}; S[m][1] = S[m][0]; }
#define M2_DMA(step) do { if (w < 4) { const int st_ = (step) < 136 ? (step) : 135; const unsigned char* rc = rec0 + (size_t)st_ * MREC_BYTES; CHUNK_ROWS(false, b, dir, st_ * 32) \
        LAS unsigned char* dst = F.lds + ((step) % 3) * M2_SLOT + w * 12288; \
        _Pragma("unroll") for (int j = 0; j < 12; ++j) { const unsigned char* sp = crow[j] >= 0 ? xbc0 + (size_t)(row0_ + crow[j] * rstr_) * 8192 + soff[j] : rc + soff[j]; \
            __builtin_amdgcn_global_load_lds((const unsigned*)sp, (LAS unsigned*)(dst + j * 1024), 16, 0, 0); } } } while (0)
#define M2_STEP(step, NW) do { \
        M2_DMA((step) + 2); \
        const LAS unsigned char* im = F.lds + ((step) % 3) * M2_SLOT; const LAS bf16* CT = (const LAS bf16*)(im + M2_CT); const LAS bf16* BTT = (const LAS bf16*)(im + M2_BTT); \
        const LAS bf16* XT = (const LAS bf16*)(im + M2_XT); const LAS float* EL = (const LAS float*)(im + M2_EL) + hg * 32; const LAS float* WSC = (const LAS float*)(im + M2_WS) + hg * 32; \
        const float dend = ((const LAS float*)(im + M2_DEND))[hg]; \
        f32x4 Y[2][2]; \
        _Pragma("unroll") for (int ti = 0; ti < 2; ++ti) { Y[ti][0] = (f32x4){0.f, 0.f, 0.f, 0.f}; Y[ti][1] = Y[ti][0]; } \
        _Pragma("unroll") for (int ks = 0; ks < 4; ++ks) { \
            const bf16x8 a0 = cat8(*(const LAS bf16x4*)(CT + i16 * 136 + 32 * ks + 4 * g), *(const LAS bf16x4*)(CT + i16 * 136 + 32 * ks + 16 + 4 * g)); \
            const bf16x8 a1 = cat8(*(const LAS bf16x4*)(CT + (16 + i16) * 136 + 32 * ks + 4 * g), *(const LAS bf16x4*)(CT + (16 + i16) * 136 + 32 * ks + 16 + 4 * g)); \
            _Pragma("unroll") for (int nt = 0; nt < 2; ++nt) { const bf16x8 sb = pack8(S[2 * ks][nt], S[2 * ks + 1][nt]); Y[0][nt] = MFMA16(sb, a0, Y[0][nt]); Y[1][nt] = MFMA16(sb, a1, Y[1][nt]); } } \
        { const float e0 = EL[i16], e1 = EL[16 + i16]; \
          const LAS v4u* wt = (const LAS v4u*)(im + M2_W + hg * 2048 + F.lane * 32); const bf16x8 w0 = __builtin_bit_cast(bf16x8, wt[0]), w1 = __builtin_bit_cast(bf16x8, wt[1]); \
          bf16* ob = O + (size_t)(chain * 136 + (step)) * 32 * 256 + hg * 64 + ph * 32 + 4 * g; \
          _Pragma("unroll") for (int nt = 0; nt < 2; ++nt) { const LAS bf16* xr = XT + (hg * 64 + ph * 32 + nt * 16 + i16) * 40; \
              const bf16x8 vbp = cat8(*(const LAS bf16x4*)(xr + 4 * g), *(const LAS bf16x4*)(xr + 16 + 4 * g)); \
              const f32x4 y0 = MFMA16(vbp, w0, Y[0][nt] * e0), y1 = MFMA16(vbp, w1, Y[1][nt] * e1);        \
              *(v2u*)(ob + (size_t)i16 * 256 + 16 * nt) = (v2u){pk2(y0[0], y0[1]), pk2(y0[2], y0[3])}; \
              *(v2u*)(ob + (size_t)(16 + i16) * 256 + 16 * nt) = (v2u){pk2(y1[0], y1[1]), pk2(y1[2], y1[3])}; } } \
        { const f32x4 ws0 = *(const LAS f32x4*)(WSC + 8 * g), ws1 = *(const LAS f32x4*)(WSC + 8 * g + 4); \
          _Pragma("unroll") for (int nt = 0; nt < 2; ++nt) { const v4u xv = *(const LAS v4u*)(XT + (hg * 64 + ph * 32 + nt * 16 + i16) * 40 + 8 * g); \
            v4u xs; xs.x = pk2(bflo(xv.x) * ws0.x, bfhi(xv.x) * ws0.y); xs.y = pk2(bflo(xv.y) * ws0.z, bfhi(xv.y) * ws0.w); xs.z = pk2(bflo(xv.z) * ws1.x, bfhi(xv.z) * ws1.y); xs.w = pk2(bflo(xv.w) * ws1.z, bfhi(xv.w) * ws1.w); \
            const bf16x8 vb2 = __builtin_bit_cast(bf16x8, xs);                                              \
            _Pragma("unroll") for (int m = 0; m < 8; ++m) { const bf16x8 ba = *(const LAS bf16x8*)(BTT + (16 * m + i16) * 40 + 8 * g); S[m][nt] = MFMA16(ba, vb2, S[m][nt] * dend); } } } \
        asm volatile("s_waitcnt lgkmcnt(0)" ::: "memory"); if (w < 4) S2_WAITV(NW); __builtin_amdgcn_s_barrier(); asm volatile("" ::: "memory"); } while (0)
        M2_DMA(0); M2_DMA(1); if (w < 4) S2_WAITV(12); __builtin_amdgcn_s_barrier(); asm volatile("" ::: "memory");
        M2_STEP(0, 16);
        for (int step = 1; step < 136; ++step) M2_STEP(step, 20);
        if (w < 4) S2_WAITV(0); BSYNC();
#undef M2_STEP
#undef M2_DMA
    }
}
template <int HV  >
__device__ __forceinline__ void ph_post_gla(const Args& a, const Frame& F, const float* gain, int ldp, int ogcol0) {
    constexpr int NH = 1024 / HV; constexpr bool PERMUTED = HV == 256;
    const bf16* P = (const bf16*)(a.ws + WS_P); const bf16* O = (const bf16*)(a.ws + WS_O_GLA); bf16* A2 = (bf16*)(a.ws + WS_A2);
    const int gw = F.bid * NWAVES + F.wave, NGW = F.G * NWAVES;
    const int h = (16 * F.lane) / HV, cih = (16 * F.lane) % HV;
    float gn[16];
#pragma unroll
    for (int i = 0; i < 16; ++i) gn[i] = gain[cih + i];
    for (int row = gw; row < MROWS; row += NGW) {
        const int b = row < NLAT ? (row >> 12) : ((row - NLAT) >> 8);
        const int pf = scan_pos(PERMUTED, row, 0), pb = scan_pos(PERMUTED, row, 1);
        const size_t of_ = ((size_t)(((b * NH + h) * 2 + 0) * 136 + (pf >> 5)) * 32 + (pf & 31)) * HV + cih, ob_ = ((size_t)(((b * NH + h) * 2 + 1) * 136 + (pb >> 5)) * 32 + (pb & 31)) * HV + cih;
        const v4u* of = (const v4u*)(O + of_); const v4u* ob = (const v4u*)(O + ob_);
        const v4u* og = (const v4u*)(P + (size_t)row * ldp + ogcol0) + 2 * F.lane;
        float o[16], gte[16];
#pragma unroll
        for (int hh = 0; hh < 2; ++hh) { const v4u wf = of[hh], wb = ob[hh], wg = og[hh];
#pragma unroll
            for (int q = 0; q < 4; ++q) { o[8 * hh + 2 * q] = bflo(wf[q]) + bflo(wb[q]); o[8 * hh + 2 * q + 1] = bfhi(wf[q]) + bfhi(wb[q]);
                gte[8 * hh + 2 * q] = bflo(wg[q]); gte[8 * hh + 2 * q + 1] = bfhi(wg[q]); } }
        float ss = 0.f;
#pragma unroll
        for (int i = 0; i < 16; ++i) ss += o[i] * o[i];
#pragma unroll
        for (int m = 1; m < HV / 16; m <<= 1) ss += __shfl_xor(ss, m);
        const float rstd = rsqrtf(ss * (1.f / HV) + NORM_EPS);
        v4u w[2];
#pragma unroll
        for (int hh = 0; hh < 2; ++hh)
#pragma unroll
            for (int q = 0; q < 4; ++q) { const int i = 8 * hh + 2 * q; w[hh][q] = pk2(o[i] * rstd * gn[i] * siluf_(gte[i]), o[i + 1] * rstd * gn[i + 1] * siluf_(gte[i + 1])); }
        v4u* dst = (v4u*)(A2 + (size_t)row * 1024) + 2 * F.lane; dst[0] = w[0]; dst[1] = w[1];
    }
}
__device__ __forceinline__ void ph_mamba_conv(const Args& a, const Frame& F) {
    const bf16* P = (const bf16*)(a.ws + WS_P); bf16* XBC = (bf16*)(a.ws + WS_XBC); float* DT = (float*)(a.ws + WS_DT);
    const float* cw = a.in[I_MB_CW]; const float* cb = a.in[I_MB_CB]; const float* dtb = a.in[I_MB_DTB];
    const int c0 = F.tid * 8;
    float kw[5][8], bias[8];
#pragma unroll
    for (int j = 0; j < 5; ++j) { const f32x4 k0 = *(const f32x4*)(cw + j * 4096 + c0), k1 = *(const f32x4*)(cw + j * 4096 + c0 + 4);
        kw[j][0] = k0.x; kw[j][1] = k0.y; kw[j][2] = k0.z; kw[j][3] = k0.w; kw[j][4] = k1.x; kw[j][5] = k1.y; kw[j][6] = k1.z; kw[j][7] = k1.w; }
#pragma unroll
    for (int i = 0; i < 8; ++i) bias[i] = cb[c0 + i];
    const int per = (MROWS + F.G - 1) / F.G, r0 = F.bid * per, r1 = (r0 + per < MROWS) ? r0 + per : MROWS;
    if (r0 >= MROWS) return;
#define MC_LOAD(r) (*(const v4u*)(P + (size_t)((r) < 0 ? 0 : ((r) >= MROWS ? MROWS - 1 : (r))) * N_MBP + c0))
    for (int rc = r0; rc < r1; rc += 8) {
        v4u wv[12];
#pragma unroll
        for (int i = 0; i < 12; ++i) wv[i] = MC_LOAD(rc - 2 + i);
#pragma unroll
        for (int i = 0; i < 8; ++i) { const int row = rc + i; if (row >= r1) break;
            int t, L; if (row < NLAT) { t = row & (SEQ - 1); L = SEQ; } else { t = (row - NLAT) & (CTXL - 1); L = CTXL; }
            float acc[8];
#pragma unroll
            for (int e = 0; e < 8; ++e) acc[e] = bias[e];
#pragma unroll
            for (int j = 0; j < 5; ++j) if (t + j - 2 >= 0 && t + j - 2 < L) { const v4u VV = wv[i + j];
                acc[0] += bflo(VV[0]) * kw[j][0]; acc[1] += bfhi(VV[0]) * kw[j][1]; acc[2] += bflo(VV[1]) * kw[j][2]; acc[3] += bfhi(VV[1]) * kw[j][3];
                acc[4] += bflo(VV[2]) * kw[j][4]; acc[5] += bfhi(VV[2]) * kw[j][5]; acc[6] += bflo(VV[3]) * kw[j][6]; acc[7] += bfhi(VV[3]) * kw[j][7]; }
            v4u o; o.x = pk2(siluf_(acc[0]), siluf_(acc[1])); o.y = pk2(siluf_(acc[2]), siluf_(acc[3])); o.z = pk2(siluf_(acc[4]), siluf_(acc[5])); o.w = pk2(siluf_(acc[6]), siluf_(acc[7]));
            *(v4u*)(XBC + (size_t)row * 4096 + c0) = o;
            if (c0 < 64) {
#pragma unroll
                for (int e = 0; e < 8; ++e) { const float x = bf2f(P[(size_t)row * N_MBP + 4096 + c0 + e]) + dtb[c0 + e];
                    DT[(size_t)row * 64 + c0 + e] = x > 20.f ? x : log1pf(__expf(x)); }
            }
        }
    }
#undef MC_LOAD
}
__device__ __forceinline__ void ph_post_mamba(const Args& a, const Frame& F) {
    const bf16* ZB = (const bf16*)(a.ws + WS_ZB); const bf16* XBC = (const bf16*)(a.ws + WS_XBC); const bf16* O = (const bf16*)(a.ws + WS_O_MB); bf16* A2 = (bf16*)(a.ws + WS_A2);
    const float* ng = a.in[I_MB_NG]; const float dsk = a.in[I_MB_D][F.lane >> 1];
    const int gw = F.bid * NWAVES + F.wave, NGW = F.G * NWAVES;
    for (int row = gw; row < MROWS; row += NGW) {
        const int b = row < NLAT ? (row >> 12) : ((row - NLAT) >> 8), grp = F.lane >> 3, cig = (32 * F.lane) & 255;
        const int pf = scan_pos(false, row, 0), pb = scan_pos(false, row, 1);
        const size_t of_ = ((size_t)(((b * 8 + grp) * 2 + 0) * 136 + (pf >> 5)) * 32 + (pf & 31)) * 256 + cig, ob_ = ((size_t)(((b * 8 + grp) * 2 + 1) * 136 + (pb >> 5)) * 32 + (pb & 31)) * 256 + cig;
        const v4u* yf = (const v4u*)(O + of_); const v4u* yb = (const v4u*)(O + ob_);
        const v4u* xs = (const v4u*)(XBC + (size_t)row * 4096) + 4 * F.lane; const v4u* zz = (const v4u*)(ZB + (size_t)row * 2048) + 4 * F.lane;
        float y[32]; float ss = 0.f;
#pragma unroll
        for (int h = 0; h < 4; ++h) { const v4u wf = yf[h], wb = yb[h], wx = xs[h], wz = zz[h];
#pragma unroll
            for (int q = 0; q < 4; ++q) { const int i = 8 * h + 2 * q;
                y[i] = ((bflo(wf[q]) + bflo(wb[q])) + dsk * bflo(wx[q])) * siluf_(bflo(wz[q])); y[i + 1] = ((bfhi(wf[q]) + bfhi(wb[q])) + dsk * bfhi(wx[q])) * siluf_(bfhi(wz[q]));
                ss += y[i] * y[i] + y[i + 1] * y[i + 1]; } }
        ss += __shfl_xor(ss, 1); ss += __shfl_xor(ss, 2); ss += __shfl_xor(ss, 4);
        const float rstd = rsqrtf(ss * (1.f / 256.f) + NORM_EPS);
        const f32x4* gp = (const f32x4*)(ng + 32 * F.lane);
        v4u* dst = (v4u*)(A2 + (size_t)row * 2048) + 4 * F.lane;
#pragma unroll
        for (int h = 0; h < 4; ++h) { const f32x4 g0 = gp[2 * h], g1 = gp[2 * h + 1]; const int i = 8 * h;
            v4u w; w.x = pk2(y[i] * rstd * g0.x, y[i + 1] * rstd * g0.y); w.y = pk2(y[i + 2] * rstd * g0.z, y[i + 3] * rstd * g0.w);
            w.z = pk2(y[i + 4] * rstd * g1.x, y[i + 5] * rstd * g1.y); w.w = pk2(y[i + 6] * rstd * g1.z, y[i + 7] * rstd * g1.w); dst[h] = w; }
    }
}
constexpr int FFT_N = 8192;
constexpr int HY_DATA = 0, HY_Z1 = 69632;
__device__ __forceinline__ f32x2 cmul(f32x2 a, f32x2 b) { return (f32x2){a.x * b.x - a.y * b.y, a.x * b.y + a.y * b.x}; }
__device__ __forceinline__ f32x2 cmulc(f32x2 a, f32x2 b) { return (f32x2){a.x * b.x + a.y * b.y, a.y * b.x - a.x * b.y}; }
__device__ __forceinline__ f32x2 cw(float turns) { float s, c; sincospif(2.0f * turns, &s, &c); return (f32x2){c, -s}; }
__device__ __forceinline__ constexpr int FP(int i) { return i + (i >> 4); }
#define C16R(q) ((q) == 0 ? 1.0f : (q) == 1 ? 0.9238795325112867f : (q) == 2 ? 0.7071067811865476f : (q) == 3 ? 0.3826834323650898f : (q) == 4 ? 0.0f : (q) == 5 ? -0.3826834323650898f : (q) == 6 ? -0.7071067811865476f : -0.9238795325112867f)
#define C16I(q) ((q) == 0 ? 0.0f : (q) == 1 ? -0.3826834323650898f : (q) == 2 ? -0.7071067811865476f : (q) == 3 ? -0.9238795325112867f : (q) == 4 ? -1.0f : (q) == 5 ? -0.9238795325112867f : (q) == 6 ? -0.7071067811865476f : -0.3826834323650898f)
template <bool INV>
__device__ __forceinline__ void r16_pure(f32x2 (&v)[16]) {
#pragma unroll
    for (int tt = 0; tt < 4; ++tt) { const int t = INV ? 3 - tt : tt, h = 8 >> t;
#pragma unroll
        for (int k = 0; k < 16; ++k) { if (k & h) continue; const int q = (k & (h - 1)) * (8 / h);
            const f32x2 T = (f32x2){C16R(q), C16I(q)};
            if (!INV) { const f32x2 a = v[k], b = v[k + h], d = a - b; v[k] = a + b;
                v[k + h] = (q == 0) ? d : (q == 4) ? (f32x2){d.y, -d.x} : (q == 2) ? (f32x2){(d.x + d.y) * 0.7071067811865476f, (d.y - d.x) * 0.7071067811865476f}
                         : (q == 6) ? (f32x2){(d.y - d.x) * 0.7071067811865476f, -(d.x + d.y) * 0.7071067811865476f} : cmul(d, T); }
            else { const f32x2 a = v[k], u = v[k + h];
                const f32x2 b = (q == 0) ? u : (q == 4) ? (f32x2){-u.y, u.x} : (q == 2) ? (f32x2){(u.x - u.y) * 0.7071067811865476f, (u.x + u.y) * 0.7071067811865476f}
                              : (q == 6) ? (f32x2){-(u.x + u.y) * 0.7071067811865476f, (u.x - u.y) * 0.7071067811865476f} : cmulc(u, T);
                v[k] = a + b; v[k + h] = a - b; } } }
}
constexpr int HY_TW256 = 102400, HY_TW16 = 102400 + 32768;
__device__ __forceinline__ void fft_build_tw(const Frame& F) {
    LAS f32x2* t256 = (LAS f32x2*)(F.lds + HY_TW256); LAS f32x2* t16 = (LAS f32x2*)(F.lds + HY_TW16);
    for (int i = F.tid; i < 16 * 256; i += NT) { const int k = i >> 8, lo = i & 255, f = ((k & 1) << 3) | ((k & 2) << 1) | ((k & 4) >> 1) | ((k & 8) >> 3); t256[i] = cw((float)(lo * f) * (1.0f / 4096.0f)); }
    if (F.tid < 256) { const int k = F.tid >> 4, lo = F.tid & 15, f = ((k & 1) << 3) | ((k & 2) << 1) | ((k & 4) >> 1) | ((k & 8) >> 3); t16[F.tid] = cw((float)(lo * f) * (1.0f / 256.0f)); }
    BSYNC();
}
template <int S, bool INV>
__device__ __forceinline__ void fft_pass(LAS f32x2* x, int tid) {
    const int half = tid >> 8, r = tid & 255; int g0;
    const LAS f32x2* tw = S == 256 ? (const LAS f32x2*)((LAS unsigned char*)x + HY_TW256) + r : (const LAS f32x2*)((LAS unsigned char*)x + HY_TW16) + (r & 15);
    constexpr int TS = S == 256 ? 256 : 16;
    if (S == 256) { g0 = r; } else if (S == 16) { g0 = (r >> 4) * 256 + (r & 15); } else { g0 = r * 16; }
    LAS f32x2* p = x + FP(half * 4096 + g0); constexpr int PS = S == 256 ? 272 : (S == 16 ? 17 : 1);
    f32x2 v[16];
#pragma unroll
    for (int k = 0; k < 16; ++k) v[k] = p[PS * k];
    if (INV && S != 1) {
#pragma unroll
        for (int k = 1; k < 16; ++k) v[k] = cmulc(v[k], tw[k * TS]); }
    r16_pure<INV>(v);
    if (!INV && S != 1) {
#pragma unroll
        for (int k = 1; k < 16; ++k) v[k] = cmul(v[k], tw[k * TS]); }
#pragma unroll
    for (int k = 0; k < 16; ++k) p[PS * k] = v[k];
}
__device__ __forceinline__ void fft_pass1_mul(LAS f32x2* x, const unsigned* sp, int tid) {
    const int half = tid >> 8, r = tid & 255, g0 = half * 4096 + r * 16;
    LAS f32x2* p = x + FP(g0); const v4u* s4 = (const v4u*)(sp + g0);
    f32x2 v[16];
#pragma unroll
    for (int k = 0; k < 16; ++k) v[k] = p[k];
    r16_pure<false>(v);
#pragma unroll
    for (int k = 0; k < 4; ++k) { const v4u s = s4[k];
#pragma unroll
        for (int e = 0; e < 4; ++e) v[4 * k + e] = cmul(v[4 * k + e], (f32x2){bflo(s[e]), bfhi(s[e])}); }
    r16_pure<true>(v);
#pragma unroll
    for (int k = 0; k < 16; ++k) p[k] = v[k];
}
__device__ __forceinline__ float block_sum(float v, LAS float* red, const Frame& F) {
    v = wave_sum(v); if (F.lane == 0) red[F.wave] = v; BSYNC();
    float s = 0.f;
#pragma unroll
    for (int w = 0; w < NWAVES; ++w) s += red[w];
    BSYNC(); return s;
}
__device__ __forceinline__ void ph_hy_mlp(const Args& a, const Frame& F) {
    float* A3G = (float*)(a.ws + WS_A3G);
    const float* w1 = a.in[I_HY_W1]; const float* b1 = a.in[I_HY_B1]; const float* w2 = a.in[I_HY_W2]; const float* b2 = a.in[I_HY_B2];
    const float* w3 = a.in[I_HY_W3]; const float* b3 = a.in[I_HY_B3]; const float* fq = a.in[I_HY_FREQ];
    const int j = F.lane; const float freq = fq[j];
    LAS float* W1 = (LAS float*)(F.lds + 65536); LAS float* W2 = W1 + 33 * 64; LAS float* W3 = W2 + 64 * 64;
    for (int i = F.tid; i < 33 * 64; i += NT) W1[i] = w1[i];
    for (int i = F.tid; i < 64 * 64; i += NT) { W2[i] = w2[i]; W3[i] = w3[i]; }
    BSYNC();
    for (int pos = F.bid * NWAVES + F.wave; pos < SEQ + CTXL; pos += F.G * NWAVES) {
        const bool isx = pos < SEQ; const int L = isx ? SEQ : CTXL, l = isx ? pos : pos - SEQ;
        const float t = (float)l / (float)(L - 1), wl = 6.283185307179586f * (float)l / (float)L;
        float z = 0.f;
        if (j == 0) z = t; else if (j <= 16) z = cosf((1e-4f + (float)(j - 1) * ((15.0f - 1e-4f) / 15.0f)) * wl); else if (j <= 32) z = -sinf((1e-4f + (float)(j - 17) * ((15.0f - 1e-4f) / 15.0f)) * wl);
        float h = b1[j];
#pragma unroll
        for (int i = 0; i < 33; ++i) h += __shfl(z, i) * W1[i * 64 + j];
        const float a1 = sinf(freq * h);
        h = b2[j];
#pragma unroll 16
        for (int i = 0; i < 64; ++i) h += __shfl(a1, i) * W2[i * 64 + j];
        const float a2 = sinf(freq * h);
        h = b3[j];
#pragma unroll 16
        for (int i = 0; i < 64; ++i) h += __shfl(a2, i) * W3[i * 64 + j];
        A3G[(size_t)pos * 64 + j] = sinf(freq * h);
    }
}
__device__ __forceinline__ void ph_hy_filters(const Args& a, const Frame& F, int u0, int ustride, int uend) {
    float* HFT = (float*)(a.ws + WS_HFT); float* HFC = (float*)(a.ws + WS_HFC); const float* A3G = (const float*)(a.ws + WS_A3G);
    LAS float* A3 = (LAS float*)F.lds;
    typedef const __attribute__((address_space(4))) f32x4 cf32x4;
    const cf32x4* w4 = (const cf32x4*)(unsigned long long)a.in[I_HY_W4];
    for (int unit = u0; unit < uend; unit += ustride) {
        const int pb = unit >> 3, c8 = unit & 7; const bool isx = pb < 64; const int L = isx ? SEQ : CTXL, l0 = isx ? pb * 64 : (pb - 64) * 64, pos0 = pb * 64;
#pragma unroll
        for (int k = 0; k < 8; ++k) { const int idx = F.tid + NT * k; A3[(idx >> 6) * 68 + (idx & 63)] = A3G[(size_t)pos0 * 64 + idx]; }
        BSYNC();
        {
            const int l = l0 + F.lane; const float t = (float)l / (float)(L - 1);
            const int o = c8 >> 2, side = (c8 >> 1) & 1;
            for (int k = 0; k < 64; k += 4) {
                const int ch = c8 * 512 + F.wave * 64 + k, d = ch & 1023;
                f32x4 acc = {0.f, 0.f, 0.f, 0.f};
#pragma unroll 4
                for (int i = 0; i < 64; i += 4) { const f32x4 av = *(const LAS f32x4*)(A3 + F.lane * 68 + i);
                    acc += w4[(i * 4096 + ch) >> 2] * av.x; acc += w4[((i + 1) * 4096 + ch) >> 2] * av.y; acc += w4[((i + 2) * 4096 + ch) >> 2] * av.z; acc += w4[((i + 3) * 4096 + ch) >> 2] * av.w; }
#pragma unroll
                for (int e = 0; e < 4; ++e) { const float delta = fabsf(-3.0701134573253945f + (float)(d + e) * ((-15.350567286626973f + 3.0701134573253945f) / 1023.0f));
                    const float v = acc[e] * __expf(-t * delta);
                    if (isx) HFT[(((size_t)((o * 2 + side) * 64 + (l >> 6)) * 1024) + d + e) * 64 + (l & 63)] = v; else HFC[(((size_t)((o * 2 + side) * 4 + (l >> 6)) * 1024) + d + e) * 64 + (l & 63)] = v; }
            }
        }
        BSYNC();
    }
}
__device__ __forceinline__ void ph_hy_spectra(const Args& a, const Frame& F, int u0, int ustride) {
    const float* HFT = (const float*)(a.ws + WS_HFT); unsigned* SPEC = (unsigned*)(a.ws + WS_SPEC);
    LAS f32x2* x = (LAS f32x2*)(F.lds + HY_DATA); LAS float* red = (LAS float*)(F.lds + HY_Z1);
    const f32x2 wt = cw((float)F.tid * (1.0f / FFT_N)), dummy_ = (f32x2){0.f, 0.f}; (void)dummy_; fft_build_tw(F);
    for (int unit = u0; unit < 2048; unit += ustride) {
        const int o = unit >> 10, d = unit & 1023;
#define HFT_AT(side_, l_) HFT[(((size_t)((o * 2 + (side_)) * 64 + ((l_) >> 6)) * 1024) + d) * 64 + ((l_) & 63)]
        float sa = 0.f;
#pragma unroll
        for (int r = 0; r < 8; ++r) { const int i = F.tid + NT * r; const float vf = HFT_AT(0, i), vb0 = HFT_AT(1, i), vb = i ? HFT_AT(1, 4096 - i) : 0.f; sa += fabsf(vf) + fabsf(vb0);
            x[FP(i)] = (f32x2){vf + vb, 0.f}; x[FP(4096 + i)] = cmul(wt, (f32x2){C16R(r), C16I(r)}) * (vf - vb); }
        const float inv = 1.0f / block_sum(sa, red, F);
        fft_pass<256, false>(x, F.tid); BSYNC();
        fft_pass<16, false>(x, F.tid); BSYNC();
        fft_pass<1, false>(x, F.tid); BSYNC();
        unsigned* sp = SPEC + (size_t)unit * FFT_N;
#pragma unroll
        for (int r = 0; r < 16; ++r) { const int i = F.tid + NT * r; const f32x2 v = x[FP(i)] * inv; sp[i] = pk2(v.x, v.y); }
        BSYNC();
    }
#undef HFT_AT
}
__device__ __forceinline__ void ph_hy_conv(const Args& a, const Frame& F) {
    const bf16* P = (const bf16*)(a.ws + WS_P); bf16* UT = (bf16*)(a.ws + WS_UT); bf16* UTC = (bf16*)(a.ws + WS_UTC);
    const float* sw = a.in[I_HY_SW]; const float* sb = a.in[I_HY_SB];
    LAS float* tile = (LAS float*)F.lds;
    constexpr int NU = 3 * 16 * 272;
    v4u raw[3];
#define HYC_DECODE(unit) const int tix = (unit) % 272, dt = ((unit) / 272) & 15, wh = (unit) / (272 * 16), d0 = dt * 64; int b, t0, L, rowb; \
        if (tix < 256) { b = tix >> 5; t0 = (tix & 31) * 128; L = SEQ; rowb = b * SEQ; } else { b = (tix - 256) >> 1; t0 = ((tix - 256) & 1) * 128; L = CTXL; rowb = NLAT + b * CTXL; }
#define HYC_LOAD(unit) do { HYC_DECODE(unit) \
        _Pragma("unroll") for (int k = 0; k < 3; ++k) { const int idx = F.tid + NT * k, r = idx >> 3, ch = idx & 7, t = t0 - 1 + r; \
            raw[k] = (idx < 1040 && t >= 0 && t < L) ? *(const v4u*)(P + (size_t)(rowb + t) * N_HY + wh * 1024 + d0 + 8 * ch) : (v4u){0u, 0u, 0u, 0u}; } } while (0)
    if (F.bid < NU) HYC_LOAD(F.bid);
    for (int unit = F.bid; unit < NU; unit += F.G) {
        HYC_DECODE(unit)
        (void)L; (void)rowb;
#pragma unroll
        for (int k = 0; k < 3; ++k) { const int idx = F.tid + NT * k, r = idx >> 3, ch = idx & 7;
            if (idx < 1040) { LAS float* tp = tile + r * 65 + 8 * ch;
                tp[0] = bflo(raw[k].x); tp[1] = bfhi(raw[k].x); tp[2] = bflo(raw[k].y); tp[3] = bfhi(raw[k].y); tp[4] = bflo(raw[k].z); tp[5] = bfhi(raw[k].z); tp[6] = bflo(raw[k].w); tp[7] = bfhi(raw[k].w); } }
        BSYNC();
        if (unit + F.G < NU) HYC_LOAD(unit + F.G);
        {   const int dd = F.tid >> 3, tq = F.tid & 7, col = wh * 1024 + d0 + dd;
            const float k0 = sw[col], k1 = sw[3072 + col], k2 = sw[6144 + col], bb = sb[col];
            float x0 = tile[(16 * tq) * 65 + dd], x1 = tile[(16 * tq + 1) * 65 + dd]; unsigned w[8];
#pragma unroll
            for (int j = 0; j < 16; j += 2) { const float x2 = tile[(16 * tq + j + 2) * 65 + dd], x3 = tile[(16 * tq + j + 3) * 65 + dd];
                w[j >> 1] = pk2(x0 * k0 + x1 * k1 + x2 * k2 + bb, x1 * k0 + x2 * k1 + x3 * k2 + bb); x0 = x2; x1 = x3; }
            bf16* dst = (tix < 256) ? UT + ((size_t)(wh * 8 + b) * 1024 + d0 + dd) * SEQ + t0 + 16 * tq : UTC + ((size_t)(wh * 8 + b) * 1024 + d0 + dd) * CTXL + t0 + 16 * tq;
            ((v4u*)dst)[0] = (v4u){w[0], w[1], w[2], w[3]}; ((v4u*)dst)[1] = (v4u){w[4], w[5], w[6], w[7]}; }
        BSYNC();
    }
#undef HYC_LOAD
#undef HYC_DECODE
}
__device__ __forceinline__ void ph_hy_fftconv(const Args& a, const Frame& F) {
    const bf16* UT = (const bf16*)(a.ws + WS_UT); const bf16* UTC = (const bf16*)(a.ws + WS_UTC); const unsigned* SPEC = (const unsigned*)(a.ws + WS_SPEC);
    const float* HFC = (const float*)(a.ws + WS_HFC); bf16* ZT = (bf16*)(a.ws + WS_ZT); bf16* ZTC = (bf16*)(a.ws + WS_ZTC); const float* fb = a.in[I_HY_FBIAS];
    LAS f32x2* x = (LAS f32x2*)(F.lds + HY_DATA); LAS f32x2* z1 = (LAS f32x2*)(F.lds + HY_Z1);
    const f32x2 wt4 = cw((float)F.tid * (4.0f / FFT_N)), dummy_ = (f32x2){0.f, 0.f}; (void)dummy_; fft_build_tw(F);
#define HY_TW(r2, e) cmul((r2) ? (f32x2){wt4.y, -wt4.x} : wt4, (f32x2){(e) == 0 ? 1.0f : (e) == 1 ? 0.9999997058628822f : (e) == 2 ? 0.9999988234517019f : 0.9999973527669782f, \
                                                                     (e) == 0 ? 0.0f : (e) == 1 ? -0.0007669903187427045f : (e) == 2 ? -0.0015339801862847655f : -0.0023009691514258070f})
#define HY_LD4(p, t0, out) do { const v2u w_ = *(const v2u*)((p) + (t0)); out[0] = bflo(w_.x); out[1] = bfhi(w_.x); out[2] = bflo(w_.y); out[3] = bfhi(w_.y); } while (0)
    for (int d = F.bid; d < 1024; d += F.G) {
        const float bias0 = fb[d], bias1 = fb[1024 + d]; const float invn = 1.0f / FFT_N;
        const unsigned* sp0 = SPEC + (size_t)(0 * 1024 + d) * FFT_N; const unsigned* sp1 = SPEC + (size_t)(1 * 1024 + d) * FFT_N;
#pragma unroll 1
        for (int pr = 0; pr < 4; ++pr) {
            const int b1 = 2 * pr, b2 = 2 * pr + 1;
            const bf16* v1 = UT + ((size_t)(2 * 8 + b1) * 1024 + d) * SEQ; const bf16* v2 = UT + ((size_t)(2 * 8 + b2) * 1024 + d) * SEQ;
            const bf16* g1a = UT + ((size_t)(0 * 8 + b1) * 1024 + d) * SEQ; const bf16* g1b = UT + ((size_t)(0 * 8 + b2) * 1024 + d) * SEQ;
            const bf16* g2a = UT + ((size_t)(1 * 8 + b1) * 1024 + d) * SEQ; const bf16* g2b = UT + ((size_t)(1 * 8 + b2) * 1024 + d) * SEQ;
#pragma unroll
            for (int r2 = 0; r2 < 2; ++r2) { const int t0 = 4 * (F.tid + NT * r2); float a1[4], a2[4]; HY_LD4(v1, t0, a1); HY_LD4(v2, t0, a2);
#pragma unroll
                for (int e = 0; e < 4; ++e) { const f32x2 z0 = (f32x2){a1[e], a2[e]}; x[FP(t0 + e)] = z0; x[FP(t0 + e + SEQ)] = cmul(z0, HY_TW(r2, e)); } }
            BSYNC();
            fft_pass<256, false>(x, F.tid); BSYNC();
            fft_pass<16, false>(x, F.tid); BSYNC();
            fft_pass1_mul(x, sp0, F.tid); BSYNC();
            fft_pass<16, true>(x, F.tid); BSYNC();
            fft_pass<256, true>(x, F.tid); BSYNC();
#pragma unroll
            for (int r2 = 0; r2 < 2; ++r2) { const int t0 = 4 * (F.tid + NT * r2); float a1[4], a2[4], ga[4], gb[4]; HY_LD4(v1, t0, a1); HY_LD4(v2, t0, a2); HY_LD4(g1a, t0, ga); HY_LD4(g1b, t0, gb);
#pragma unroll
                for (int e = 0; e < 4; ++e) { const f32x2 wr = HY_TW(r2, e); const int t = t0 + e;
                    const f32x2 y = (x[FP(t)] + cmulc(x[FP(t + SEQ)], wr)) * invn;
                    const f32x2 zz = (f32x2){ga[e], gb[e]} * (y + (f32x2){a1[e], a2[e]} * bias0); z1[t] = zz; x[FP(t)] = zz; x[FP(t + SEQ)] = cmul(zz, wr); } }
            BSYNC();
            fft_pass<256, false>(x, F.tid); BSYNC();
            fft_pass<16, false>(x, F.tid); BSYNC();
            fft_pass1_mul(x, sp1, F.tid); BSYNC();
            fft_pass<16, true>(x, F.tid); BSYNC();
            fft_pass<256, true>(x, F.tid); BSYNC();
            bf16* o1 = ZT + ((size_t)b1 * 1024 + d) * SEQ; bf16* o2 = ZT + ((size_t)b2 * 1024 + d) * SEQ;
#pragma unroll
            for (int r2 = 0; r2 < 2; ++r2) { const int t0 = 4 * (F.tid + NT * r2); float ga[4], gb[4], za[4], zb[4]; HY_LD4(g2a, t0, ga); HY_LD4(g2b, t0, gb);
#pragma unroll
                for (int e = 0; e < 4; ++e) { const f32x2 wr = HY_TW(r2, e); const int t = t0 + e;
                    const f32x2 y = (x[FP(t)] + cmulc(x[FP(t + SEQ)], wr)) * invn;
                    const f32x2 zz = (f32x2){ga[e], gb[e]} * (y + z1[t] * bias1); za[e] = zz.x; zb[e] = zz.y; }
                *(v2u*)(o1 + t0) = (v2u){pk2(za[0], za[1]), pk2(za[2], za[3])}; *(v2u*)(o2 + t0) = (v2u){pk2(zb[0], zb[1]), pk2(zb[2], zb[3])}; }
        }
        BSYNC();
        {   LAS float* hh = (LAS float*)(F.lds + HY_DATA);
            LAS float* zc = hh + 1028;
            LAS float* zc1 = zc + 2048;
            LAS float* red = zc1 + 2048;
            { const int side = F.tid >> 8, l = F.tid & 255;
              const float h0 = HFC[(((size_t)((0 * 2 + side) * 4 + (l >> 6)) * 1024) + d) * 64 + (l & 63)], h1 = HFC[(((size_t)((1 * 2 + side) * 4 + (l >> 6)) * 1024) + d) * 64 + (l & 63)];
              const float n0 = block_sum(fabsf(h0), red, F), n1 = block_sum(fabsf(h1), red, F);
              if (side == 0) { hh[1 + 255 + l] = h0 / n0; hh[514 + 1 + 255 + l] = h1 / n1; } else if (l > 0) { hh[1 + 255 - l] = h0 / n0; hh[514 + 1 + 255 - l] = h1 / n1; }
              if (F.tid == 0) { hh[0] = 0.f; hh[514] = 0.f; } }
            for (int i = F.tid; i < 2048; i += NT) zc[i] = bf2f(UTC[((size_t)(2 * 8 + (i >> 8)) * 1024 + d) * 256 + (i & 255)]);
            BSYNC();
            const int b = F.tid >> 6, t0 = 4 * (F.tid & 63);
#pragma unroll
            for (int o = 0; o < 2; ++o) {
                const LAS float* hp = hh + o * 514 + 1 + 255 + t0; const LAS float* zin = (o == 0 ? zc : zc1) + b * 256;
                float h0 = hp[0], h1 = hp[1], h2 = hp[2], h3 = hp[3], y0 = 0.f, y1 = 0.f, y2 = 0.f, y3 = 0.f;
#pragma unroll 4
                for (int s = 0; s < 256; ++s) { const float zv = zin[s]; y0 += h0 * zv; y1 += h1 * zv; y2 += h2 * zv; y3 += h3 * zv; h3 = h2; h2 = h1; h1 = h0; h0 = hp[-1 - s]; }
                const float bias = o == 0 ? bias0 : bias1; const float yy[4] = {y0, y1, y2, y3};
                const bf16* gp = UTC + ((size_t)(o * 8 + b) * 1024 + d) * 256 + t0;
                float zz[4];
#pragma unroll
                for (int e = 0; e < 4; ++e) zz[e] = bf2f(gp[e]) * (yy[e] + zin[t0 + e] * bias);
                if (o == 0) {
#pragma unroll
                    for (int e = 0; e < 4; ++e) zc1[b * 256 + t0 + e] = zz[e]; }
                else { v2u w; w.x = pk2(zz[0], zz[1]); w.y = pk2(zz[2], zz[3]); *(v2u*)(ZTC + ((size_t)b * 1024 + d) * 256 + t0) = w; }
                BSYNC();
            }
        }
    }
}
__device__ __forceinline__ void ph_hy_transpose(const Args& a, const Frame& F) {
    const bf16* ZT = (const bf16*)(a.ws + WS_ZT); const bf16* ZTC = (const bf16*)(a.ws + WS_ZTC); bf16* A2 = (bf16*)(a.ws + WS_HYA2);
    LAS bf16* tile = (LAS bf16*)F.lds;
    for (int unit = F.bid; unit < 16 * 272; unit += F.G) {
        const int tix = unit % 272, dt = unit / 272, d0 = dt * 64;
        int b, t0, rowb; const bf16* src; int lsrc;
        if (tix < 256) { b = tix >> 5; t0 = (tix & 31) * 128; rowb = b * SEQ; src = ZT + ((size_t)b * 1024 + d0) * SEQ + t0; lsrc = SEQ; }
        else { b = (tix - 256) >> 1; t0 = ((tix - 256) & 1) * 128; rowb = NLAT + b * CTXL; src = ZTC + ((size_t)b * 1024 + d0) * CTXL + t0; lsrc = CTXL; }
#pragma unroll
        for (int k = 0; k < 2; ++k) { const int idx = F.tid + NT * k, dd = idx >> 4, ch = idx & 15; const v4u w = *(const v4u*)(src + (size_t)dd * lsrc + 8 * ch);
            LAS unsigned* tp = (LAS unsigned*)(tile + dd * 130 + 8 * ch); tp[0] = w.x; tp[1] = w.y; tp[2] = w.z; tp[3] = w.w; }
        BSYNC();
#pragma unroll
        for (int k = 0; k < 2; ++k) { const int idx = F.tid + NT * k, tt = idx >> 3, dq = idx & 7; const LAS bf16* s = tile + (8 * dq) * 130 + tt;
            v4u o; o.x = s[0] | ((unsigned)s[130] << 16); o.y = s[260] | ((unsigned)s[390] << 16); o.z = s[520] | ((unsigned)s[650] << 16); o.w = s[780] | ((unsigned)s[910] << 16);
            *(v4u*)(A2 + (size_t)(rowb + t0 + tt) * 1024 + d0 + 8 * dq) = o; }
        BSYNC();
    }
}
__device__ __forceinline__ void moe_gemm1(const Args& a, const Frame& F, int nM) {
    pg8::Gemm g{(const pg8::bf16_t*)(a.ws + WS_H), (const pg8::bf16_t*)(a.ws + WS_WGU), MG, NE * 4096, 1024, (const int*)(a.ws + WS_SRCROW)};
    GroupedOrder S{16, F.G, F.bid, nM}; EpiSwiGLU E{(bf16*)(a.ws + WS_HID)};
    pg8::gemm_phase<EpiSwiGLU, GroupedOrder, true, true, true>(F.lds, g, S, E);
}
__device__ __forceinline__ void moe_gemm2(const Args& a, const Frame& F, bool with_ctx) {
    {   pg8::Gemm g{(const pg8::bf16_t*)(a.ws + WS_HID), (const pg8::bf16_t*)(a.ws + WS_WDN), MG, NE * 1024, 2048};
        GroupedOrder S{4, F.G, F.bid, 16}; EpiDown E{(bf16*)(a.ws + WS_YE), (const float*)(a.ws + WS_GATE)};
        pg8::gemm_phase<EpiDown, GroupedOrder, true, true>(F.lds, g, S, E); }
    if (with_ctx) { pg8::Gemm g{(const pg8::bf16_t*)(a.ws + WS_HID), (const pg8::bf16_t*)(a.ws + WS_WDN), MG, NE * 1024, 512, nullptr, 2048};
        CtxQuarterOrder S{F.G, F.bid}; EpiDownPart E{(bf16*)(a.ws + WS_YEP), (const float*)(a.ws + WS_GATE)};
        pg8::gemm_phase<EpiDownPart, CtxQuarterOrder, true, true>(F.lds, g, S, E); }
}
__device__ __forceinline__ void gemm_in(const Args& a, const Frame& F, int N, const float* bias, bool mamba_split = false) {
    pg8::Gemm g{(const pg8::bf16_t*)(a.ws + WS_H), (const pg8::bf16_t*)(a.ws + WS_WIN), MROWS, N, 1024};
    pg8::StaticOrder S; S.init(MROWS, N, F.G, F.bid);
    EpiStoreBf16 E{(bf16*)(a.ws + WS_P), mamba_split ? N_MBP : N, bias, (bf16*)(a.ws + WS_ZB), 2048, mamba_split ? 8 : 0};
    pg8::gemm_phase<EpiStoreBf16, pg8::StaticOrder, true, true>(F.lds, g, S, E);
}
__device__ __forceinline__ void gemm_out(const Args& a, const Frame& F, int layer, size_t a2off, int K, const float* bias, int M = MROWS) {
    pg8::Gemm g{(const pg8::bf16_t*)(a.ws + a2off), (const pg8::bf16_t*)(a.ws + WS_WOUT), M, 1024, K};
    pg8::StaticOrder S; S.init(M, 1024, F.G, F.bid);
    EpiResid E{(bf16*)(a.ws + WS_X), (const float*)(a.ws + WS_MOD) + (size_t)layer * 9 * 6144 + 2 * 1024, bias, layer == 0 ? a.in[I_X] : nullptr, layer == 0 ? a.in[I_CTX] : nullptr};
    pg8::gemm_phase<EpiResid, pg8::StaticOrder, true, true>(F.lds, g, S, E);
}

constexpr int NPHASES = 43;
__global__ void __launch_bounds__(NT, 2) fwd_kernel(Args a0) {
    extern __shared__ __attribute__((aligned(16))) unsigned char lds_raw[];
    Frame F; F.lds = (LAS unsigned char*)lds_raw + LDSCTL_BYTES; F.tid = threadIdx.x; F.lane = F.tid & 63; F.wave = __builtin_amdgcn_readfirstlane(F.tid >> 6); F.G = gridDim.x; F.bid = blockIdx.x;
    volatile LAS unsigned* MISC = (volatile LAS unsigned*)((LAS unsigned char*)lds_raw + MISC_OFF);
    for (int u = F.tid; u < LDSCTL_BYTES / 4; u += NT) ((LAS unsigned*)lds_raw)[u] = 0u;
    __syncthreads();
    const int lo = a0.ph_lo, hi = a0.ph_hi; int rep = 0; (void)rep;
    XcdBarrier bar; bar.bar = (unsigned*)(a0.ws + WS_CTL) + CW_BAR; bar.x = 0; bar.st = nullptr;
    if (hi - lo > 1) bar = xcd_barrier_post((unsigned*)(a0.ws + WS_CTL) + CW_BAR, MISC + 8);
#ifndef PH_LO
#define PH_LO 0
#define PH_HI 1000
#endif
#ifndef PH_LO
#define PH_LO 0
#define PH_HI 1000
#endif
#ifdef DUP_LO
#ifndef S2VAR
#define S2VAR 0
#endif
#define PH(k, body) if ((k) >= PH_LO && (k) <= PH_HI && lo <= (k) && (k) < hi) { Args a = a0; { GAS unsigned char* wsg_ = (GAS unsigned char*)a0.ws; asm volatile("" : "+s"(wsg_)); a.ws = (unsigned char*)wsg_; } rep = 0; body; if ((k) >= DUP_LO && (k) <= DUP_HI) { xcd_barrier(bar); rep = 1; body; } if ((k) + 1 < hi) xcd_barrier(bar); }
#define PH4_S2() do { if (rep == 0) ph_s2_gla<0>(a, F); else (ph_s2_gla<0, S2VAR>)(a, F); } while (0)
#else
#define PH(k, body) if ((k) >= PH_LO && (k) <= PH_HI && lo <= (k) && (k) < hi) { Args a = a0; { GAS unsigned char* wsg_ = (GAS unsigned char*)a0.ws; asm volatile("" : "+s"(wsg_)); a.ws = (unsigned char*)wsg_; } body; if ((k) + 1 < hi) xcd_barrier(bar); }
#define PH4_S2() ph_s2_gla<0>(a, F)
#endif

    PH(0, { ph_prologue(a, F); ph_hy_mlp(a, F); BSYNC();
            cvt_plain(F, a.in[I_HG_WIN], 1024, N_HG, (bf16*)(a.ws + WS_WIN), N_HG); cvt_plain(F, a.in[I_HG_WOUT], 1024, 1024, (bf16*)(a.ws + WS_WOUT), 1024); });
    PH(1, ph_norm1(a, F, 0));
    PH(2, gemm_in(a, F, N_HG, nullptr));
    PH(3, { ph_s1_gla<0>(a, F); ph_hy_filters(a, F, F.bid, F.G, 544); });
    PH(4, { if (F.bid < 128 || F.G <= 128) PH4_S2(); if (rep == 0) { if (F.G < 256) ph_hy_spectra(a, F, F.bid, F.G); else if (F.bid >= 128) ph_hy_spectra(a, F, F.bid - 128, F.G - 128); } BSYNC(); cvt_moe_dyn(a, F, 0, 0); });
    PH(5, ph_post_gla<128>(a, F, a.in[I_HG_ONG], N_HG, 4096));
    PH(6, gemm_out(a, F, 0, WS_A2, 1024, nullptr));
    PH(7, ph_norm2_router(a, F, 0, false));
    PH(8, ph_select_gather(a, F, false));
    PH(9, moe_gemm1(a, F, 17));
    PH(10, moe_gemm2(a, F, true));
    PH(11, { ph_combine(a, F, 0, false); cvt_plain(F, a.in[I_HY_WIN], 1024, N_HY, (bf16*)(a.ws + WS_WIN), N_HY); cvt_plain(F, a.in[I_HY_WOUT], 1024, 1024, (bf16*)(a.ws + WS_WOUT), 1024); cvt_moe(a, F, 1, 0, 0, F.G); cvt_moe(a, F, 1, 1, 0, F.G); });
    PH(12, gemm_in(a, F, N_HY, a.in[I_HY_BIN]));
    PH(13, ph_hy_conv(a, F));
    PH(14, ph_hy_fftconv(a, F));
    PH(15, ph_hy_transpose(a, F));
    PH(16, gemm_out(a, F, 1, WS_HYA2, 1024, a.in[I_HY_BOUT]));
    PH(17, ph_norm2_router(a, F, 1, false));
    PH(18, ph_select_gather(a, F, false));
    PH(19, moe_gemm1(a, F, 17));
    PH(20, moe_gemm2(a, F, true));
    PH(21, { ph_combine(a, F, 1, false); cvt_plain(F, a.in[I_MB_WIN], 1024, N_MB_REAL, (bf16*)(a.ws + WS_WIN), N_MB); cvt_plain(F, a.in[I_MB_WOUT], 2048, 1024, (bf16*)(a.ws + WS_WOUT), 1024); });
    PH(22, gemm_in(a, F, N_MB, nullptr, true));
    PH(23, ph_mamba_conv(a, F));
    PH(24, ph_s1_mamba(a, F));
    PH(25, { ph_s2_mamba(a, F); if (F.G >= 256) { cvt_moe(a, F, 2, 0, 128, F.G - 128, 0, 7); cvt_moe(a, F, 2, 1, 128, F.G - 128, 0, 7); cvt_moe(a, F, 2, 0, 0, 128, 7, 8); cvt_moe(a, F, 2, 1, 0, 128, 7, 8); } else { cvt_moe(a, F, 2, 0, 0, F.G); cvt_moe(a, F, 2, 1, 0, F.G); } });
    PH(26, ph_post_mamba(a, F));
    PH(27, gemm_out(a, F, 2, WS_A2, 2048, nullptr));
    PH(28, ph_norm2_router(a, F, 2, false));
    PH(29, ph_select_gather(a, F, false));
    PH(30, moe_gemm1(a, F, 17));
    PH(31, moe_gemm2(a, F, true));
    PH(32, { ph_combine(a, F, 2, false); cvt_plain(F, a.in[I_GLA_WIN], 1024, N_GLA_REAL, (bf16*)(a.ws + WS_WIN), N_GLA); cvt_plain(F, a.in[I_GLA_WOUT], 1024, 1024, (bf16*)(a.ws + WS_WOUT), 1024); });
    PH(33, gemm_in(a, F, N_GLA, nullptr));
    PH(34, ph_s1_gla<1>(a, F));
    PH(35, { ph_s2_gla<1>(a, F); if (F.G >= 256) { cvt_moe(a, F, 3, 0, 128, F.G - 128, 0, 7); cvt_moe(a, F, 3, 1, 128, F.G - 128, 0, 7); cvt_moe(a, F, 3, 0, 0, 128, 7, 8); cvt_moe(a, F, 3, 1, 0, 128, 7, 8); } else { cvt_moe(a, F, 3, 0, 0, F.G); cvt_moe(a, F, 3, 1, 0, F.G); } });
    PH(36, ph_post_gla<256>(a, F, a.in[I_GLA_ONG], N_GLA, 2048));
    PH(37, gemm_out(a, F, 3, WS_A2, 1024, nullptr, NLAT));
    PH(38, ph_norm2_router(a, F, 3, true));
    PH(39, ph_select_gather(a, F, true));
    PH(40, moe_gemm1(a, F, 16));
    PH(41, moe_gemm2(a, F, false));
    PH(42, ph_combine(a, F, 3, true));
#undef PH
}

#ifndef N_LAUNCH_MODE
#define N_LAUNCH_MODE 0
#endif
extern "C" void kernel_launch(void* const* d_in, const int* in_sizes, int n_in, void* d_out, int out_size, void* d_ws, size_t ws_size, hipStream_t stream) {
    static int grid = 0;
    if (grid == 0) {
        if (n_in != N_IN || out_size != NLAT * D || ws_size < WS_END) { fprintf(stderr, "kernel_launch: unexpected shapes (n_in %d, out %d, ws %zu)\n", n_in, out_size, ws_size); grid = -1; return; }
        int dev = 0, cus = 0, per_cu = 0;
        if (hipGetDevice(&dev) != hipSuccess || hipDeviceGetAttribute(&cus, hipDeviceAttributeMultiprocessorCount, dev) != hipSuccess) { grid = -1; return; }
        if (hipFuncSetAttribute((const void*)fwd_kernel, hipFuncAttributeMaxDynamicSharedMemorySize, LDS_BYTES) != hipSuccess) { fprintf(stderr, "kernel_launch: hipFuncSetAttribute failed\n"); grid = -1; return; }
        if (hipOccupancyMaxActiveBlocksPerMultiprocessor(&per_cu, (const void*)fwd_kernel, NT, LDS_BYTES) != hipSuccess || per_cu < 1) { fprintf(stderr, "kernel_launch: occupancy query reports %d\n", per_cu); }
        (void)hipGetLastError();
        grid = cus;
    }
    if (grid < 0) return;
    (void)in_sizes;
    if (hipMemsetAsync((char*)d_ws + WS_CTL, 0, CTL_ZERO_BYTES, stream) != hipSuccess) return;
    Args a{};
    for (int i = 0; i < N_IN; ++i) a.in[i] = (const float*)d_in[i];
    a.out = (float*)d_out; a.ws = (unsigned char*)d_ws;
#if N_LAUNCH_MODE == 0
    a.ph_lo = 0; a.ph_hi = NPHASES;
    hipLaunchKernelGGL(fwd_kernel, dim3(grid), dim3(NT), LDS_BYTES, stream, a);
#else
    for (int p = 0; p < NPHASES; ++p) { a.ph_lo = p; a.ph_hi = p + 1; hipLaunchKernelGGL(fwd_kernel, dim3(grid), dim3(NT), LDS_BYTES, stream, a); }
#endif
}
```

```cpp
#include <hip/hip_runtime.h>
#include <cstdio>
#include <cstdint>
#define N_LAUNCH_MODE 0
namespace pg8 {
#define PG8_LAS __attribute__((address_space(3)))
typedef unsigned short bf16_t;
typedef short bf16x8 __attribute__((ext_vector_type(8)));
typedef float f32x4 __attribute__((ext_vector_type(4)));
typedef unsigned u32x4 __attribute__((ext_vector_type(4)));
constexpr int BM = 256, BK = 64, HALF = 128, HTB = HALF * BK * 2  , STAGE_BYTES = 8 * HTB, NXCD = 8, WGM = 4;

__host__ __device__ __forceinline__ int lds_byte(int r, int c) { const int st = (r >> 4) * 2 + (c >> 5), rr = r & 15, cc = c & 31, ob = rr * 64 + cc * 2; return st * 1024 + (ob ^ (((ob >> 9) & 1) << 5)); }
__host__ __device__ __forceinline__ void stage_rc(int b, int& R, int& C) { const int st = b / 1024, sb = b % 1024, swz = sb ^ (((sb >> 9) & 1) << 5); R = (st >> 1) * 16 + swz / 64; C = (st & 1) * 32 + (swz % 64) / 2; }
__host__ __device__ __forceinline__ int perm32(int rho) { const int n = rho >> 4, i = rho & 15; return 8 * (i >> 2) + 4 * n + (i & 3); }

struct Unit { int pm, pn; int kq = 0; };
struct Gemm { const bf16_t* A; const bf16_t* Bt; int M, N, K; const int* rowmap; int lda; };

struct StaticOrder {
    int nM, nN, nwg, G, c;
    __host__ __device__ void init(int M, int N, int G_, int c_) { nM = M / BM; nN = N / BM; nwg = nM * nN; G = G_; c = c_; }
    __host__ __device__ bool next(int i, Unit& u) const {
        const long L = (long)i * G + c; if (L >= nwg) return false;
        int wgid = (int)L; { const int q = nwg / NXCD, r = nwg % NXCD, xcd = wgid % NXCD, off = wgid / NXCD; wgid = (xcd < r ? xcd * (q + 1) : r * (q + 1) + (xcd - r) * q) + off; }
        const int nig = WGM * nN, gid = wgid / nig, fm = gid * WGM, gsz = (nM - fm) < WGM ? (nM - fm) : WGM;
        u.pm = fm + ((wgid % nig) % gsz); u.pn = (wgid % nig) / gsz; return true;
    }
    __device__ __forceinline__ void a_ready(const Unit&) const {}
    __device__ __forceinline__ void done(const Unit&) const {}
};

__device__ __forceinline__ unsigned cvt_pk_bf16(float lo, float hi) { unsigned r; asm volatile("v_cvt_pk_bf16_f32 %0, %1, %2" : "=v"(r) : "v"(lo), "v"(hi)); return r; }

template <class Epi, class Sched, bool ALIGN_EPI = false, bool SP2 = false, bool GATHER = false>
__device__ __forceinline__ void gemm_phase(PG8_LAS unsigned char* lds, const Gemm g, const Sched& S, const Epi& E) {
    const int tid = threadIdx.x, wid = __builtin_amdgcn_readfirstlane(tid >> 6), lane = tid & 63, wr = wid >> 2, wc = wid & 3, fr = lane & 15, fq = lane >> 4;
    const int K = g.K, nt = K / BK, LD = g.lda ? g.lda : g.K;
    unsigned voffA[2], voffB[2];
#pragma unroll
    for (int i = 0; i < 2; ++i) { int R, C; stage_rc(tid * 16 + i * 8192, R, C); const int Rb = Epi::PERM ? ((R & ~31) + perm32(R & 31)) : R;
        voffA[i] = (unsigned)(R * LD + C) * 2u; voffB[i] = (unsigned)(Rb * LD + C) * 2u; }
    const size_t kstep = (size_t)(BK * 2);
    const size_t hstep = (size_t)HALF * LD * 2;
    const size_t tstep = 2 * hstep;
    const unsigned ldsw = (unsigned)wid * 1024u;
    const int aoff = lds_byte(wr * 64 + fr, fq * 8), boff = lds_byte(wc * 32 + fr, fq * 8);
#define PG8_SA(b, h) (((b) * 2 + (h)) * HTB)
#define PG8_SB(b, h) ((4 + (b) * 2 + (h)) * HTB)
#define PG8_STAGE(bufoff, gbase, voff) do { _Pragma("unroll") for (int _i = 0; _i < 2; ++_i) \
        __builtin_amdgcn_global_load_lds((const unsigned*)((const char*)(gbase) + (voff)[_i]), (PG8_LAS unsigned*)(lds + (bufoff) + ldsw + _i * 8192), 16, 0, 0); } while (0)
#define PG8_LDA(dst, b, h) do { _Pragma("unroll") for (int m = 0; m < 4; ++m) _Pragma("unroll") for (int k = 0; k < 2; ++k) dst[m][k] = *(const PG8_LAS bf16x8*)(lds + PG8_SA(b, h) + aoff + m * 2048 + k * 1024); } while (0)
#define PG8_LDB(dst, b, h) do { _Pragma("unroll") for (int n = 0; n < 2; ++n) _Pragma("unroll") for (int k = 0; k < 2; ++k) dst[n][k] = *(const PG8_LAS bf16x8*)(lds + PG8_SB(b, h) + boff + n * 2048 + k * 1024); } while (0)
#define PG8_MMA(ai, bj, At, Bt) do { __builtin_amdgcn_s_setprio(1); _Pragma("unroll") for (int m = 0; m < 4; ++m) _Pragma("unroll") for (int n = 0; n < 2; ++n) _Pragma("unroll") for (int k = 0; k < 2; ++k) \
        acc[ai][bj][m][n] = __builtin_amdgcn_mfma_f32_16x16x32_bf16(Bt[n][k], At[m][k], acc[ai][bj][m][n], 0, 0, 0); __builtin_amdgcn_s_setprio(0); } while (0)
#define PG8_WAIT_V(n) asm volatile("s_waitcnt vmcnt(" #n ")" ::: "memory")
#define PG8_WAIT_L(n) asm volatile("s_waitcnt lgkmcnt(" #n ")" ::: "memory")
#define PG8_BAR __builtin_amdgcn_s_barrier()
#define PG8_SCHED __builtin_amdgcn_sched_barrier(0)
    Unit cur, nxt; int ui = 0;
    if (!S.next(0, cur)) return;
    f32x4 acc[2][2][4][2];
#pragma unroll
    for (int a = 0; a < 2; ++a)
#pragma unroll
        for (int b = 0; b < 2; ++b)
#pragma unroll
            for (int m = 0; m < 4; ++m)
#pragma unroll
                for (int n = 0; n < 2; ++n) acc[a][b][m][n] = (f32x4){0.f, 0.f, 0.f, 0.f};
    bf16x8 At[4][2], B0[2][2], B1[2][2];
    const char* cA = (const char*)g.A + (GATHER ? (size_t)0 : (size_t)cur.pm * tstep) + (size_t)cur.kq * K * 2; const char* cB = (const char*)g.Bt + (size_t)cur.pn * tstep + (size_t)cur.kq * K * 2;
    unsigned voffGC[2][2], voffGN[2][2];
#define PG8_GOFF(dst, unit) do { _Pragma("unroll") for (int h_ = 0; h_ < 2; ++h_) _Pragma("unroll") for (int i_ = 0; i_ < 2; ++i_) { int R_, C_; stage_rc(tid * 16 + i_ * 8192, R_, C_); \
        dst[h_][i_] = (unsigned)(g.rowmap[(unit).pm * BM + h_ * HALF + R_] * LD + C_) * 2u; } } while (0)
    if constexpr (GATHER) { PG8_GOFF(voffGC, cur); _Pragma("unroll") for (int h_ = 0; h_ < 2; ++h_) { voffGN[h_][0] = voffGC[h_][0]; voffGN[h_][1] = voffGC[h_][1]; } }
#define PG8_STAGE_A(bufoff, ptr, h, isnext) do { if constexpr (GATHER) { const unsigned vs_[2] = {(isnext) ? voffGN[h][0] : voffGC[h][0], (isnext) ? voffGN[h][1] : voffGC[h][1]}; PG8_STAGE(bufoff, ptr, vs_); } \
        else { PG8_STAGE(bufoff, (ptr) + (h) * hstep, voffA); } } while (0)
    S.a_ready(cur);
    if constexpr (SP2) {
        PG8_STAGE(PG8_SB(0, 0), cB, voffB); PG8_STAGE(PG8_SB(0, 1), cB + hstep, voffB); PG8_STAGE_A(PG8_SA(0, 0), cA, 0, false); PG8_STAGE_A(PG8_SA(0, 1), cA, 1, false);
        if (wr == 1) PG8_BAR;
        PG8_WAIT_V(2); PG8_BAR;
        PG8_STAGE(PG8_SB(1, 0), cB + kstep, voffB); PG8_STAGE_A(PG8_SA(1, 0), cA + kstep, 0, false); PG8_STAGE(PG8_SB(1, 1), cB + hstep + kstep, voffB);
        PG8_WAIT_V(6); PG8_BAR;
    } else {
        PG8_STAGE(PG8_SB(0, 0), cB, voffB); PG8_STAGE_A(PG8_SA(0, 0), cA, 0, false); PG8_STAGE(PG8_SB(0, 1), cB + hstep, voffB); PG8_STAGE_A(PG8_SA(0, 1), cA, 1, false);
        if (wr == 1) PG8_BAR;
        PG8_WAIT_V(4); PG8_BAR;
        PG8_STAGE(PG8_SB(1, 0), cB + kstep, voffB); PG8_STAGE_A(PG8_SA(1, 0), cA + kstep, 0, false); PG8_STAGE(PG8_SB(1, 1), cB + hstep + kstep, voffB);
        PG8_WAIT_V(6); PG8_BAR;
    }
    for (;;) {
        const bool has_next = S.next(ui + 1, nxt);
        const char* nA = GATHER ? cA : (has_next ? (const char*)g.A + (size_t)nxt.pm * tstep + (size_t)nxt.kq * K * 2 : cA);
        if constexpr (GATHER) { if (has_next) PG8_GOFF(voffGN, nxt); } const char* nB = has_next ? (const char*)g.Bt + (size_t)nxt.pn * tstep + (size_t)nxt.kq * K * 2 : cB;
        for (int t = 0; t < nt; t += 2) {
            const bool last = (t == nt - 2);
            const char* a1 = cA + (size_t)(t + 1) * kstep;
            const char* a2 = last ? nA : cA + (size_t)(t + 2) * kstep; const char* b2 = last ? nB : cB + (size_t)(t + 2) * kstep;
            const char* a3 = a2 + kstep; const char* b3 = b2 + kstep;
            if (last && has_next) S.a_ready(nxt);
            if constexpr (SP2) {
            PG8_LDB(B0, 0, 0); PG8_LDB(B1, 0, 1); PG8_SCHED; PG8_LDA(At, 0, 0); PG8_STAGE_A(PG8_SA(1, 1), a1, 1, false);
            PG8_WAIT_V(8); PG8_WAIT_L(0); PG8_BAR; PG8_MMA(0, 0, At, B0); PG8_MMA(0, 1, At, B1); PG8_BAR; PG8_SCHED;
            PG8_LDA(At, 0, 1); PG8_STAGE(PG8_SB(0, 0), b2, voffB); PG8_STAGE(PG8_SB(0, 1), b2 + hstep, voffB); PG8_STAGE_A(PG8_SA(0, 0), a2, 0, last);
            PG8_WAIT_V(8); PG8_WAIT_L(0); PG8_BAR; PG8_MMA(1, 0, At, B0); PG8_MMA(1, 1, At, B1); PG8_BAR; PG8_SCHED;
            PG8_LDB(B0, 1, 0); PG8_LDB(B1, 1, 1); PG8_SCHED; PG8_LDA(At, 1, 0); PG8_STAGE_A(PG8_SA(0, 1), a2, 1, last);
            PG8_WAIT_V(8); PG8_WAIT_L(0); PG8_BAR; PG8_MMA(0, 0, At, B0); PG8_MMA(0, 1, At, B1); PG8_BAR; PG8_SCHED;
            PG8_LDA(At, 1, 1); PG8_STAGE(PG8_SB(1, 0), b3, voffB); PG8_STAGE(PG8_SB(1, 1), b3 + hstep, voffB); PG8_STAGE_A(PG8_SA(1, 0), a3, 0, last);
            PG8_WAIT_V(8); PG8_WAIT_L(0); PG8_BAR; PG8_MMA(1, 0, At, B0); PG8_MMA(1, 1, At, B1); PG8_BAR; PG8_SCHED;
            } else {
            PG8_LDB(B0, 0, 0); PG8_SCHED; PG8_LDA(At, 0, 0); PG8_STAGE_A(PG8_SA(1, 1), a1, 1, false);
            PG8_WAIT_L(8); PG8_BAR; PG8_WAIT_L(0); PG8_MMA(0, 0, At, B0); PG8_BAR; PG8_SCHED;
            PG8_LDB(B1, 0, 1); PG8_STAGE(PG8_SB(0, 0), b2, voffB);
            PG8_BAR; PG8_WAIT_L(0); PG8_MMA(0, 1, At, B1); PG8_BAR;
            PG8_LDA(At, 0, 1); PG8_STAGE_A(PG8_SA(0, 0), a2, 0, last);
            PG8_BAR; PG8_WAIT_L(0); PG8_MMA(1, 0, At, B0); PG8_BAR; PG8_SCHED;
            PG8_STAGE(PG8_SB(0, 1), b2 + hstep, voffB);
            PG8_WAIT_V(6); PG8_BAR; PG8_MMA(1, 1, At, B1); PG8_BAR;
            PG8_LDB(B0, 1, 0); PG8_SCHED; PG8_LDA(At, 1, 0); PG8_STAGE_A(PG8_SA(0, 1), a2, 1, last);
            PG8_WAIT_L(8); PG8_BAR; PG8_WAIT_L(0); PG8_MMA(0, 0, At, B0); PG8_BAR; PG8_SCHED;
            PG8_LDB(B1, 1, 1); PG8_STAGE(PG8_SB(1, 0), b3, voffB);
            PG8_BAR; PG8_WAIT_L(0); PG8_MMA(0, 1, At, B1); PG8_BAR;
            PG8_LDA(At, 1, 1); PG8_STAGE_A(PG8_SA(1, 0), a3, 0, last);
            PG8_BAR; PG8_WAIT_L(0); PG8_MMA(1, 0, At, B0); PG8_BAR; PG8_SCHED;
            PG8_STAGE(PG8_SB(1, 1), b3 + hstep, voffB);
            PG8_WAIT_V(6); PG8_BAR; PG8_MMA(1, 1, At, B1); PG8_BAR;
            }
        }
        if constexpr (ALIGN_EPI) { if (wr == 0) PG8_BAR; }
        if constexpr (!Epi::AFTER_DRAIN) { E(acc, cur, wr, wc, fr, fq); S.done(cur); }
        if (!has_next) break;
#pragma unroll
        for (int a = 0; a < 2; ++a)
#pragma unroll
            for (int b = 0; b < 2; ++b)
#pragma unroll
                for (int m = 0; m < 4; ++m)
#pragma unroll
                    for (int n = 0; n < 2; ++n) acc[a][b][m][n] = (f32x4){0.f, 0.f, 0.f, 0.f};
        cur = nxt; cA = nA; cB = nB; ++ui;
        if constexpr (GATHER) { _Pragma("unroll") for (int h_ = 0; h_ < 2; ++h_) { voffGC[h_][0] = voffGN[h_][0]; voffGC[h_][1] = voffGN[h_][1]; } }
        if constexpr (ALIGN_EPI) { if (wr == 1) PG8_BAR; }
    }
    PG8_WAIT_V(0);
    if constexpr (!ALIGN_EPI) { if (wr == 0) PG8_BAR; }
    PG8_BAR;
    if constexpr (Epi::AFTER_DRAIN) { E.fused(acc, cur, wr, wc, fr, fq, lds, wid, lane); S.done(cur); }
#undef PG8_SA
#undef PG8_SB
#undef PG8_STAGE
#undef PG8_STAGE_A
#undef PG8_GOFF
#undef PG8_LDA
#undef PG8_LDB
#undef PG8_MMA
#undef PG8_WAIT_V
#undef PG8_WAIT_L
#undef PG8_BAR
#undef PG8_SCHED
}
}
#define GAS __attribute__((address_space(1)))
#define LAS __attribute__((address_space(3)))
typedef unsigned short bf16;
typedef unsigned v4u __attribute__((ext_vector_type(4)));
typedef unsigned v2u __attribute__((ext_vector_type(2)));
typedef float f32x4 __attribute__((ext_vector_type(4)));
typedef float f32x2 __attribute__((ext_vector_type(2)));
typedef short bf16x8 __attribute__((ext_vector_type(8)));
typedef short bf16x4 __attribute__((ext_vector_type(4)));
#define RLX_AGENT __ATOMIC_RELAXED, __HIP_MEMORY_SCOPE_AGENT
#define LDS_WAIT() asm volatile("s_waitcnt lgkmcnt(0)" ::: "memory")
#define VM_WAIT() asm volatile("s_waitcnt vmcnt(0)" ::: "memory")

constexpr int NT = 512, NWAVES = 8;
constexpr int D = 1024, NB = 8, SEQ = 4096, CTXL = 256;
constexpr int NLAT = NB * SEQ, NCTX = NB * CTXL, MROWS = NLAT + NCTX;
constexpr int NE = 16, FF = 2048, CAPX = 512, CAPC = 32, ROWS_E = NB * CAPX + NB * CAPC  , MG = NE * ROWS_E  ;
constexpr float NORM_EPS = 1e-6f;
constexpr int N_HG = 5120, N_HY = 3072, N_MB = 6400  , N_MB_REAL = 6208, N_MBP = 4352  , N_GLA = 3328  , N_GLA_REAL = 3104;

enum { I_X = 0, I_C, I_CTX, I_CCTX, I_ADA_W, I_ADA_B, I_N1G, I_N2G, I_HG_WIN, I_HG_LB, I_HG_ONG, I_HG_WOUT,
       I_HY_WIN, I_HY_BIN, I_HY_SW, I_HY_SB, I_HY_W1, I_HY_B1, I_HY_W2, I_HY_B2, I_HY_W3, I_HY_B3, I_HY_W4, I_HY_FREQ, I_HY_FBIAS, I_HY_WOUT, I_HY_BOUT,
       I_MB_WIN, I_MB_CW, I_MB_CB, I_MB_DTB, I_MB_ALOG, I_MB_D, I_MB_NG, I_MB_WOUT,
       I_GLA_WIN, I_GLA_W2, I_GLA_GKB, I_GLA_ONG, I_GLA_WOUT, I_ROUTER, I_MOE_G, I_MOE_U, I_MOE_D, I_FNG, N_IN };

constexpr size_t MiB = 1ull << 20;
constexpr size_t WS_CTL = 0, CTL_ZERO_BYTES = 1 * MiB;
constexpr size_t WS_MOD = 1 * MiB;
constexpr size_t WS_LB = WS_MOD + 4ull * 9 * 6144 * 4;
constexpr size_t WS_X = 2 * MiB;
constexpr size_t WS_H = 138 * MiB;
constexpr size_t WS_WIN = 206 * MiB;
constexpr size_t WS_WOUT = 219 * MiB;
constexpr size_t WS_WGU = 223 * MiB;
constexpr size_t WS_WDN = 351 * MiB;
constexpr size_t WS_AFF = 415 * MiB;
constexpr size_t WS_SLOT = 418 * MiB;
constexpr size_t WS_GATE = 421 * MiB;
constexpr size_t WS_SRCROW = 422 * MiB;
constexpr size_t WS_BIG = 424 * MiB;
constexpr size_t WS_P = WS_BIG;
constexpr size_t WS_XBC = WS_BIG + 426 * MiB;
constexpr size_t WS_REC = WS_BIG + 426 * MiB;
constexpr size_t WS_REC_MB = WS_BIG + 837 * MiB;
constexpr size_t WS_O_MB = WS_BIG;
constexpr size_t WS_ZB = WS_BIG + 700 * MiB;
constexpr size_t WS_O = WS_BIG + 850 * MiB;
constexpr size_t WS_OI = WS_BIG + 1124 * MiB;
constexpr size_t WS_O_GLA = WS_BIG + 1124 * MiB;
constexpr size_t WS_A2 = WS_BIG + 1400 * MiB;
constexpr size_t WS_DT = WS_BIG + 1540 * MiB;
constexpr size_t WS_UT = WS_BIG + 426 * MiB;
constexpr size_t WS_UTC = WS_BIG + 810 * MiB;
constexpr size_t WS_HFT = WS_BIG + 1552 * MiB;
constexpr size_t WS_HFC = WS_BIG + 1616 * MiB;
constexpr size_t WS_A3G = WS_BIG + 1620 * MiB;
constexpr size_t WS_SPEC = WS_BIG + 1270 * MiB;
constexpr size_t WS_ZT = WS_BIG + 1040 * MiB;
constexpr size_t WS_ZTC = WS_BIG + 1168 * MiB;
constexpr size_t WS_HYA2 = WS_BIG + 1180 * MiB;
constexpr size_t WS_YEP = WS_BIG;
constexpr size_t WS_HID = WS_BIG + 136 * MiB;
constexpr size_t WS_YE = WS_BIG + 408 * MiB;
constexpr size_t WS_END = WS_BIG + 1624 * MiB;

constexpr int CW_CVT = 1024;
constexpr int CW_BAR = 4096;

constexpr int LDS_BYTES = 163840, LDSCTL_BYTES = 512, MISC_OFF = 320;

__device__ __forceinline__ unsigned f2bf(float f) { return (unsigned)__builtin_bit_cast(unsigned short, (__bf16)f); }
typedef __bf16 bf16x2_t __attribute__((ext_vector_type(2)));
__device__ __forceinline__ unsigned pk2(float lo, float hi) { const f32x2 v = {lo, hi}; return __builtin_bit_cast(unsigned, __builtin_convertvector(v, bf16x2_t)); }
__device__ __forceinline__ float bf2f(unsigned b) { return __builtin_bit_cast(float, b << 16); }
__device__ __forceinline__ float bflo(unsigned w) { return __builtin_bit_cast(float, w << 16); }
__device__ __forceinline__ float bfhi(unsigned w) { return __builtin_bit_cast(float, w & 0xffff0000u); }
__device__ __forceinline__ float sigmoidf_(float x) { return __builtin_amdgcn_rcpf(1.0f + __expf(-x)); }
__device__ __forceinline__ float siluf_(float x) { return x * __builtin_amdgcn_rcpf(1.0f + __expf(-x)); }
__device__ __forceinline__ float wave_sum(float v) {
#pragma unroll
    for (int o = 1; o < 64; o <<= 1) v += __shfl_xor(v, o);
    return v;
}
__device__ __forceinline__ bf16x8 pack8(f32x4 a, f32x4 b) {
    v4u w; w.x = pk2(a[0], a[1]); w.y = pk2(a[2], a[3]); w.z = pk2(b[0], b[1]); w.w = pk2(b[2], b[3]);
    return __builtin_bit_cast(bf16x8, w);
}
__device__ __forceinline__ bf16x8 cat8(bf16x4 lo, bf16x4 hi) { return __builtin_shufflevector(lo, hi, 0, 1, 2, 3, 4, 5, 6, 7); }
#define MFMA16(a, b, c) __builtin_amdgcn_mfma_f32_16x16x32_bf16((a), (b), (c), 0, 0, 0)

struct Args { const float* in[N_IN]; float* out; unsigned char* ws; int ph_lo, ph_hi; };
struct Frame { LAS unsigned char* lds; int tid, lane, wave, G, bid; };

struct EpiStoreBf16 {
    static constexpr bool PERM = true, AFTER_DRAIN = false;
    bf16* O; int ldc; const float* bias; bf16* O2; int ldc2, split_pn;
    __device__ __forceinline__ void operator()(const pg8::f32x4 (&acc)[2][2][4][2], const pg8::Unit& u, int wr, int wc, int fr, int fq) const {
        const int row0 = u.pm * 256 + wr * 64 + fr, col0 = u.pn * 256 + wc * 32 + 8 * fq;
        const bool lo = u.pn < split_pn; bf16* base = lo ? O2 : O; const int ld = lo ? ldc2 : ldc, ocol0 = lo ? col0 : col0 - 256 * split_pn;
        f32x4 bv[2][2];
#pragma unroll
        for (int bj = 0; bj < 2; ++bj)
#pragma unroll
            for (int n = 0; n < 2; ++n) bv[bj][n] = bias ? *(const f32x4*)(bias + col0 + bj * 128 + 4 * n) : (f32x4){0.f, 0.f, 0.f, 0.f};
#pragma unroll
        for (int ai = 0; ai < 2; ++ai)
#pragma unroll
            for (int m = 0; m < 4; ++m) { bf16* rowp = base + (size_t)(row0 + ai * 128 + m * 16) * ld + ocol0;
#pragma unroll
                for (int bj = 0; bj < 2; ++bj) { const f32x4 v0 = acc[ai][bj][m][0] + bv[bj][0], v1 = acc[ai][bj][m][1] + bv[bj][1];
                    v4u w; w.x = pk2(v0[0], v0[1]); w.y = pk2(v0[2], v0[3]); w.z = pk2(v1[0], v1[1]); w.w = pk2(v1[2], v1[3]);
                    *(v4u*)(rowp + bj * 128) = w; } }
    }
};
struct EpiResid {
    static constexpr bool PERM = false, AFTER_DRAIN = false;
    bf16* X; const float* gate  ; const float* bias; const float* xin; const float* cin;
    __device__ __forceinline__ void operator()(const pg8::f32x4 (&acc)[2][2][4][2], const pg8::Unit& u, int wr, int wc, int fr, int fq) const {
        const int row0 = u.pm * 256 + wr * 64 + fr, col0 = u.pn * 256 + wc * 32 + 4 * fq;
        const int modrow = u.pm < 128 ? (u.pm >> 4) : 8;
        const float* gp = gate + (size_t)modrow * 6144 + col0;
        f32x4 gv[2][2], bv[2][2];
#pragma unroll
        for (int bj = 0; bj < 2; ++bj)
#pragma unroll
            for (int n = 0; n < 2; ++n) { gv[bj][n] = *(const f32x4*)(gp + bj * 128 + n * 16); bv[bj][n] = bias ? *(const f32x4*)(bias + col0 + bj * 128 + n * 16) : (f32x4){0.f, 0.f, 0.f, 0.f}; }
#pragma unroll
        for (int ai = 0; ai < 2; ++ai)
#pragma unroll
            for (int m = 0; m < 4; ++m) { const int r = row0 + ai * 128 + m * 16; bf16* rowp = X + (size_t)r * 1024 + col0;
                const float* srcp = xin ? (u.pm < 128 ? xin + (size_t)r * 1024 + col0 : cin + (size_t)(r - NLAT) * 1024 + col0) : nullptr;
#pragma unroll
                for (int bj = 0; bj < 2; ++bj)
#pragma unroll
                    for (int n = 0; n < 2; ++n) { f32x4 res;
                        if (xin) res = *(const f32x4*)(srcp + bj * 128 + n * 16);
                        else { const v2u w = *(const v2u*)(rowp + bj * 128 + n * 16); res = (f32x4){bflo(w.x), bfhi(w.x), bflo(w.y), bfhi(w.y)}; }
                        const f32x4 o = res + gv[bj][n] * (acc[ai][bj][m][n] + bv[bj][n]);
                        v2u wo; wo.x = pk2(o[0], o[1]); wo.y = pk2(o[2], o[3]); *(v2u*)(rowp + bj * 128 + n * 16) = wo; } }
    }
};
struct EpiSwiGLU {
    static constexpr bool PERM = true, AFTER_DRAIN = false;
    bf16* HID;
    __device__ __forceinline__ void operator()(const pg8::f32x4 (&acc)[2][2][4][2], const pg8::Unit& u, int wr, int wc, int fr, int fq) const {
        const int row0 = u.pm * 256 + wr * 64 + fr, col0 = (u.pn & 15) * 128 + wc * 32 + 8 * fq;
#pragma unroll
        for (int ai = 0; ai < 2; ++ai)
#pragma unroll
            for (int m = 0; m < 4; ++m) { bf16* rowp = HID + (size_t)(row0 + ai * 128 + m * 16) * 2048 + col0;
                f32x4 h0, h1;
#pragma unroll
                for (int j = 0; j < 4; ++j) { h0[j] = siluf_(acc[ai][0][m][0][j]) * acc[ai][1][m][0][j]; h1[j] = siluf_(acc[ai][0][m][1][j]) * acc[ai][1][m][1][j]; }
                v4u w; w.x = pk2(h0[0], h0[1]); w.y = pk2(h0[2], h0[3]); w.z = pk2(h1[0], h1[1]); w.w = pk2(h1[2], h1[3]);
                *(v4u*)rowp = w; }
    }
};
struct EpiDown {
    static constexpr bool PERM = true, AFTER_DRAIN = false;
    bf16* YE; const float* GATE;
    __device__ __forceinline__ void operator()(const pg8::f32x4 (&acc)[2][2][4][2], const pg8::Unit& u, int wr, int wc, int fr, int fq) const {
        const int row0 = u.pm * 256 + wr * 64 + fr, col0 = (u.pn & 3) * 256 + wc * 32 + 8 * fq;
#pragma unroll
        for (int ai = 0; ai < 2; ++ai)
#pragma unroll
            for (int m = 0; m < 4; ++m) { const int r = row0 + ai * 128 + m * 16; const float gt = GATE[r]; bf16* rowp = YE + (size_t)r * 1024 + col0;
#pragma unroll
                for (int bj = 0; bj < 2; ++bj) { const f32x4 v0 = acc[ai][bj][m][0] * gt, v1 = acc[ai][bj][m][1] * gt;
                    v4u w; w.x = pk2(v0[0], v0[1]); w.y = pk2(v0[2], v0[3]); w.z = pk2(v1[0], v1[1]); w.w = pk2(v1[2], v1[3]);
                    *(v4u*)(rowp + bj * 128) = w; } }
    }
};
struct EpiDownPart {
    static constexpr bool PERM = true, AFTER_DRAIN = false;
    bf16* YEP; const float* GATE;
    __device__ __forceinline__ void operator()(const pg8::f32x4 (&acc)[2][2][4][2], const pg8::Unit& u, int wr, int wc, int fr, int fq) const {
        const int e = u.pn >> 2, lrow0 = wr * 64 + fr, col0 = (u.pn & 3) * 256 + wc * 32 + 8 * fq;
#pragma unroll
        for (int ai = 0; ai < 2; ++ai)
#pragma unroll
            for (int m = 0; m < 4; ++m) { const int lr = lrow0 + ai * 128 + m * 16; const float gt = GATE[u.pm * 256 + lr]; bf16* rowp = YEP + ((size_t)(u.kq * NE + e) * 256 + lr) * 1024 + col0;
#pragma unroll
                for (int bj = 0; bj < 2; ++bj) { const f32x4 v0 = acc[ai][bj][m][0] * gt, v1 = acc[ai][bj][m][1] * gt;
                    v4u w; w.x = pk2(v0[0], v0[1]); w.y = pk2(v0[2], v0[3]); w.z = pk2(v1[0], v1[1]); w.w = pk2(v1[2], v1[3]);
                    *(v4u*)(rowp + bj * 128) = w; } }
    }
};
struct CtxQuarterOrder {
    int G, c;
    __device__ __forceinline__ bool next(int i, pg8::Unit& u) const {
        const int L = i * G + c; if (L >= 256) return false;
        const int e = L >> 4, r = L & 15; u.pm = e * 17 + 16; u.pn = e * 4 + (r >> 2); u.kq = r & 3; return true;
    }
    __device__ __forceinline__ void a_ready(const pg8::Unit&) const {}
    __device__ __forceinline__ void done(const pg8::Unit&) const {}
};
struct GroupedOrder {
    int nN, G, c, nM;
    __device__ __forceinline__ bool next(int i, pg8::Unit& u) const {
        const int nwg = NE * nM * nN; int L = i * G + c; if (L >= nwg) return false;
        { const int q = nwg / 8, r = nwg % 8, xcd = L % 8, off = L / 8; L = (xcd < r ? xcd * (q + 1) : r * (q + 1) + (xcd - r) * q) + off; }
        const int per = nM * nN, e = L / per, r = L % per; int jn, im;
        if (nN == 16) { const int jg = r / (8 * nM), r2 = r % (8 * nM); im = r2 >> 3; jn = jg * 8 + (r2 & 7); }
        else { im = r / nN; jn = r % nN; }
        u.pm = e * 17 + im; u.pn = e * nN + jn; u.kq = 0; return true;
    }
    __device__ __forceinline__ void a_ready(const pg8::Unit&) const {}
    __device__ __forceinline__ void done(const pg8::Unit&) const {}
};
#define XB_TMO      128
#define XB_XCNT(j)  (256  + 64 * (j))
#define XB_XSUB(j)  (1280 + 64 * (j))
#define XB_XGEN(j)  (2304 + 64 * (j))
#define XB_TOP      3328
#define XB_TOPGEN   3392
#define XCD_BAR_WORDS 3456
#define XB_SPIN_CAP (1u << 18)

__device__ __forceinline__ unsigned xb_ld(unsigned* p)              { return __hip_atomic_load(p, __ATOMIC_RELAXED, __HIP_MEMORY_SCOPE_AGENT); }
__device__ __forceinline__ unsigned xb_add(unsigned* p, unsigned v) { return __hip_atomic_fetch_add(p, v, __ATOMIC_RELAXED, __HIP_MEMORY_SCOPE_AGENT); }
__device__ __forceinline__ unsigned xb_xcc_id() { return (unsigned)__builtin_amdgcn_s_getreg((3 << 11) | 20) & 0xFu; }
#define XB_SPIN(cond, bar) do { unsigned _sp = 0; while (cond) { __builtin_amdgcn_s_sleep(1); \
    if ((++_sp & 255u) == 0u) { if (xb_ld(&(bar)[XB_TMO])) break; if (_sp > XB_SPIN_CAP) { atomicAdd(&(bar)[XB_TMO], 1u); break; } } } } while (0)

struct XcdBarrier {
    unsigned* bar; unsigned x;
    volatile LAS unsigned* st;
};

__device__ __forceinline__ XcdBarrier xcd_barrier_post(unsigned* bar, volatile LAS unsigned* st) {
    XcdBarrier b; b.bar = bar; b.x = xb_xcc_id(); b.st = st;
    if (threadIdx.x == 0) (void)xb_add(&bar[XB_XCNT(b.x)], 1u);
    return b;
}
__device__ __forceinline__ void xcd_barrier_complete(unsigned* bar, unsigned x, unsigned& nloc, unsigned& nx) {
    const unsigned G = gridDim.x * gridDim.y * gridDim.z;
    unsigned sum, cnt, mine, sp = 0u;
    for (;;) {
        sum = 0u; cnt = 0u; mine = 0u;
#pragma unroll
        for (unsigned j = 0; j < 16; ++j) { const unsigned c = xb_ld(&bar[XB_XCNT(j)]); sum += c; cnt += (c > 0u) ? 1u : 0u; mine = (j == x) ? c : mine; }
        if (sum == G) break;
        __builtin_amdgcn_s_sleep(1);
        if ((++sp & 255u) == 0u) { if (xb_ld(&bar[XB_TMO])) break; if (sp > XB_SPIN_CAP) { atomicAdd(&bar[XB_TMO], 1u); break; } }
    }
    nloc = mine > 0u ? mine : 1u; nx = cnt > 0u ? cnt : 1u;
}

__device__ __forceinline__ void xcd_barrier(const XcdBarrier& b) {
    asm volatile("s_waitcnt vmcnt(0)" ::: "memory");
    __syncthreads();
    if (threadIdx.x == 0) {
        unsigned* bar = b.bar;
        __builtin_amdgcn_s_waitcnt(0);
        unsigned nloc = b.st[0], nx = b.st[1];
        if (nloc == 0u) { xcd_barrier_complete(bar, b.x, nloc, nx); b.st[0] = nloc; b.st[1] = nx; }
        const unsigned old = xb_add(&bar[XB_XSUB(b.x)], 1u);
        const unsigned gen = old / nloc;
        if (old + 1u == (gen + 1u) * nloc) {
            __builtin_amdgcn_fence(__ATOMIC_RELEASE, "agent");
            asm volatile("s_waitcnt vmcnt(0)" ::: "memory");
            const unsigned og = xb_add(&bar[XB_TOP], 1u);
            const unsigned tg = og / nx;
            if (og + 1u == (tg + 1u) * nx) xb_add(&bar[XB_TOPGEN], 1u);
            else XB_SPIN(xb_ld(&bar[XB_TOPGEN]) == tg, bar);
            __builtin_amdgcn_fence(__ATOMIC_ACQUIRE, "agent");
            xb_add(&bar[XB_XGEN(b.x)], 1u);
            asm volatile("s_waitcnt vmcnt(0)" ::: "memory");
        } else {
            XB_SPIN(xb_ld(&bar[XB_XGEN(b.x)]) == gen, bar);
            __builtin_amdgcn_fence(__ATOMIC_ACQUIRE, "agent");
            asm volatile("s_waitcnt vmcnt(0)" ::: "memory");
        }
    }
    __syncthreads();
}
#define BSYNC() __syncthreads()

__device__ __forceinline__ void ph_prologue(const Args& a, const Frame& F) {
    LAS float* sc = (LAS float*)F.lds;
    LAS float* part = sc + 9 * 1024;
    for (int j = F.tid; j < 9 * 1024; j += NT) { const int r = j >> 10, k = j & 1023; const float v = r < 8 ? a.in[I_C][r * 1024 + k] : a.in[I_CCTX][k]; sc[j] = siluf_(v); }
    BSYNC();
    float* MOD = (float*)(a.ws + WS_MOD);
    for (int unit = F.bid; unit < 4 * 48; unit += F.G) {
        const int l = unit / 48, ch = unit % 48, cn = F.tid & 127, kq = F.tid >> 7;
        const float* W = a.in[I_ADA_W] + (size_t)l * 1024 * 6144 + ch * 128 + cn;
        float acc[9];
#pragma unroll
        for (int j = 0; j < 9; ++j) acc[j] = 0.f;
        for (int k = kq * 256; k < kq * 256 + 256; ++k) { const float w = W[(size_t)k * 6144];
#pragma unroll
            for (int j = 0; j < 9; ++j) acc[j] += sc[j * 1024 + k] * w; }
#pragma unroll
        for (int j = 0; j < 9; ++j) part[(kq * 9 + j) * 128 + cn] = acc[j];
        BSYNC();
        for (int o = F.tid; o < 9 * 128; o += NT) { const int j = o >> 7, cc = o & 127, n = ch * 128 + cc;
            const float s = (part[(0 * 9 + j) * 128 + cc] + part[(1 * 9 + j) * 128 + cc]) + (part[(2 * 9 + j) * 128 + cc] + part[(3 * 9 + j) * 128 + cc]);
            MOD[(size_t)(l * 9 + j) * 6144 + n] = s + a.in[I_ADA_B][l * 6144 + n]; }
        BSYNC();
    }
    if (F.bid == F.G - 1) {
        float* LB = (float*)(a.ws + WS_LB);
        for (int d = F.tid; d < 1024; d += NT) { float v[5], mx = -1e30f;
#pragma unroll
            for (int r = 0; r < 5; ++r) { v[r] = a.in[I_HG_LB][r * 1024 + d]; mx = fmaxf(mx, v[r]); }
            float s = 0.f;
#pragma unroll
            for (int r = 0; r < 5; ++r) { v[r] = expf(v[r] - mx); s += v[r]; }
            LB[d] = v[0] / s; }
    }
}

struct TileRegs { f32x4 v[8]; };
__device__ __forceinline__ void tile_load(TileRegs& t, const float* W, int N, int k0, int n0, int lane) {
    const float* p = W + (size_t)(k0 + (lane >> 3)) * N + n0 + 4 * (lane & 7);
#pragma unroll
    for (int i = 0; i < 8; ++i) t.v[i] = __builtin_nontemporal_load((const f32x4*)(p + (size_t)(8 * i) * N));
}
template <bool NTS = false>
__device__ __forceinline__ void tile_store(const TileRegs& t, int K, bf16* WT, int dst_row0, int k0, LAS float* scr, int lane) {
    { LAS float* d = scr + (lane >> 3) * 33 + 4 * (lane & 7);
#pragma unroll
      for (int i = 0; i < 8; ++i) { d[264 * i + 0] = t.v[i].x; d[264 * i + 1] = t.v[i].y; d[264 * i + 2] = t.v[i].z; d[264 * i + 3] = t.v[i].w; } }
    LDS_WAIT(); asm volatile("" ::: "memory");
    const int c = lane & 7;
#pragma unroll
    for (int j = 0; j < 4; ++j) { const int n = (lane >> 3) + 8 * j; const LAS float* s = scr + (8 * c) * 33 + n;
        v4u o; o.x = pk2(s[0 * 33], s[1 * 33]); o.y = pk2(s[2 * 33], s[3 * 33]); o.z = pk2(s[4 * 33], s[5 * 33]); o.w = pk2(s[6 * 33], s[7 * 33]);
        if (NTS) __builtin_nontemporal_store(o, (v4u*)(WT + (size_t)(dst_row0 + n) * K + k0 + 8 * c)); else *(v4u*)(WT + (size_t)(dst_row0 + n) * K + k0 + 8 * c) = o; }
    LDS_WAIT(); asm volatile("" ::: "memory");
}
template <int UNR = 8>
__device__ __forceinline__ void transpose_item(const float* W, int K, int N, bf16* WT, int dst_row0, int k0, int n0, LAS float* scr, int lane) {
    TileRegs t; tile_load(t, W, N, k0, n0, lane); if (UNR == 32) tile_store<true>(t, K, WT, dst_row0, k0, scr, lane); else tile_store<false>(t, K, WT, dst_row0, k0, scr, lane);
}
__device__ __forceinline__ void cvt_plain(const Frame& F, const float* W, int K, int N, bf16* WT, int Npad, int b0 = 0, int nb = 0) {
    if (nb == 0) nb = F.G;
    if (F.bid < b0 || F.bid >= b0 + nb) return;
    LAS float* scr = (LAS float*)(F.lds + F.wave * 8448);
    const int gw = (F.bid - b0) * NWAVES + F.wave, NGW = nb * NWAVES, nnb = N / 32, items = (K / 64) * nnb;
    for (int it = gw; it < items; it += NGW) { const int kb = it / nnb, nb_ = it % nnb; transpose_item(W, K, N, WT, nb_ * 32, kb * 64, nb_ * 32, scr, F.lane); }
    const int padv = (Npad - N) * K / 8;
    for (int i = (F.bid - b0) * NT + F.tid; i < padv; i += nb * NT) ((v4u*)(WT + (size_t)N * K))[i] = (v4u){0u, 0u, 0u, 0u};
}
__device__ __forceinline__ void cvt_moe(const Args& a, const Frame& F, int layer, int which, int b0, int nb, int f0 = 0, int f1 = 8) {
    if (F.bid < b0 || F.bid >= b0 + nb) return;
    LAS float* scr = (LAS float*)(F.lds + F.wave * 8448);
    const int gw = (F.bid - b0) * NWAVES + F.wave, NGW = nb * NWAVES;
    if (which == 0) { bf16* WGU = (bf16*)(a.ws + WS_WGU);
        for (int it = 4096 * f0 + gw; it < 4096 * f1; it += NGW) {
            const int wh = it >> 14, e = (it >> 10) & 15, r = it & 1023, kb = r >> 6, nb_ = r & 63, n0 = nb_ * 32;
            const float* W = a.in[wh ? I_MOE_U : I_MOE_G] + (size_t)(layer * 16 + e) * 1024 * 2048;
            transpose_item<32>(W, 1024, 2048, WGU, e * 4096 + (n0 >> 7) * 256 + wh * 128 + (n0 & 127), kb * 64, n0, scr, F.lane); } }
    else { bf16* WDN = (bf16*)(a.ws + WS_WDN);
        for (int it = 2048 * f0 + gw; it < 2048 * f1; it += NGW) {
            const int e = it >> 10, r = it & 1023, kb = r >> 5, nb_ = r & 31, n0 = nb_ * 32;
            const float* W = a.in[I_MOE_D] + (size_t)(layer * 16 + e) * 2048 * 1024;
            transpose_item<32>(W, 2048, 1024, WDN, e * 1024 + n0, kb * 64, n0, scr, F.lane); } }
}

__device__ __forceinline__ void cvt_moe_dyn(const Args& a, const Frame& F, int layer, int ctr_idx) {
    LAS float* scr = (LAS float*)(F.lds + F.wave * 8448);
    unsigned* ctr = (unsigned*)(a.ws + WS_CTL) + CW_CVT + 64 * ctr_idx;
    bf16* WGU = (bf16*)(a.ws + WS_WGU); bf16* WDN = (bf16*)(a.ws + WS_WDN);
    constexpr unsigned NGU = 4096 * 8, NTOT = NGU + 2048 * 8;
    unsigned curv = 0; if (F.lane == 0) curv = __hip_atomic_fetch_add(ctr, 8u, __ATOMIC_RELAXED, __HIP_MEMORY_SCOPE_AGENT);
    unsigned cur = __builtin_amdgcn_readfirstlane(curv);
    while (cur < NTOT) {
        unsigned nxtv = 0; if (F.lane == 0) nxtv = __hip_atomic_fetch_add(ctr, 8u, __ATOMIC_RELAXED, __HIP_MEMORY_SCOPE_AGENT);
        const bool gu = cur < NGU; const int it0 = gu ? (int)cur : (int)(cur - NGU);
        const int wh = it0 >> 14, e = gu ? (it0 >> 10) & 15 : it0 >> 10, r0 = it0 & 1023, kb = gu ? r0 >> 6 : r0 >> 5, nb0 = gu ? r0 & 63 : r0 & 31;
        const float* W = gu ? a.in[wh ? I_MOE_U : I_MOE_G] + (size_t)(layer * 16 + e) * 1024 * 2048 : a.in[I_MOE_D] + (size_t)(layer * 16 + e) * 2048 * 1024;
        const int N = gu ? 2048 : 1024, K = gu ? 1024 : 2048;
        bf16* WT = gu ? WGU : WDN;
#pragma unroll 1
        for (int q = 0; q < 8; q += 2) {
            const int n0 = (nb0 + q) * 32, n1 = n0 + 32;
            TileRegs t0, t1; tile_load(t0, W, N, kb * 64, n0, F.lane); tile_load(t1, W, N, kb * 64, n1, F.lane);
            const int d0 = gu ? e * 4096 + (n0 >> 7) * 256 + wh * 128 + (n0 & 127) : e * 1024 + n0;
            const int d1 = gu ? e * 4096 + (n1 >> 7) * 256 + wh * 128 + (n1 & 127) : e * 1024 + n1;
            tile_store<true>(t0, K, WT, d0, kb * 64, scr, F.lane); tile_store<true>(t1, K, WT, d1, kb * 64, scr, F.lane);
        }
        cur = __builtin_amdgcn_readfirstlane(nxtv);
    }
}

__device__ __forceinline__ void ph_norm1(const Args& a, const Frame& F, int layer) {
    const float* X = (const float*)(a.ws + WS_X); bf16* H = (bf16*)(a.ws + WS_H);
    const float* MOD = (const float*)(a.ws + WS_MOD) + (size_t)layer * 9 * 6144;
    const float* g = a.in[I_N1G] + layer * 1024;
    const int gw = F.bid * NWAVES + F.wave, NGW = F.G * NWAVES;
    for (int row = gw; row < MROWS; row += NGW) {
        const f32x4* xr = (const f32x4*)(layer == 0 ? (row < NLAT ? a.in[I_X] + (size_t)row * 1024 : a.in[I_CTX] + (size_t)(row - NLAT) * 1024) : X + (size_t)row * 1024) + F.lane;
        f32x4 v[4]; float ss = 0.f;
#pragma unroll
        for (int j = 0; j < 4; ++j) { v[j] = xr[64 * j]; ss += (v[j].x * v[j].x + v[j].y * v[j].y) + (v[j].z * v[j].z + v[j].w * v[j].w); }
        const float rstd = rsqrtf(wave_sum(ss) * (1.f / 1024.f) + NORM_EPS);
        const int mr = row < NLAT ? (row >> 12) : 8;
        const f32x4* sh = (const f32x4*)(MOD + (size_t)mr * 6144 + 0 * 1024) + F.lane; const f32x4* sc = (const f32x4*)(MOD + (size_t)mr * 6144 + 1 * 1024) + F.lane;
        const f32x4* gg = (const f32x4*)g + F.lane;
        v2u* o8 = (v2u*)(H + (size_t)row * 1024) + F.lane;
#pragma unroll
        for (int j = 0; j < 4; ++j) { const f32x4 h = v[j] * rstd * gg[64 * j] * (sc[64 * j] + 1.0f) + sh[64 * j]; v2u w; w.x = pk2(h.x, h.y); w.y = pk2(h.z, h.w); o8[64 * j] = w; }
    }
}
__device__ __forceinline__ void ph_norm2_router(const Args& a, const Frame& F, int layer, bool skip_ctx) {
    const bf16* X = (const bf16*)(a.ws + WS_X); bf16* H = (bf16*)(a.ws + WS_H); float* AFF = (float*)(a.ws + WS_AFF);
    const float* MOD = (const float*)(a.ws + WS_MOD) + (size_t)layer * 9 * 6144;
    const float* g = a.in[I_N2G] + layer * 1024;
    LAS float* RWt = (LAS float*)F.lds;
    { const float* rw = a.in[I_ROUTER] + (size_t)layer * 1024 * 16; for (int i = F.tid; i < 16384; i += NT) RWt[(i & 15) * 1024 + (i >> 4)] = rw[i]; }
    BSYNC();
    const int gw = F.bid * NWAVES + F.wave, NGW = F.G * NWAVES, nrows = skip_ctx ? NLAT : MROWS;
    for (int row = gw; row < nrows; row += NGW) {
        const v2u* xr = (const v2u*)(X + (size_t)row * 1024) + F.lane;
        f32x4 v[4]; float ss = 0.f;
#pragma unroll
        for (int j = 0; j < 4; ++j) { const v2u xw = xr[64 * j]; v[j] = (f32x4){bflo(xw.x), bfhi(xw.x), bflo(xw.y), bfhi(xw.y)}; ss += (v[j].x * v[j].x + v[j].y * v[j].y) + (v[j].z * v[j].z + v[j].w * v[j].w); }
        const float rstd = rsqrtf(wave_sum(ss) * (1.f / 1024.f) + NORM_EPS);
        const int mr = row < NLAT ? (row >> 12) : 8;
        const f32x4* sh = (const f32x4*)(MOD + (size_t)mr * 6144 + 3 * 1024) + F.lane; const f32x4* sc = (const f32x4*)(MOD + (size_t)mr * 6144 + 4 * 1024) + F.lane;
        const f32x4* gg = (const f32x4*)g + F.lane;
        v2u* o8 = (v2u*)(H + (size_t)row * 1024) + F.lane;
        f32x4 h[4];
#pragma unroll
        for (int j = 0; j < 4; ++j) { h[j] = v[j] * rstd * gg[64 * j] * (sc[64 * j] + 1.0f) + sh[64 * j]; v2u w; w.x = pk2(h[j].x, h[j].y); w.y = pk2(h[j].z, h[j].w); o8[64 * j] = w; }
        float p[16];
#pragma unroll
        for (int e = 0; e < 16; ++e) { float acc = 0.f;
#pragma unroll
            for (int j = 0; j < 4; ++j) { const f32x4 r = *(const LAS f32x4*)(RWt + e * 1024 + 4 * F.lane + 256 * j); acc += (h[j].x * r.x + h[j].y * r.y) + (h[j].z * r.z + h[j].w * r.w); }
            p[e] = acc; if ((e & 3) == 3) __builtin_amdgcn_sched_barrier(0); }
        float q8[8], q4[4], q2[2], mine;
        { const bool hi = F.lane & 1;
#pragma unroll
          for (int i = 0; i < 8; ++i) { const float send = hi ? p[i] : p[i + 8], keep = hi ? p[i + 8] : p[i]; q8[i] = keep + __shfl_xor(send, 1); } }
        { const bool hi = F.lane & 2;
#pragma unroll
          for (int i = 0; i < 4; ++i) { const float send = hi ? q8[i] : q8[i + 4], keep = hi ? q8[i + 4] : q8[i]; q4[i] = keep + __shfl_xor(send, 2); } }
        { const bool hi = F.lane & 4;
#pragma unroll
          for (int i = 0; i < 2; ++i) { const float send = hi ? q4[i] : q4[i + 2], keep = hi ? q4[i + 2] : q4[i]; q2[i] = keep + __shfl_xor(send, 4); } }
        { const bool hi = F.lane & 8; const float send = hi ? q2[0] : q2[1], keep = hi ? q2[1] : q2[0]; mine = keep + __shfl_xor(send, 8); }
        mine += __shfl_xor(mine, 16); mine += __shfl_xor(mine, 32);
        float mx = mine;
#pragma unroll
        for (int m = 1; m < 16; m <<= 1) mx = fmaxf(mx, __shfl_xor(mx, m));
        const float ex = expf(mine - mx); float s = ex;
#pragma unroll
        for (int m = 1; m < 16; m <<= 1) s += __shfl_xor(s, m);
        mine = ex / s;
        const int eidx = ((F.lane & 1) << 3) | ((F.lane & 2) << 1) | ((F.lane & 4) >> 1) | ((F.lane & 8) >> 3);
        if (F.lane < 16) AFF[(size_t)row * 16 + eidx] = mine;
    }
}

__device__ __forceinline__ int wave_incl_scan(int v, int lane) {
#pragma unroll
    for (int o = 1; o < 64; o <<= 1) { const int t = __shfl_up(v, o); if (lane >= o) v += t; }
    return v;
}
__device__ __forceinline__ int block_excl_scan(int v, LAS int* tmp, const Frame& F, int& total) {
    const int incl = wave_incl_scan(v, F.lane);
    if (F.lane == 63) tmp[F.wave] = incl;
    BSYNC();
    int base = 0, tot = 0;
#pragma unroll
    for (int w = 0; w < NWAVES; ++w) { const int t = tmp[w]; base += (w < F.wave) ? t : 0; tot += t; }
    BSYNC();
    total = tot; return base + incl - v;
}
__device__ __forceinline__ void ph_select_gather(const Args& a, const Frame& F, bool skip_ctx) {
    const float* AFF = (const float*)(a.ws + WS_AFF); int* SLOT = (int*)(a.ws + WS_SLOT); float* GATE = (float*)(a.ws + WS_GATE);

    LAS int* hist = (LAS int*)F.lds;
    LAS int* tmp = hist + 256;
    LAS int* res = tmp + 16;
    LAS int* selrow = res + 16;
    int* SRCROW = (int*)(a.ws + WS_SRCROW);
    const int nprob = skip_ctx ? 128 : 256;
    for (int prob = F.bid; prob < nprob; prob += F.G) {
        const bool isx = prob < 128; const int pb = isx ? prob : prob - 128, b = pb >> 4, e = pb & 15;
        const int n = isx ? SEQ : CTXL, kcap = isx ? CAPX : CAPC, row0 = isx ? b * SEQ : NLAT + b * CTXL, slot0 = e * ROWS_E + (isx ? b * CAPX : NB * CAPX + b * CAPC);
        unsigned key[8];
#pragma unroll
        for (int j = 0; j < 8; ++j) { const int t = 8 * F.tid + j; key[j] = t < n ? __builtin_bit_cast(unsigned, AFF[(size_t)(row0 + t) * 16 + e]) : 0u; }
        unsigned prefix = 0u, mask = 0u; int rem = kcap;
        for (int pass = 3; pass >= 0; --pass) {
            const int shift = pass * 8;
            if (F.tid < 256) hist[F.tid] = 0;
            BSYNC();
#pragma unroll
            for (int j = 0; j < 8; ++j) if (8 * F.tid + j < n && (key[j] & mask) == prefix) __hip_atomic_fetch_add(&hist[(key[j] >> shift) & 255u], 1, __ATOMIC_RELAXED, __HIP_MEMORY_SCOPE_WORKGROUP);
            BSYNC();
            if (F.wave == 0) {
                const int h0 = hist[4 * F.lane], h1 = hist[4 * F.lane + 1], h2 = hist[4 * F.lane + 2], h3 = hist[4 * F.lane + 3];
                int S = h0 + h1 + h2 + h3;
#pragma unroll
                for (int o = 1; o < 64; o <<= 1) { const int t = __shfl_down(S, o); if (F.lane + o < 64) S += t; }
                const unsigned long long bal = __ballot(S >= rem);
                const int Ls = 63 - __builtin_clzll(bal);
                const int above0 = __shfl_down(S, 1);
                if (F.lane == Ls) { int above = (F.lane == 63) ? 0 : above0; int bin;
                    if (above + h3 >= rem) bin = 3; else { above += h3; if (above + h2 >= rem) bin = 2; else { above += h2; if (above + h1 >= rem) bin = 1; else { above += h1; bin = 0; } } }
                    res[0] = 4 * F.lane + bin; res[1] = rem - above; }
            }
            BSYNC();
            prefix |= (unsigned)res[0] << shift; mask |= 255u << shift; rem = res[1];
            BSYNC();
        }
        int ceq = 0;
#pragma unroll
        for (int j = 0; j < 8; ++j) ceq += (8 * F.tid + j < n && key[j] == prefix) ? 1 : 0;
        int toteq; int eqbase = block_excl_scan(ceq, tmp, F, toteq);
        int csel = 0; unsigned selm = 0u;
#pragma unroll
        for (int j = 0; j < 8; ++j) { const bool valid = 8 * F.tid + j < n; bool s = valid && key[j] > prefix;
            if (valid && key[j] == prefix) { s = eqbase < rem; ++eqbase; }
            if (s) { selm |= 1u << j; ++csel; } }
        int totsel; int sb = block_excl_scan(csel, tmp, F, totsel);
#pragma unroll
        for (int j = 0; j < 8; ++j) { const int t = 8 * F.tid + j;
            if (t < n) { const int row = row0 + t; int sl = -1;
                if (selm & (1u << j)) { sl = slot0 + sb; SRCROW[sl] = row; GATE[sl] = __builtin_bit_cast(float, key[j]); ++sb; }
                SLOT[(size_t)row * 16 + e] = sl; } }
        BSYNC();
    }
}

__device__ __forceinline__ void ph_combine(const Args& a, const Frame& F, int layer, bool last) {
    bf16* X = (bf16*)(a.ws + WS_X); const int* SLOT = (const int*)(a.ws + WS_SLOT); const bf16* YE = (const bf16*)(a.ws + WS_YE); const bf16* YEP = (const bf16*)(a.ws + WS_YEP);
    const float* MOD = (const float*)(a.ws + WS_MOD) + (size_t)layer * 9 * 6144;
    const int gw = F.bid * NWAVES + F.wave, NGW = F.G * NWAVES, nrows = last ? NLAT : MROWS;
    int myslot = gw < nrows ? SLOT[(size_t)gw * 16 + (F.lane & 15)] : -1;
    for (int row = gw; row < nrows; row += NGW) {
        const int mr = row < NLAT ? (row >> 12) : 8;
        const f32x4* g2 = (const f32x4*)(MOD + (size_t)mr * 6144 + 5 * 1024) + F.lane;
        v2u* xr = (v2u*)(X + (size_t)row * 1024) + F.lane;
        v2u xw[4]; f32x4 gv[4];
#pragma unroll
        for (int j = 0; j < 4; ++j) { xw[j] = xr[64 * j]; gv[j] = g2[64 * j]; }
        const int curslot = myslot;
        if (row + NGW < nrows) myslot = SLOT[(size_t)(row + NGW) * 16 + (F.lane & 15)];
        f32x4 acc[4];
#pragma unroll
        for (int j = 0; j < 4; ++j) acc[j] = (f32x4){0.f, 0.f, 0.f, 0.f};
        unsigned sm = (unsigned)(__ballot(curslot >= 0) & 0xFFFFull);
        while (sm) {
            const int e0 = __builtin_ctz(sm); sm &= sm - 1; const bool two = sm != 0; const int e1 = two ? __builtin_ctz(sm) : e0; if (two) sm &= sm - 1;
            const int s0 = __shfl(curslot, e0), s1 = __shfl(curslot, e1);
            if (row < NLAT) {
                const v2u* y0 = (const v2u*)(YE + (size_t)s0 * 1024) + F.lane; const v2u* y1 = (const v2u*)(YE + (size_t)s1 * 1024) + F.lane;
                v2u w0[4], w1[4];
#pragma unroll
                for (int j = 0; j < 4; ++j) { w0[j] = __builtin_nontemporal_load(&y0[64 * j]); w1[j] = __builtin_nontemporal_load(&y1[64 * j]); }
#pragma unroll
                for (int j = 0; j < 4; ++j) { acc[j].x += bflo(w0[j].x); acc[j].y += bfhi(w0[j].x); acc[j].z += bflo(w0[j].y); acc[j].w += bfhi(w0[j].y); }
                if (two) {
#pragma unroll
                    for (int j = 0; j < 4; ++j) { acc[j].x += bflo(w1[j].x); acc[j].y += bfhi(w1[j].x); acc[j].z += bflo(w1[j].y); acc[j].w += bfhi(w1[j].y); } }
            } else {
#pragma unroll
                for (int which = 0; which < 2; ++which) { if (which == 1 && !two) break; const int sl = which ? s1 : s0;
                    const size_t pr = (size_t)(sl / ROWS_E) * 256 + (sl % ROWS_E - NB * CAPX);
#pragma unroll
                    for (int kq = 0; kq < 4; ++kq) { const v2u* yp = (const v2u*)(YEP + ((size_t)kq * NE * 256 + pr) * 1024) + F.lane;
#pragma unroll
                        for (int j = 0; j < 4; ++j) { const v2u w = yp[64 * j]; acc[j].x += bflo(w.x); acc[j].y += bfhi(w.x); acc[j].z += bflo(w.y); acc[j].w += bfhi(w.y); } } }
            }
        }
        f32x4 v[4]; float ss = 0.f;
#pragma unroll
        for (int j = 0; j < 4; ++j) { const f32x4 xv = (f32x4){bflo(xw[j].x), bfhi(xw[j].x), bflo(xw[j].y), bfhi(xw[j].y)}; v[j] = xv + gv[j] * acc[j]; ss += (v[j].x * v[j].x + v[j].y * v[j].y) + (v[j].z * v[j].z + v[j].w * v[j].w); }
        if (!last) {
#pragma unroll
            for (int j = 0; j < 4; ++j) { v2u w; w.x = pk2(v[j].x, v[j].y); w.y = pk2(v[j].z, v[j].w); xr[64 * j] = w; }
            const float rstd = rsqrtf(wave_sum(ss) * (1.f / 1024.f) + NORM_EPS);
            const float* MODN = MOD + 9 * 6144;
            const f32x4* sh = (const f32x4*)(MODN + (size_t)mr * 6144 + 0 * 1024) + F.lane; const f32x4* sc = (const f32x4*)(MODN + (size_t)mr * 6144 + 1 * 1024) + F.lane;
            const f32x4* gg = (const f32x4*)(a.in[I_N1G] + (layer + 1) * 1024) + F.lane;
            v2u* o8 = (v2u*)((bf16*)(a.ws + WS_H) + (size_t)row * 1024) + F.lane;
#pragma unroll
            for (int j = 0; j < 4; ++j) { const f32x4 hh = v[j] * rstd * gg[64 * j] * (sc[64 * j] + 1.0f) + sh[64 * j]; v2u w; w.x = pk2(hh.x, hh.y); w.y = pk2(hh.z, hh.w); o8[64 * j] = w; }
        } else {
            const float rstd = rsqrtf(wave_sum(ss) * (1.f / 1024.f) + NORM_EPS);
            const f32x4* gg = (const f32x4*)a.in[I_FNG] + F.lane; f32x4* o = (f32x4*)(a.out + (size_t)row * 1024) + F.lane;
#pragma unroll
            for (int j = 0; j < 4; ++j) o[64 * j] = v[j] * rstd * gg[64 * j];
        }
    }
}
__device__ __forceinline__ int scan_row(bool perm, int b, int dir, int p) {
    if (p < CTXL) return NLAT + b * CTXL + (dir ? CTXL - 1 - p : p);
    int q = p - CTXL; if (dir) q = SEQ - 1 - q;
    const int t = perm ? ((q & 63) * 64 + (q >> 6)) : q;
    return b * SEQ + t;
}
__device__ __forceinline__ int scan_pos(bool perm, int row, int dir) {
    if (row >= NLAT) { const int t = (row - NLAT) & (CTXL - 1); return dir ? CTXL - 1 - t : t; }
    const int t = row & (SEQ - 1), q = perm ? ((t & 63) * 64 + (t >> 6)) : t;
    return CTXL + (dir ? SEQ - 1 - q : q);
}
#define CHUNK_ROWS(perm, b, dir, p0) const int row0_ = scan_row(perm, b, dir, (p0)), rstr_ = scan_row(perm, b, dir, (p0) + 1) - row0_;
constexpr int SC_QT = 0, SC_KT = 8704, SC_VT = 17408  , SC_TOT = 37888, SC_RF = 39936, SC_RAW = 41984  ;
template <int KIND> struct GlaCfg { static constexpr int LDP = KIND == 0 ? N_HG : N_GLA, NV = KIND == 0 ? 128 : 256, NVT = NV / 128, NH = KIND == 0 ? 8 : 4,
    REC_KHT = 8192, REC_VT = 16384, REC_DEC = 16384 + NV * 64, REC_X = REC_DEC + 512, REC_BYTES = REC_X + 2048, NUNITS = NB * NH * 2 * 136; };

template <int KIND  >
__device__ __forceinline__ void ph_s1_gla(const Args& a, const Frame& F) {
    typedef GlaCfg<KIND> C; constexpr int LDP = C::LDP, NVT = C::NVT;
    const bf16* P = (const bf16*)(a.ws + WS_P); bf16* OI = (bf16*)(a.ws + WS_OI); unsigned char* REC = a.ws + WS_REC;
    LAS bf16* QT = (LAS bf16*)(F.lds + SC_QT); LAS bf16* KT = (LAS bf16*)(F.lds + SC_KT); LAS bf16* VT = (LAS bf16*)(F.lds + SC_VT);
    LAS float* TOT = (LAS float*)(F.lds + SC_TOT); LAS float* RF = (LAS float*)(F.lds + SC_RF); LAS bf16* RAW = (LAS bf16*)(F.lds + SC_RAW);
    const int c = F.tid & 127, rq = F.tid >> 7, g = F.lane >> 4, i16 = F.lane & 15, w = F.wave, lr = F.tid >> 4, lcg = F.tid & 15;
    v4u wq, wk, wv[NVT]; unsigned short rrf = 0;
#define S1_DECODE(unit) const int cid = (unit) % (C::NUNITS / 136), chunk = 135 - (unit) / (C::NUNITS / 136)  , b = cid / (2 * C::NH), h = (cid >> 1) % C::NH, dir = cid & 1, p0 = chunk * 32; \
        const int qcol = h * 128, kcol = KIND == 0 ? 1024 + dir * 1024 + h * 128 : 512 + h * 128, vcol = KIND == 0 ? 3072 + h * 128 : 1024 + h * 256, ocol = h * C::NV;
#define S1_LOAD(unit) do { S1_DECODE(unit) (void)ocol; CHUNK_ROWS(KIND == 1, b, dir, p0) \
        { const bf16* pr = P + (size_t)(row0_ + lr * rstr_) * LDP + 8 * lcg; wq = *(const v4u*)(pr + qcol); wk = *(const v4u*)(pr + kcol); \
          if (dir == 0) { _Pragma("unroll") for (int vt = 0; vt < NVT; ++vt) wv[vt] = *(const v4u*)(pr + vcol + vt * 128); } } \
        if (KIND == 1) { const size_t ro = (size_t)(row0_ + (F.tid >> 4) * rstr_) * LDP; rrf = P[ro + 3072 + dir * 16 + (F.tid & 15)]; } } while (0)
    if (F.bid < C::NUNITS) S1_LOAD(F.bid);
    for (int unit = F.bid; unit < C::NUNITS; unit += F.G) {
        S1_DECODE(unit)
        (void)qcol; (void)kcol; (void)vcol; (void)ocol;
        unsigned char* rec = REC + (size_t)(cid * 136 + chunk) * C::REC_BYTES;
        float lbv = 0.f, w2[16], gkb = 0.f;
        if (KIND == 0) lbv = ((const float*)(a.ws + WS_LB))[h * 128 + c];
        else { gkb = a.in[I_GLA_GKB][dir * 512 + h * 128 + c];
#pragma unroll
            for (int r = 0; r < 16; ++r) w2[r] = a.in[I_GLA_W2][(dir * 16 + r) * 512 + h * 128 + c]; }
        *(LAS v4u*)(RAW + lr * 136 + 8 * lcg) = wq; *(LAS v4u*)(RAW + 4352 + lr * 136 + 8 * lcg) = wk;
        if (dir == 0) {
#pragma unroll
            for (int vt = 0; vt < NVT; ++vt) *(LAS v4u*)(RAW + (2 + vt) * 4352 + lr * 136 + 8 * lcg) = wv[vt]; }
        if (KIND == 1) RF[F.tid] = bf2f(rrf);
        BSYNC();
        unsigned short rq_[8], rk_[8], rv_[8 * NVT];
#pragma unroll
        for (int j = 0; j < 8; ++j) { const int ro = (8 * rq + j) * 136 + c; rq_[j] = RAW[ro]; rk_[j] = RAW[4352 + ro];
#pragma unroll
            for (int vt = 0; vt < NVT; ++vt) rv_[vt * 8 + j] = RAW[(2 + vt) * 4352 + ro]; }
        float qv[8], kv[8], G[8];
        {   float run = 0.f;
#pragma unroll
            for (int j = 0; j < 8; ++j) {
                float gj;
                if (KIND == 0) { const float fr = bf2f(rk_[j]); qv[j] = siluf_(bf2f(rq_[j])) * 0.08838834764831845f;
                    const float sg = sigmoidf_(fr), f = lbv + (1.0f - lbv) * sg; kv[j] = (1.0f - lbv) * (1.0f - sg); gj = __logf(f); }
                else { qv[j] = bf2f(rq_[j]) * 0.08838834764831845f; kv[j] = bf2f(rk_[j]);
                    float x = gkb; const LAS f32x4* rf = (const LAS f32x4*)(RF + (8 * rq + j) * 16);
#pragma unroll
                    for (int r4 = 0; r4 < 4; ++r4) { const f32x4 v = rf[r4]; x += v.x * w2[4 * r4] + v.y * w2[4 * r4 + 1] + v.z * w2[4 * r4 + 2] + v.w * w2[4 * r4 + 3]; }
                    gj = (fminf(x, 0.f) - __logf(1.0f + __expf(-fabsf(x)))) * (1.0f / 16.0f); }
                run += gj; G[j] = run; }
            TOT[rq * 128 + c] = run; }
        if (dir == 0) {
#pragma unroll
        for (int vt = 0; vt < NVT; ++vt) {
            v4u wv2; wv2.x = rv_[vt * 8 + 0] | ((unsigned)rv_[vt * 8 + 1] << 16); wv2.y = rv_[vt * 8 + 2] | ((unsigned)rv_[vt * 8 + 3] << 16); wv2.z = rv_[vt * 8 + 4] | ((unsigned)rv_[vt * 8 + 5] << 16); wv2.w = rv_[vt * 8 + 6] | ((unsigned)rv_[vt * 8 + 7] << 16);
            *(LAS v4u*)(VT + (vt * 128 + c) * 40 + 8 * rq) = wv2; *(v4u*)(rec + C::REC_VT + (vt * 128 + c) * 64 + rq * 16) = wv2; } }
        BSYNC();
        {   const float t0 = TOT[c], t1 = TOT[128 + c], t2 = TOT[256 + c], t3 = TOT[384 + c];
            const float pre = (rq > 0 ? t0 : 0.f) + (rq > 1 ? t1 : 0.f) + (rq > 2 ? t2 : 0.f), gend = (t0 + t1) + (t2 + t3);
            unsigned kh[8];
#pragma unroll
            for (int j = 0; j < 8; ++j) { const float Gj = pre + G[j]; const int r = 8 * rq + j;
                QT[r * 136 + c] = (bf16)f2bf(qv[j] * __expf(Gj)); KT[r * 136 + c] = (bf16)f2bf(kv[j] * __expf(fminf(-Gj, 80.f))); kh[j] = f2bf(kv[j] * __expf(gend - Gj)); }
            v4u wk2; wk2.x = kh[0] | (kh[1] << 16); wk2.y = kh[2] | (kh[3] << 16); wk2.z = kh[4] | (kh[5] << 16); wk2.w = kh[6] | (kh[7] << 16);
            *(v4u*)(rec + C::REC_KHT + c * 64 + rq * 16) = wk2;
            if (rq == 0) *(float*)(rec + C::REC_DEC + c * 4) = __expf(gend); }
        BSYNC();
        if (unit + F.G < C::NUNITS) S1_LOAD(unit + F.G);
        { const int row = F.tid >> 4, ch = F.tid & 15; *(v4u*)(rec + row * 256 + ch * 16) = *(const LAS v4u*)(QT + row * 136 + ch * 8); }
        f32x4 X00 = {0.f, 0.f, 0.f, 0.f}, X01 = X00, X11 = X00;
#pragma unroll
        for (int ks = 0; ks < 4; ++ks) {
            const bf16x8 k0 = *(const LAS bf16x8*)(KT + i16 * 136 + ks * 32 + g * 8), k1 = *(const LAS bf16x8*)(KT + (16 + i16) * 136 + ks * 32 + g * 8);
            const bf16x8 q0 = *(const LAS bf16x8*)(QT + i16 * 136 + ks * 32 + g * 8), q1 = *(const LAS bf16x8*)(QT + (16 + i16) * 136 + ks * 32 + g * 8);
            X00 = MFMA16(k0, q0, X00); X01 = MFMA16(k0, q1, X01); X11 = MFMA16(k1, q1, X11);
        }
#pragma unroll
        for (int r = 0; r < 4; ++r) if (4 * g + r > i16) { X00[r] = 0.f; X11[r] = 0.f; }
        const bf16x8 xa0 = pack8(X00, (f32x4){0.f, 0.f, 0.f, 0.f}), xa1 = pack8(X01, X11);
        if (w == 0) { v4u* xr = (v4u*)(rec + C::REC_X + F.lane * 32); xr[0] = __builtin_bit_cast(v4u, xa0); xr[1] = __builtin_bit_cast(v4u, xa1); }
        BSYNC();
    }
#undef S1_LOAD
#undef S1_DECODE
}

__device__ __forceinline__ unsigned swap16(unsigned u) { return __builtin_amdgcn_alignbit(u, u, 16); }
__device__ __forceinline__ bf16x4 rev4(v2u a) { return __builtin_bit_cast(bf16x4, (v2u){swap16(a.y), swap16(a.x)}); }
__device__ __forceinline__ bf16x8 rev8(v4u a) { return __builtin_bit_cast(bf16x8, (v4u){swap16(a.w), swap16(a.z), swap16(a.y), swap16(a.x)}); }
constexpr int S2_QT = 0, S2_KHT = 8704, S2_VT = 18944, S2_DEC = 29184, S2_XS = 29696, S2_IMG = 31744, S2_SLOT = 32768, S2_OB = 4 * 32768, S2_OBSZ = 8704;
#define S2_WAITV(n) asm volatile("s_waitcnt vmcnt(" #n ")" ::: "memory")
template <int KIND, int VAR = 0  >
__device__ __forceinline__ void ph_s2_gla(const Args& a, const Frame& F) {
    typedef GlaCfg<KIND> C;
    bf16* O = (bf16*)(a.ws + (VAR ? WS_A2 : WS_O_GLA)); const unsigned char* REC = a.ws + WS_REC;
    const int g = F.lane >> 4, i16 = F.lane & 15, w = F.wave;
    for (int chain = F.bid; chain < 128; chain += F.G) {
        int cid, vh = 0; if (KIND == 0) cid = chain; else { cid = chain >> 1; vh = chain & 1; }
        const int dir = cid & 1;
        const unsigned char* rec0 = REC + (size_t)cid * 136 * C::REC_BYTES;
        unsigned soff[8]; unsigned vmask = 0u;
        const unsigned char* recv0 = REC + (size_t)(cid & ~1) * 136 * C::REC_BYTES;
#pragma unroll
        for (int j = 0; j < 8; ++j) { const int q = 16 * ((8 * (w & 3) + j) * 64 + F.lane); int src;
            if (q < S2_KHT) { const int row = q / 272, cb = q % 272; src = row * 256 + (cb < 256 ? cb : 0); }
            else if (q < S2_VT) { const int q2 = q - S2_KHT, row = q2 / 80, cb = q2 % 80; src = C::REC_KHT + row * 64 + (cb < 64 ? cb : 0); }
            else if (q < S2_DEC) { const int q2 = q - S2_VT, row = q2 / 80, cb = q2 % 80; src = C::REC_VT + vh * 8192 + row * 64 + (cb < 64 ? cb : 0); vmask |= 1u << j; }
            else if (q < S2_XS) src = C::REC_DEC + (q - S2_DEC);
            else if (q < S2_IMG) src = C::REC_X + (q - S2_XS);
            else src = 0;
            soff[j] = (unsigned)src; }
        f32x4 S[8];
#pragma unroll
        for (int m = 0; m < 8; ++m) S[m] = (f32x4){0.f, 0.f, 0.f, 0.f};
#define S2_DMA(step) do { if (w < 4 && !(VAR & 1)) { const int st_ = (step) < 136 ? (step) : 135; const unsigned char* rc = rec0 + (size_t)st_ * C::REC_BYTES; LAS unsigned char* dst = F.lds + ((step) & 3) * S2_SLOT + w * 8192; \
        const unsigned char* rcv = dir ? recv0 + (size_t)(st_ < 8 ? 7 - st_ : 143 - st_) * C::REC_BYTES : rc;     \
        _Pragma("unroll") for (int j = 0; j < 8; ++j) __builtin_amdgcn_global_load_lds((const unsigned*)(((vmask >> j) & 1u ? rcv : rc) + soff[j]), (LAS unsigned*)(dst + j * 1024), 16, 0, 2  ); } } while (0)
#define S2_OSTORE(step) do { if (w >= 4 && !(VAR & 2)) { const LAS unsigned char* obuf = F.lds + S2_OB + ((step) & 1) * S2_OBSZ; \
        _Pragma("unroll") for (int k = 0; k < 2; ++k) { const int idx = (F.tid - 256) + 256 * k, row = idx >> 4, ch = idx & 15; \
            *(v4u*)(O + ((size_t)(cid * 136 + (step)) * 32 + row) * C::NV + vh * 128 + ch * 8) = *(const LAS v4u*)(obuf + row * 272 + ch * 16); } } } while (0)
#define S2_STEP(step) do { \
        S2_DMA((step) + 3); \
        if ((step) > 0) S2_OSTORE((step) - 1); \
        const LAS unsigned char* im = F.lds + ((step) & 3) * S2_SLOT; const LAS bf16* QT = (const LAS bf16*)(im + S2_QT); const LAS bf16* KHT = (const LAS bf16*)(im + S2_KHT); \
        const LAS bf16* VT = (const LAS bf16*)(im + S2_VT); const LAS float* DEC = (const LAS float*)(im + S2_DEC); \
        f32x4 O0 = {0.f, 0.f, 0.f, 0.f}, O1 = O0; \
        _Pragma("unroll") for (int ks = 0; ks < 4; ++ks) { const bf16x8 sb = pack8(S[2 * ks], S[2 * ks + 1]); \
            const bf16x8 a0 = cat8(*(const LAS bf16x4*)(QT + i16 * 136 + 32 * ks + 4 * g), *(const LAS bf16x4*)(QT + i16 * 136 + 32 * ks + 16 + 4 * g)); \
            const bf16x8 a1 = cat8(*(const LAS bf16x4*)(QT + (16 + i16) * 136 + 32 * ks + 4 * g), *(const LAS bf16x4*)(QT + (16 + i16) * 136 + 32 * ks + 16 + 4 * g)); \
            O0 = MFMA16(sb, a0, O0); O1 = MFMA16(sb, a1, O1); } \
        { const bf16x8 vbp = dir ? cat8(rev4(*(const LAS v2u*)(VT + (16 * w + i16) * 40 + 28 - 4 * g)), rev4(*(const LAS v2u*)(VT + (16 * w + i16) * 40 + 12 - 4 * g))) \
                                 : cat8(*(const LAS bf16x4*)(VT + (16 * w + i16) * 40 + 4 * g), *(const LAS bf16x4*)(VT + (16 * w + i16) * 40 + 16 + 4 * g)); \
          const LAS v4u* xs = (const LAS v4u*)(im + S2_XS + F.lane * 32); \
          O0 = MFMA16(vbp, __builtin_bit_cast(bf16x8, xs[0]), O0); O1 = MFMA16(vbp, __builtin_bit_cast(bf16x8, xs[1]), O1); }     \
        { LAS unsigned char* obuf = F.lds + S2_OB + ((step) & 1) * S2_OBSZ + (16 * w + 4 * g) * 2; \
          *(LAS v2u*)(obuf + i16 * 272) = (v2u){pk2(O0[0], O0[1]), pk2(O0[2], O0[3])}; *(LAS v2u*)(obuf + (16 + i16) * 272) = (v2u){pk2(O1[0], O1[1]), pk2(O1[2], O1[3])}; } \
        { const bf16x8 vb2 = dir ? rev8(*(const LAS v4u*)(VT + (16 * w + i16) * 40 + 24 - 8 * g)) : *(const LAS bf16x8*)(VT + (16 * w + i16) * 40 + 8 * g); \
          _Pragma("unroll") for (int m = 0; m < 8; ++m) { const f32x4 dec = *(const LAS f32x4*)(DEC + 16 * m + 4 * g); const bf16x8 ka = *(const LAS bf16x8*)(KHT + (16 * m + i16) * 40 + 8 * g); \
              S[m] = MFMA16(ka, vb2, S[m] * dec); } } \
        asm volatile("s_waitcnt lgkmcnt(0)" ::: "memory"); if (w < 4) S2_WAITV(16); if (!(VAR & 4)) __builtin_amdgcn_s_barrier(); asm volatile("" ::: "memory"); } while (0)
        S2_DMA(0); S2_DMA(1); S2_DMA(2); if (w < 4) S2_WAITV(16); __builtin_amdgcn_s_barrier(); asm volatile("" ::: "memory");
        for (int step = 0; step < 136; ++step) S2_STEP(step);
        S2_OSTORE(135);
        if (w < 4) S2_WAITV(0); BSYNC();
#undef S2_STEP
#undef S2_OSTORE
#undef S2_DMA
    }
}
constexpr int MS_CT = 0, MS_BT = 8704, MS_XT = 17408, MS_LL = 37888, MS_DTL = 38400;
constexpr int MREC_XT = 8192, MREC_EL = 24576, MREC_WS = 25088, MREC_DEND = 25600, MREC_W = 25664, MREC_BYTES = 25664 + 8192, M_NUNITS = NB * 8 * 2 * 136;
__device__ __forceinline__ void ph_s1_mamba(const Args& a, const Frame& F) {
    const bf16* XBC = (const bf16*)(a.ws + WS_XBC); const float* DT = (const float*)(a.ws + WS_DT); unsigned char* REC = a.ws + WS_REC_MB;
    LAS bf16* CT = (LAS bf16*)(F.lds + MS_CT); LAS bf16* BT = (LAS bf16*)(F.lds + MS_BT); LAS bf16* XT = (LAS bf16*)(F.lds + MS_XT);
    LAS float* LL = (LAS float*)(F.lds + MS_LL); LAS float* DTL = (LAS float*)(F.lds + MS_DTL);
    const int c = F.tid & 127, rq = F.tid >> 7, xc = F.tid & 255, rh = F.tid >> 8, g = F.lane >> 4, i16 = F.lane & 15, w = F.wave, hg = w >> 1, ph = w & 1, th = (F.tid >> 5) & 3;
    unsigned short rc_[8], rb_[8], rx_[16]; float rdt = 0.f;
#define M1_DECODE(unit) const int cid = (unit) % (M_NUNITS / 136), chunk = 135 - (unit) / (M_NUNITS / 136)  , b = cid >> 4, grp = (cid >> 1) & 7, dir = cid & 1, p0 = chunk * 32;
#define M1_LOAD(unit) do { M1_DECODE(unit) CHUNK_ROWS(false, b, dir, p0) \
        _Pragma("unroll") for (int j = 0; j < 8; ++j) { const size_t ro = (size_t)(row0_ + (8 * rq + j) * rstr_) * 4096; rb_[j] = XBC[ro + 2048 + grp * 128 + c]; rc_[j] = XBC[ro + 3072 + grp * 128 + c]; } \
        _Pragma("unroll") for (int j = 0; j < 16; ++j) { const size_t ro = (size_t)(row0_ + (16 * rh + j) * rstr_) * 4096; rx_[j] = XBC[ro + grp * 256 + xc]; } \
        if (F.tid < 128) rdt = DT[(size_t)(row0_ + (F.tid & 31) * rstr_) * 64 + dir * 32 + grp * 4 + th]; } while (0)
    if (F.bid < M_NUNITS) M1_LOAD(F.bid);
    for (int unit = F.bid; unit < M_NUNITS; unit += F.G) {
        M1_DECODE(unit)
        unsigned char* rec = REC + (size_t)(cid * 136 + chunk) * MREC_BYTES;
        if (F.tid < 128) {
            const float aval = -__expf(a.in[I_MB_ALOG][dir * 32 + grp * 4 + th]);
            float l = rdt * aval;
#pragma unroll
            for (int o = 1; o < 32; o <<= 1) { const float t = __shfl_up(l, o, 32); if ((F.tid & 31) >= o) l += t; }
            LL[F.tid] = l; DTL[F.tid] = rdt;
            *(float*)(rec + MREC_EL + F.tid * 4) = __expf(l);
            { const float lend_ = __shfl(l, 31, 32); *(float*)(rec + MREC_WS + F.tid * 4) = __expf(lend_ - l) * rdt; }
            if ((F.tid & 31) == 31) *(float*)(rec + MREC_DEND + th * 4) = __expf(l);
        }
        {   v4u wb;
            wb.x = rb_[0] | ((unsigned)rb_[1] << 16); wb.y = rb_[2] | ((unsigned)rb_[3] << 16); wb.z = rb_[4] | ((unsigned)rb_[5] << 16); wb.w = rb_[6] | ((unsigned)rb_[7] << 16);
            *(v4u*)(rec + c * 64 + rq * 16) = wb;
#pragma unroll
            for (int j = 0; j < 8; ++j) { BT[(8 * rq + j) * 136 + c] = rb_[j]; CT[(8 * rq + j) * 136 + c] = rc_[j]; } }
        BSYNC();
        {   unsigned xw[16];
#pragma unroll
            for (int j = 0; j < 16; ++j) xw[j] = rx_[j];
#pragma unroll
            for (int q = 0; q < 2; ++q) { v4u u0;
                u0.x = xw[8 * q] | (xw[8 * q + 1] << 16); u0.y = xw[8 * q + 2] | (xw[8 * q + 3] << 16); u0.z = xw[8 * q + 4] | (xw[8 * q + 5] << 16); u0.w = xw[8 * q + 6] | (xw[8 * q + 7] << 16);
                *(v4u*)(rec + MREC_XT + xc * 64 + rh * 32 + q * 16) = u0; } }
        BSYNC();
        if (unit + F.G < M_NUNITS) M1_LOAD(unit + F.G);
        f32x4 X00 = {0.f, 0.f, 0.f, 0.f}, X01 = X00, X11 = X00;
#pragma unroll
        for (int ks = 0; ks < 4; ++ks) {
            const bf16x8 b0 = *(const LAS bf16x8*)(BT + i16 * 136 + ks * 32 + g * 8), b1 = *(const LAS bf16x8*)(BT + (16 + i16) * 136 + ks * 32 + g * 8);
            const bf16x8 c0 = *(const LAS bf16x8*)(CT + i16 * 136 + ks * 32 + g * 8), c1 = *(const LAS bf16x8*)(CT + (16 + i16) * 136 + ks * 32 + g * 8);
            X00 = MFMA16(b0, c0, X00); X01 = MFMA16(b0, c1, X01); X11 = MFMA16(b1, c1, X11);
        }
        {   const LAS float* ll = LL + hg * 32; const LAS float* dl = DTL + hg * 32;
            const float lt0 = ll[i16], lt1 = ll[16 + i16];
            const f32x4 ls0 = *(const LAS f32x4*)(ll + 4 * g), ls1 = *(const LAS f32x4*)(ll + 16 + 4 * g), ds0 = *(const LAS f32x4*)(dl + 4 * g), ds1 = *(const LAS f32x4*)(dl + 16 + 4 * g);
#pragma unroll
            for (int r = 0; r < 4; ++r) {
                X00[r] = (4 * g + r <= i16) ? X00[r] * __expf(lt0 - ls0[r]) * ds0[r] : 0.f;
                X01[r] = X01[r] * __expf(lt1 - ls0[r]) * ds0[r];
                X11[r] = (4 * g + r <= i16) ? X11[r] * __expf(lt1 - ls1[r]) * ds1[r] : 0.f; } }
        {   const bf16x8 w0 = pack8(X00, (f32x4){0.f, 0.f, 0.f, 0.f}), w1 = pack8(X01, X11);
            if (ph == 0) { v4u* wr = (v4u*)(rec + MREC_W + hg * 2048 + F.lane * 32); wr[0] = __builtin_bit_cast(v4u, w0); wr[1] = __builtin_bit_cast(v4u, w1); } }
        BSYNC();
    }
#undef M1_LOAD
#undef M1_DECODE
}
constexpr int M2_CT = 0, M2_BTT = 8704, M2_XT = 18944, M2_EL = 39424, M2_WS = 39936, M2_DEND = 40448, M2_W = 40512, M2_IMG = 48704, M2_SLOT = 49152;
__device__ __forceinline__ void ph_s2_mamba(const Args& a, const Frame& F) {
    const bf16* XBC = (const bf16*)(a.ws + WS_XBC); bf16* O = (bf16*)(a.ws + WS_O_MB); const unsigned char* REC = a.ws + WS_REC_MB;
    const int g = F.lane >> 4, i16 = F.lane & 15, w = F.wave, hg = w >> 1, ph = w & 1;
    for (int chain = F.bid; chain < 128; chain += F.G) {
        const int b = chain >> 4, grp = (chain >> 1) & 7, dir = chain & 1;
        const unsigned char* rec0 = REC + (size_t)chain * 136 * MREC_BYTES;
        const unsigned char* xbc0 = (const unsigned char*)(XBC + 3072 + grp * 128);
        unsigned soff[12]; int crow[12];
#pragma unroll
        for (int j = 0; j < 12; ++j) { const int q = 16 * ((12 * (w & 3) + j) * 64 + F.lane); int src, cr = -1;
            if (q < M2_BTT) { cr = q / 272; const int cb = q % 272; src = cb < 256 ? cb : 0; }
            else if (q < M2_XT) { const int q2 = q - M2_BTT, row = q2 / 80, cb = q2 % 80; src = row * 64 + (cb < 64 ? cb : 0); }
            else if (q < M2_EL) { const int q2 = q - M2_XT, row = q2 / 80, cb = q2 % 80; src = MREC_XT + row * 64 + (cb < 64 ? cb : 0); }
            else if (q < M2_DEND) src = MREC_EL + (q - M2_EL);
            else if (q < M2_W) src = MREC_DEND + (q - M2_DEND);
            else if (q < M2_IMG) src = MREC_W + (q - M2_W);
            else src = 0;
            soff[j] = (unsigned)src; crow[j] = cr; }
        f32x4 S[8][2];
#pragma unroll
        for (int m = 0; m < 8; ++m) { S[m][0] = (f32x4){0.f, 0.f, 0.f, 0.f}; S[m][1] = S[m][0]; }
#define M2_DMA(step) do { if (w < 4) { const int st_ = (step) < 136 ? (step) : 135; const unsigned char* rc = rec0 + (size_t)st_ * MREC_BYTES; CHUNK_ROWS(false, b, dir, st_ * 32) \
        LAS unsigned char* dst = F.lds + ((step) % 3) * M2_SLOT + w * 12288; \
        _Pragma("unroll") for (int j = 0; j < 12; ++j) { const unsigned char* sp = crow[j] >= 0 ? xbc0 + (size_t)(row0_ + crow[j] * rstr_) * 8192 + soff[j] : rc + soff[j]; \
            __builtin_amdgcn_global_load_lds((const unsigned*)sp, (LAS unsigned*)(dst + j * 1024), 16, 0, 2  ); } } } while (0)
#define M2_STEP(step, NW) do { \
        M2_DMA((step) + 2); \
        const LAS unsigned char* im = F.lds + ((step) % 3) * M2_SLOT; const LAS bf16* CT = (const LAS bf16*)(im + M2_CT); const LAS bf16* BTT = (const LAS bf16*)(im + M2_BTT); \
        const LAS bf16* XT = (const LAS bf16*)(im + M2_XT); const LAS float* EL = (const LAS float*)(im + M2_EL) + hg * 32; const LAS float* WSC = (const LAS float*)(im + M2_WS) + hg * 32; \
        const float dend = ((const LAS float*)(im + M2_DEND))[hg]; \
        f32x4 Y[2][2]; \
        _Pragma("unroll") for (int ti = 0; ti < 2; ++ti) { Y[ti][0] = (f32x4){0.f, 0.f, 0.f, 0.f}; Y[ti][1] = Y[ti][0]; } \
        _Pragma("unroll") for (int ks = 0; ks < 4; ++ks) { \
            const bf16x8 a0 = cat8(*(const LAS bf16x4*)(CT + i16 * 136 + 32 * ks + 4 * g), *(const LAS bf16x4*)(CT + i16 * 136 + 32 * ks + 16 + 4 * g)); \
            const bf16x8 a1 = cat8(*(const LAS bf16x4*)(CT + (16 + i16) * 136 + 32 * ks + 4 * g), *(const LAS bf16x4*)(CT + (16 + i16) * 136 + 32 * ks + 16 + 4 * g)); \
            _Pragma("unroll") for (int nt = 0; nt < 2; ++nt) { const bf16x8 sb = pack8(S[2 * ks][nt], S[2 * ks + 1][nt]); Y[0][nt] = MFMA16(sb, a0, Y[0][nt]); Y[1][nt] = MFMA16(sb, a1, Y[1][nt]); } } \
        { const float e0 = EL[i16], e1 = EL[16 + i16]; \
          const LAS v4u* wt = (const LAS v4u*)(im + M2_W + hg * 2048 + F.lane * 32); const bf16x8 w0 = __builtin_bit_cast(bf16x8, wt[0]), w1 = __builtin_bit_cast(bf16x8, wt[1]); \
          bf16* ob = O + (size_t)(chain * 136 + (step)) * 32 * 256 + hg * 64 + ph * 32 + 4 * g; \
          _Pragma("unroll") for (int nt = 0; nt < 2; ++nt) { const LAS bf16* xr = XT + (hg * 64 + ph * 32 + nt * 16 + i16) * 40; \
              const bf16x8 vbp = cat8(*(const LAS bf16x4*)(xr + 4 * g), *(const LAS bf16x4*)(xr + 16 + 4 * g)); \
              const f32x4 y0 = MFMA16(vbp, w0, Y[0][nt] * e0), y1 = MFMA16(vbp, w1, Y[1][nt] * e1);        \
              *(v2u*)(ob + (size_t)i16 * 256 + 16 * nt) = (v2u){pk2(y0[0], y0[1]), pk2(y0[2], y0[3])}; \
              *(v2u*)(ob + (size_t)(16 + i16) * 256 + 16 * nt) = (v2u){pk2(y1[0], y1[1]), pk2(y1[2], y1[3])}; } } \
        { const f32x4 ws0 = *(const LAS f32x4*)(WSC + 8 * g), ws1 = *(const LAS f32x4*)(WSC + 8 * g + 4); \
          _Pragma("unroll") for (int nt = 0; nt < 2; ++nt) { const v4u xv = *(const LAS v4u*)(XT + (hg * 64 + ph * 32 + nt * 16 + i16) * 40 + 8 * g); \
            v4u xs; xs.x = pk2(bflo(xv.x) * ws0.x, bfhi(xv.x) * ws0.y); xs.y = pk2(bflo(xv.y) * ws0.z, bfhi(xv.y) * ws0.w); xs.z = pk2(bflo(xv.z) * ws1.x, bfhi(xv.z) * ws1.y); xs.w = pk2(bflo(xv.w) * ws1.z, bfhi(xv.w) * ws1.w); \
            const bf16x8 vb2 = __builtin_bit_cast(bf16x8, xs);                                              \
            _Pragma("unroll") for (int m = 0; m < 8; ++m) { const bf16x8 ba = *(const LAS bf16x8*)(BTT + (16 * m + i16) * 40 + 8 * g); S[m][nt] = MFMA16(ba, vb2, S[m][nt] * dend); } } } \
        asm volatile("s_waitcnt lgkmcnt(0)" ::: "memory"); if (w < 4) S2_WAITV(NW); __builtin_amdgcn_s_barrier(); asm volatile("" ::: "memory"); } while (0)
        M2_DMA(0); M2_DMA(1); if (w < 4) S2_WAITV(12); __builtin_amdgcn_s_barrier(); asm volatile("" ::: "memory");
        M2_STEP(0, 16);
        for (int step = 1; step < 136; ++step) M2_STEP(step, 20);
        if (w < 4) S2_WAITV(0); BSYNC();
#undef M2_STEP
#undef M2_DMA
    }
}
template <int HV  >
__device__ __forceinline__ void ph_post_gla(const Args& a, const Frame& F, const float* gain, int ldp, int ogcol0) {
    constexpr int NH = 1024 / HV; constexpr bool PERMUTED = HV == 256;
    const bf16* P = (const bf16*)(a.ws + WS_P); const bf16* O = (const bf16*)(a.ws + WS_O_GLA); bf16* A2 = (bf16*)(a.ws + WS_A2);
    const int gw = F.bid * NWAVES + F.wave, NGW = F.G * NWAVES;
    const int h = (16 * F.lane) / HV, cih = (16 * F.lane) % HV;
    float gn[16];
#pragma unroll
    for (int i = 0; i < 16; ++i) gn[i] = gain[cih + i];
    for (int row = gw; row < MROWS; row += NGW) {
        const int b = row < NLAT ? (row >> 12) : ((row - NLAT) >> 8);
        const int pf = scan_pos(PERMUTED, row, 0), pb = scan_pos(PERMUTED, row, 1);
        const size_t of_ = ((size_t)(((b * NH + h) * 2 + 0) * 136 + (pf >> 5)) * 32 + (pf & 31)) * HV + cih, ob_ = ((size_t)(((b * NH + h) * 2 + 1) * 136 + (pb >> 5)) * 32 + (pb & 31)) * HV + cih;
        const v4u* of = (const v4u*)(O + of_); const v4u* ob = (const v4u*)(O + ob_);
        const v4u* og = (const v4u*)(P + (size_t)row * ldp + ogcol0) + 2 * F.lane;
        float o[16], gte[16];
#pragma unroll
        for (int hh = 0; hh < 2; ++hh) { const v4u wf = of[hh], wb = ob[hh], wg = og[hh];
#pragma unroll
            for (int q = 0; q < 4; ++q) { o[8 * hh + 2 * q] = bflo(wf[q]) + bflo(wb[q]); o[8 * hh + 2 * q + 1] = bfhi(wf[q]) + bfhi(wb[q]);
                gte[8 * hh + 2 * q] = bflo(wg[q]); gte[8 * hh + 2 * q + 1] = bfhi(wg[q]); } }
        float ss = 0.f;
#pragma unroll
        for (int i = 0; i < 16; ++i) ss += o[i] * o[i];
#pragma unroll
        for (int m = 1; m < HV / 16; m <<= 1) ss += __shfl_xor(ss, m);
        const float rstd = rsqrtf(ss * (1.f / HV) + NORM_EPS);
        v4u w[2];
#pragma unroll
        for (int hh = 0; hh < 2; ++hh)
#pragma unroll
            for (int q = 0; q < 4; ++q) { const int i = 8 * hh + 2 * q; w[hh][q] = pk2(o[i] * rstd * gn[i] * siluf_(gte[i]), o[i + 1] * rstd * gn[i + 1] * siluf_(gte[i + 1])); }
        v4u* dst = (v4u*)(A2 + (size_t)row * 1024) + 2 * F.lane; dst[0] = w[0]; dst[1] = w[1];
    }
}
__device__ __forceinline__ void ph_mamba_conv(const Args& a, const Frame& F) {
    const bf16* P = (const bf16*)(a.ws + WS_P); bf16* XBC = (bf16*)(a.ws + WS_XBC); float* DT = (float*)(a.ws + WS_DT);
    const float* cw = a.in[I_MB_CW]; const float* cb = a.in[I_MB_CB]; const float* dtb = a.in[I_MB_DTB];
    const int c0 = F.tid * 8;
    float kw[5][8], bias[8];
#pragma unroll
    for (int j = 0; j < 5; ++j) { const f32x4 k0 = *(const f32x4*)(cw + j * 4096 + c0), k1 = *(const f32x4*)(cw + j * 4096 + c0 + 4);
        kw[j][0] = k0.x; kw[j][1] = k0.y; kw[j][2] = k0.z; kw[j][3] = k0.w; kw[j][4] = k1.x; kw[j][5] = k1.y; kw[j][6] = k1.z; kw[j][7] = k1.w; }
#pragma unroll
    for (int i = 0; i < 8; ++i) bias[i] = cb[c0 + i];
    const int per = (MROWS + F.G - 1) / F.G, r0 = F.bid * per, r1 = (r0 + per < MROWS) ? r0 + per : MROWS;
    if (r0 >= MROWS) return;
#define MC_LOAD(r) (*(const v4u*)(P + (size_t)((r) < 0 ? 0 : ((r) >= MROWS ? MROWS - 1 : (r))) * N_MBP + c0))
    for (int rc = r0; rc < r1; rc += 8) {
        v4u wv[12];
#pragma unroll
        for (int i = 0; i < 12; ++i) wv[i] = MC_LOAD(rc - 2 + i);
#pragma unroll
        for (int i = 0; i < 8; ++i) { const int row = rc + i; if (row >= r1) break;
            int t, L; if (row < NLAT) { t = row & (SEQ - 1); L = SEQ; } else { t = (row - NLAT) & (CTXL - 1); L = CTXL; }
            float acc[8];
#pragma unroll
            for (int e = 0; e < 8; ++e) acc[e] = bias[e];
#pragma unroll
            for (int j = 0; j < 5; ++j) if (t + j - 2 >= 0 && t + j - 2 < L) { const v4u VV = wv[i + j];
                acc[0] += bflo(VV[0]) * kw[j][0]; acc[1] += bfhi(VV[0]) * kw[j][1]; acc[2] += bflo(VV[1]) * kw[j][2]; acc[3] += bfhi(VV[1]) * kw[j][3];
                acc[4] += bflo(VV[2]) * kw[j][4]; acc[5] += bfhi(VV[2]) * kw[j][5]; acc[6] += bflo(VV[3]) * kw[j][6]; acc[7] += bfhi(VV[3]) * kw[j][7]; }
            v4u o; o.x = pk2(siluf_(acc[0]), siluf_(acc[1])); o.y = pk2(siluf_(acc[2]), siluf_(acc[3])); o.z = pk2(siluf_(acc[4]), siluf_(acc[5])); o.w = pk2(siluf_(acc[6]), siluf_(acc[7]));
            *(v4u*)(XBC + (size_t)row * 4096 + c0) = o;
            if (c0 < 64) {
#pragma unroll
                for (int e = 0; e < 8; ++e) { const float x = bf2f(P[(size_t)row * N_MBP + 4096 + c0 + e]) + dtb[c0 + e];
                    DT[(size_t)row * 64 + c0 + e] = x > 20.f ? x : log1pf(__expf(x)); }
            }
        }
    }
#undef MC_LOAD
}
__device__ __forceinline__ void ph_post_mamba(const Args& a, const Frame& F) {
    const bf16* ZB = (const bf16*)(a.ws + WS_ZB); const bf16* XBC = (const bf16*)(a.ws + WS_XBC); const bf16* O = (const bf16*)(a.ws + WS_O_MB); bf16* A2 = (bf16*)(a.ws + WS_A2);
    const float* ng = a.in[I_MB_NG]; const float dsk = a.in[I_MB_D][F.lane >> 1];
    const int gw = F.bid * NWAVES + F.wave, NGW = F.G * NWAVES;
    for (int row = gw; row < MROWS; row += NGW) {
        const int b = row < NLAT ? (row >> 12) : ((row - NLAT) >> 8), grp = F.lane >> 3, cig = (32 * F.lane) & 255;
        const int pf = scan_pos(false, row, 0), pb = scan_pos(false, row, 1);
        const size_t of_ = ((size_t)(((b * 8 + grp) * 2 + 0) * 136 + (pf >> 5)) * 32 + (pf & 31)) * 256 + cig, ob_ = ((size_t)(((b * 8 + grp) * 2 + 1) * 136 + (pb >> 5)) * 32 + (pb & 31)) * 256 + cig;
        const v4u* yf = (const v4u*)(O + of_); const v4u* yb = (const v4u*)(O + ob_);
        const v4u* xs = (const v4u*)(XBC + (size_t)row * 4096) + 4 * F.lane; const v4u* zz = (const v4u*)(ZB + (size_t)row * 2048) + 4 * F.lane;
        float y[32]; float ss = 0.f;
#pragma unroll
        for (int h = 0; h < 4; ++h) { const v4u wf = yf[h], wb = yb[h], wx = xs[h], wz = zz[h];
#pragma unroll
            for (int q = 0; q < 4; ++q) { const int i = 8 * h + 2 * q;
                y[i] = ((bflo(wf[q]) + bflo(wb[q])) + dsk * bflo(wx[q])) * siluf_(bflo(wz[q])); y[i + 1] = ((bfhi(wf[q]) + bfhi(wb[q])) + dsk * bfhi(wx[q])) * siluf_(bfhi(wz[q]));
                ss += y[i] * y[i] + y[i + 1] * y[i + 1]; } }
        ss += __shfl_xor(ss, 1); ss += __shfl_xor(ss, 2); ss += __shfl_xor(ss, 4);
        const float rstd = rsqrtf(ss * (1.f / 256.f) + NORM_EPS);
        const f32x4* gp = (const f32x4*)(ng + 32 * F.lane);
        v4u* dst = (v4u*)(A2 + (size_t)row * 2048) + 4 * F.lane;
#pragma unroll
        for (int h = 0; h < 4; ++h) { const f32x4 g0 = gp[2 * h], g1 = gp[2 * h + 1]; const int i = 8 * h;
            v4u w; w.x = pk2(y[i] * rstd * g0.x, y[i + 1] * rstd * g0.y); w.y = pk2(y[i + 2] * rstd * g0.z, y[i + 3] * rstd * g0.w);
            w.z = pk2(y[i + 4] * rstd * g1.x, y[i + 5] * rstd * g1.y); w.w = pk2(y[i + 6] * rstd * g1.z, y[i + 7] * rstd * g1.w); dst[h] = w; }
    }
}
constexpr int FFT_N = 8192;
constexpr int HY_DATA = 0, HY_Z1 = 69632;
__device__ __forceinline__ f32x2 cmul(f32x2 a, f32x2 b) { return (f32x2){a.x * b.x - a.y * b.y, a.x * b.y + a.y * b.x}; }
__device__ __forceinline__ f32x2 cmulc(f32x2 a, f32x2 b) { return (f32x2){a.x * b.x + a.y * b.y, a.y * b.x - a.x * b.y}; }
__device__ __forceinline__ f32x2 cw(float turns) { float s, c; sincospif(2.0f * turns, &s, &c); return (f32x2){c, -s}; }
__device__ __forceinline__ constexpr int FP(int i) { return i + (i >> 4); }
#define C16R(q) ((q) == 0 ? 1.0f : (q) == 1 ? 0.9238795325112867f : (q) == 2 ? 0.7071067811865476f : (q) == 3 ? 0.3826834323650898f : (q) == 4 ? 0.0f : (q) == 5 ? -0.3826834323650898f : (q) == 6 ? -0.7071067811865476f : -0.9238795325112867f)
#define C16I(q) ((q) == 0 ? 0.0f : (q) == 1 ? -0.3826834323650898f : (q) == 2 ? -0.7071067811865476f : (q) == 3 ? -0.9238795325112867f : (q) == 4 ? -1.0f : (q) == 5 ? -0.9238795325112867f : (q) == 6 ? -0.7071067811865476f : -0.3826834323650898f)
template <bool INV>
__device__ __forceinline__ void r16_pure(f32x2 (&v)[16]) {
#pragma unroll
    for (int tt = 0; tt < 4; ++tt) { const int t = INV ? 3 - tt : tt, h = 8 >> t;
#pragma unroll
        for (int k = 0; k < 16; ++k) { if (k & h) continue; const int q = (k & (h - 1)) * (8 / h);
            const f32x2 T = (f32x2){C16R(q), C16I(q)};
            if (!INV) { const f32x2 a = v[k], b = v[k + h], d = a - b; v[k] = a + b;
                v[k + h] = (q == 0) ? d : (q == 4) ? (f32x2){d.y, -d.x} : (q == 2) ? (f32x2){(d.x + d.y) * 0.7071067811865476f, (d.y - d.x) * 0.7071067811865476f}
                         : (q == 6) ? (f32x2){(d.y - d.x) * 0.7071067811865476f, -(d.x + d.y) * 0.7071067811865476f} : cmul(d, T); }
            else { const f32x2 a = v[k], u = v[k + h];
                const f32x2 b = (q == 0) ? u : (q == 4) ? (f32x2){-u.y, u.x} : (q == 2) ? (f32x2){(u.x - u.y) * 0.7071067811865476f, (u.x + u.y) * 0.7071067811865476f}
                              : (q == 6) ? (f32x2){-(u.x + u.y) * 0.7071067811865476f, (u.x - u.y) * 0.7071067811865476f} : cmulc(u, T);
                v[k] = a + b; v[k + h] = a - b; } } }
}
constexpr int HY_TW256 = 102400, HY_TW16 = 102400 + 32768;
__device__ __forceinline__ void fft_build_tw(const Frame& F) {
    LAS f32x2* t256 = (LAS f32x2*)(F.lds + HY_TW256); LAS f32x2* t16 = (LAS f32x2*)(F.lds + HY_TW16);
    for (int i = F.tid; i < 16 * 256; i += NT) { const int k = i >> 8, lo = i & 255, f = ((k & 1) << 3) | ((k & 2) << 1) | ((k & 4) >> 1) | ((k & 8) >> 3); t256[i] = cw((float)(lo * f) * (1.0f / 4096.0f)); }
    if (F.tid < 256) { const int k = F.tid >> 4, lo = F.tid & 15, f = ((k & 1) << 3) | ((k & 2) << 1) | ((k & 4) >> 1) | ((k & 8) >> 3); t16[F.tid] = cw((float)(lo * f) * (1.0f / 256.0f)); }
    BSYNC();
}
template <int S, bool INV>
__device__ __forceinline__ void fft_pass(LAS f32x2* x, int tid) {
    const int half = tid >> 8, r = tid & 255; int g0;
    const LAS f32x2* tw = S == 256 ? (const LAS f32x2*)((LAS unsigned char*)x + HY_TW256) + r : (const LAS f32x2*)((LAS unsigned char*)x + HY_TW16) + (r & 15);
    constexpr int TS = S == 256 ? 256 : 16;
    if (S == 256) { g0 = r; } else if (S == 16) { g0 = (r >> 4) * 256 + (r & 15); } else { g0 = r * 16; }
    LAS f32x2* p = x + FP(half * 4096 + g0); constexpr int PS = S == 256 ? 272 : (S == 16 ? 17 : 1);
    f32x2 v[16];
#pragma unroll
    for (int k = 0; k < 16; ++k) v[k] = p[PS * k];
    if (INV && S != 1) {
#pragma unroll
        for (int k = 1; k < 16; ++k) v[k] = cmulc(v[k], tw[k * TS]); }
    r16_pure<INV>(v);
    if (!INV && S != 1) {
#pragma unroll
        for (int k = 1; k < 16; ++k) v[k] = cmul(v[k], tw[k * TS]); }
#pragma unroll
    for (int k = 0; k < 16; ++k) p[PS * k] = v[k];
}
__device__ __forceinline__ void fft_pass1_mul(LAS f32x2* x, const unsigned* sp, int tid) {
    const int half = tid >> 8, r = tid & 255, g0 = half * 4096 + r * 16;
    LAS f32x2* p = x + FP(g0); const v4u* s4 = (const v4u*)(sp + g0);
    f32x2 v[16];
#pragma unroll
    for (int k = 0; k < 16; ++k) v[k] = p[k];
    r16_pure<false>(v);
#pragma unroll
    for (int k = 0; k < 4; ++k) { const v4u s = s4[k];
#pragma unroll
        for (int e = 0; e < 4; ++e) v[4 * k + e] = cmul(v[4 * k + e], (f32x2){bflo(s[e]), bfhi(s[e])}); }
    r16_pure<true>(v);
#pragma unroll
    for (int k = 0; k < 16; ++k) p[k] = v[k];
}
__device__ __forceinline__ float block_sum(float v, LAS float* red, const Frame& F) {
    v = wave_sum(v); if (F.lane == 0) red[F.wave] = v; BSYNC();
    float s = 0.f;
#pragma unroll
    for (int w = 0; w < NWAVES; ++w) s += red[w];
    BSYNC(); return s;
}
__device__ __forceinline__ void ph_hy_mlp(const Args& a, const Frame& F) {
    float* A3G = (float*)(a.ws + WS_A3G);
    const float* w1 = a.in[I_HY_W1]; const float* b1 = a.in[I_HY_B1]; const float* w2 = a.in[I_HY_W2]; const float* b2 = a.in[I_HY_B2];
    const float* w3 = a.in[I_HY_W3]; const float* b3 = a.in[I_HY_B3]; const float* fq = a.in[I_HY_FREQ];
    const int j = F.lane; const float freq = fq[j];
    LAS float* W1 = (LAS float*)(F.lds + 65536); LAS float* W2 = W1 + 33 * 64; LAS float* W3 = W2 + 64 * 64;
    for (int i = F.tid; i < 33 * 64; i += NT) W1[i] = w1[i];
    for (int i = F.tid; i < 64 * 64; i += NT) { W2[i] = w2[i]; W3[i] = w3[i]; }
    BSYNC();
    for (int pos = F.bid * NWAVES + F.wave; pos < SEQ + CTXL; pos += F.G * NWAVES) {
        const bool isx = pos < SEQ; const int L = isx ? SEQ : CTXL, l = isx ? pos : pos - SEQ;
        const float t = (float)l / (float)(L - 1), wl = 6.283185307179586f * (float)l / (float)L;
        float z = 0.f;
        if (j == 0) z = t; else if (j <= 16) z = cosf((1e-4f + (float)(j - 1) * ((15.0f - 1e-4f) / 15.0f)) * wl); else if (j <= 32) z = -sinf((1e-4f + (float)(j - 17) * ((15.0f - 1e-4f) / 15.0f)) * wl);
        float h = b1[j];
#pragma unroll
        for (int i = 0; i < 33; ++i) h += __shfl(z, i) * W1[i * 64 + j];
        const float a1 = sinf(freq * h);
        h = b2[j];
#pragma unroll 16
        for (int i = 0; i < 64; ++i) h += __shfl(a1, i) * W2[i * 64 + j];
        const float a2 = sinf(freq * h);
        h = b3[j];
#pragma unroll 16
        for (int i = 0; i < 64; ++i) h += __shfl(a2, i) * W3[i * 64 + j];
        A3G[(size_t)pos * 64 + j] = sinf(freq * h);
    }
}
__device__ __forceinline__ void ph_hy_filters(const Args& a, const Frame& F, int u0, int ustride, int uend) {
    float* HFT = (float*)(a.ws + WS_HFT); float* HFC = (float*)(a.ws + WS_HFC); const float* A3G = (const float*)(a.ws + WS_A3G);
    LAS float* A3 = (LAS float*)F.lds;
    typedef const __attribute__((address_space(4))) f32x4 cf32x4;
    const cf32x4* w4 = (const cf32x4*)(unsigned long long)a.in[I_HY_W4];
    for (int unit = u0; unit < uend; unit += ustride) {
        const int pb = unit >> 3, c8 = unit & 7; const bool isx = pb < 64; const int L = isx ? SEQ : CTXL, l0 = isx ? pb * 64 : (pb - 64) * 64, pos0 = pb * 64;
#pragma unroll
        for (int k = 0; k < 8; ++k) { const int idx = F.tid + NT * k; A3[(idx >> 6) * 68 + (idx & 63)] = A3G[(size_t)pos0 * 64 + idx]; }
        BSYNC();
        {
            const int l = l0 + F.lane; const float t = (float)l / (float)(L - 1);
            const int o = c8 >> 2, side = (c8 >> 1) & 1;
            for (int k = 0; k < 64; k += 4) {
                const int ch = c8 * 512 + F.wave * 64 + k, d = ch & 1023;
                f32x4 acc = {0.f, 0.f, 0.f, 0.f};
#pragma unroll 4
                for (int i = 0; i < 64; i += 4) { const f32x4 av = *(const LAS f32x4*)(A3 + F.lane * 68 + i);
                    acc += w4[(i * 4096 + ch) >> 2] * av.x; acc += w4[((i + 1) * 4096 + ch) >> 2] * av.y; acc += w4[((i + 2) * 4096 + ch) >> 2] * av.z; acc += w4[((i + 3) * 4096 + ch) >> 2] * av.w; }
#pragma unroll
                for (int e = 0; e < 4; ++e) { const float delta = fabsf(-3.0701134573253945f + (float)(d + e) * ((-15.350567286626973f + 3.0701134573253945f) / 1023.0f));
                    const float v = acc[e] * __expf(-t * delta);
                    if (isx) HFT[(((size_t)((o * 2 + side) * 64 + (l >> 6)) * 1024) + d + e) * 64 + (l & 63)] = v; else HFC[(((size_t)((o * 2 + side) * 4 + (l >> 6)) * 1024) + d + e) * 64 + (l & 63)] = v; }
            }
        }
        BSYNC();
    }
}
__device__ __forceinline__ void ph_hy_spectra(const Args& a, const Frame& F, int u0, int ustride) {
    const float* HFT = (const float*)(a.ws + WS_HFT); unsigned* SPEC = (unsigned*)(a.ws + WS_SPEC);
    LAS f32x2* x = (LAS f32x2*)(F.lds + HY_DATA); LAS float* red = (LAS float*)(F.lds + HY_Z1);
    const f32x2 wt = cw((float)F.tid * (1.0f / FFT_N)), dummy_ = (f32x2){0.f, 0.f}; (void)dummy_; fft_build_tw(F);
    for (int unit = u0; unit < 2048; unit += ustride) {
        const int o = unit >> 10, d = unit & 1023;
#define HFT_AT(side_, l_) HFT[(((size_t)((o * 2 + (side_)) * 64 + ((l_) >> 6)) * 1024) + d) * 64 + ((l_) & 63)]
        float sa = 0.f;
#pragma unroll
        for (int r = 0; r < 8; ++r) { const int i = F.tid + NT * r; const float vf = HFT_AT(0, i), vb0 = HFT_AT(1, i), vb = i ? HFT_AT(1, 4096 - i) : 0.f; sa += fabsf(vf) + fabsf(vb0);
            x[FP(i)] = (f32x2){vf + vb, 0.f}; x[FP(4096 + i)] = cmul(wt, (f32x2){C16R(r), C16I(r)}) * (vf - vb); }
        const float inv = 1.0f / block_sum(sa, red, F);
        fft_pass<256, false>(x, F.tid); BSYNC();
        fft_pass<16, false>(x, F.tid); BSYNC();
        fft_pass<1, false>(x, F.tid); BSYNC();
        unsigned* sp = SPEC + (size_t)unit * FFT_N;
#pragma unroll
        for (int r = 0; r < 16; ++r) { const int i = F.tid + NT * r; const f32x2 v = x[FP(i)] * inv; sp[i] = pk2(v.x, v.y); }
        BSYNC();
    }
#undef HFT_AT
}
__device__ __forceinline__ void ph_hy_conv(const Args& a, const Frame& F) {
    const bf16* P = (const bf16*)(a.ws + WS_P); bf16* UT = (bf16*)(a.ws + WS_UT); bf16* UTC = (bf16*)(a.ws + WS_UTC);
    const float* sw = a.in[I_HY_SW]; const float* sb = a.in[I_HY_SB];
    LAS float* tile = (LAS float*)F.lds;
    constexpr int NU = 3 * 16 * 272;
    v4u raw[3];
#define HYC_DECODE(unit) const int tix = (unit) % 272, dt = ((unit) / 272) & 15, wh = (unit) / (272 * 16), d0 = dt * 64; int b, t0, L, rowb; \
        if (tix < 256) { b = tix >> 5; t0 = (tix & 31) * 128; L = SEQ; rowb = b * SEQ; } else { b = (tix - 256) >> 1; t0 = ((tix - 256) & 1) * 128; L = CTXL; rowb = NLAT + b * CTXL; }
#define HYC_LOAD(unit) do { HYC_DECODE(unit) \
        _Pragma("unroll") for (int k = 0; k < 3; ++k) { const int idx = F.tid + NT * k, r = idx >> 3, ch = idx & 7, t = t0 - 1 + r; \
            raw[k] = (idx < 1040 && t >= 0 && t < L) ? *(const v4u*)(P + (size_t)(rowb + t) * N_HY + wh * 1024 + d0 + 8 * ch) : (v4u){0u, 0u, 0u, 0u}; } } while (0)
    if (F.bid < NU) HYC_LOAD(F.bid);
    for (int unit = F.bid; unit < NU; unit += F.G) {
        HYC_DECODE(unit)
        (void)L; (void)rowb;
#pragma unroll
        for (int k = 0; k < 3; ++k) { const int idx = F.tid + NT * k, r = idx >> 3, ch = idx & 7;
            if (idx < 1040) { LAS float* tp = tile + r * 65 + 8 * ch;
                tp[0] = bflo(raw[k].x); tp[1] = bfhi(raw[k].x); tp[2] = bflo(raw[k].y); tp[3] = bfhi(raw[k].y); tp[4] = bflo(raw[k].z); tp[5] = bfhi(raw[k].z); tp[6] = bflo(raw[k].w); tp[7] = bfhi(raw[k].w); } }
        BSYNC();
        if (unit + F.G < NU) HYC_LOAD(unit + F.G);
        {   const int dd = F.tid >> 3, tq = F.tid & 7, col = wh * 1024 + d0 + dd;
            const float k0 = sw[col], k1 = sw[3072 + col], k2 = sw[6144 + col], bb = sb[col];
            float x0 = tile[(16 * tq) * 65 + dd], x1 = tile[(16 * tq + 1) * 65 + dd]; unsigned w[8];
#pragma unroll
            for (int j = 0; j < 16; j += 2) { const float x2 = tile[(16 * tq + j + 2) * 65 + dd], x3 = tile[(16 * tq + j + 3) * 65 + dd];
                w[j >> 1] = pk2(x0 * k0 + x1 * k1 + x2 * k2 + bb, x1 * k0 + x2 * k1 + x3 * k2 + bb); x0 = x2; x1 = x3; }
            bf16* dst = (tix < 256) ? UT + ((size_t)(wh * 8 + b) * 1024 + d0 + dd) * SEQ + t0 + 16 * tq : UTC + ((size_t)(wh * 8 + b) * 1024 + d0 + dd) * CTXL + t0 + 16 * tq;
            ((v4u*)dst)[0] = (v4u){w[0], w[1], w[2], w[3]}; ((v4u*)dst)[1] = (v4u){w[4], w[5], w[6], w[7]}; }
        BSYNC();
    }
#undef HYC_LOAD
#undef HYC_DECODE
}
__device__ __forceinline__ void ph_hy_fftconv(const Args& a, const Frame& F) {
    const bf16* UT = (const bf16*)(a.ws + WS_UT); const bf16* UTC = (const bf16*)(a.ws + WS_UTC); const unsigned* SPEC = (const unsigned*)(a.ws + WS_SPEC);
    const float* HFC = (const float*)(a.ws + WS_HFC); bf16* ZT = (bf16*)(a.ws + WS_ZT); bf16* ZTC = (bf16*)(a.ws + WS_ZTC); const float* fb = a.in[I_HY_FBIAS];
    LAS f32x2* x = (LAS f32x2*)(F.lds + HY_DATA); LAS f32x2* z1 = (LAS f32x2*)(F.lds + HY_Z1);
    const f32x2 wt4 = cw((float)F.tid * (4.0f / FFT_N)), dummy_ = (f32x2){0.f, 0.f}; (void)dummy_; fft_build_tw(F);
#define HY_TW(r2, e) cmul((r2) ? (f32x2){wt4.y, -wt4.x} : wt4, (f32x2){(e) == 0 ? 1.0f : (e) == 1 ? 0.9999997058628822f : (e) == 2 ? 0.9999988234517019f : 0.9999973527669782f, \
                                                                     (e) == 0 ? 0.0f : (e) == 1 ? -0.0007669903187427045f : (e) == 2 ? -0.0015339801862847655f : -0.0023009691514258070f})
#define HY_LD4(p, t0, out) do { const v2u w_ = *(const v2u*)((p) + (t0)); out[0] = bflo(w_.x); out[1] = bfhi(w_.x); out[2] = bflo(w_.y); out[3] = bfhi(w_.y); } while (0)
    for (int d = F.bid; d < 1024; d += F.G) {
        const float bias0 = fb[d], bias1 = fb[1024 + d]; const float invn = 1.0f / FFT_N;
        const unsigned* sp0 = SPEC + (size_t)(0 * 1024 + d) * FFT_N; const unsigned* sp1 = SPEC + (size_t)(1 * 1024 + d) * FFT_N;
#pragma unroll 1
        for (int pr = 0; pr < 4; ++pr) {
            const int b1 = 2 * pr, b2 = 2 * pr + 1;
            const bf16* v1 = UT + ((size_t)(2 * 8 + b1) * 1024 + d) * SEQ; const bf16* v2 = UT + ((size_t)(2 * 8 + b2) * 1024 + d) * SEQ;
            const bf16* g1a = UT + ((size_t)(0 * 8 + b1) * 1024 + d) * SEQ; const bf16* g1b = UT + ((size_t)(0 * 8 + b2) * 1024 + d) * SEQ;
            const bf16* g2a = UT + ((size_t)(1 * 8 + b1) * 1024 + d) * SEQ; const bf16* g2b = UT + ((size_t)(1 * 8 + b2) * 1024 + d) * SEQ;
#pragma unroll
            for (int r2 = 0; r2 < 2; ++r2) { const int t0 = 4 * (F.tid + NT * r2); float a1[4], a2[4]; HY_LD4(v1, t0, a1); HY_LD4(v2, t0, a2);
#pragma unroll
                for (int e = 0; e < 4; ++e) { const f32x2 z0 = (f32x2){a1[e], a2[e]}; x[FP(t0 + e)] = z0; x[FP(t0 + e + SEQ)] = cmul(z0, HY_TW(r2, e)); } }
            BSYNC();
            fft_pass<256, false>(x, F.tid); BSYNC();
            fft_pass<16, false>(x, F.tid); BSYNC();
            fft_pass1_mul(x, sp0, F.tid); BSYNC();
            fft_pass<16, true>(x, F.tid); BSYNC();
            fft_pass<256, true>(x, F.tid); BSYNC();
#pragma unroll
            for (int r2 = 0; r2 < 2; ++r2) { const int t0 = 4 * (F.tid + NT * r2); float a1[4], a2[4], ga[4], gb[4]; HY_LD4(v1, t0, a1); HY_LD4(v2, t0, a2); HY_LD4(g1a, t0, ga); HY_LD4(g1b, t0, gb);
#pragma unroll
                for (int e = 0; e < 4; ++e) { const f32x2 wr = HY_TW(r2, e); const int t = t0 + e;
                    const f32x2 y = (x[FP(t)] + cmulc(x[FP(t + SEQ)], wr)) * invn;
                    const f32x2 zz = (f32x2){ga[e], gb[e]} * (y + (f32x2){a1[e], a2[e]} * bias0); z1[t] = zz; x[FP(t)] = zz; x[FP(t + SEQ)] = cmul(zz, wr); } }
            BSYNC();
            fft_pass<256, false>(x, F.tid); BSYNC();
            fft_pass<16, false>(x, F.tid); BSYNC();
            fft_pass1_mul(x, sp1, F.tid); BSYNC();
            fft_pass<16, true>(x, F.tid); BSYNC();
            fft_pass<256, true>(x, F.tid); BSYNC();
            bf16* o1 = ZT + ((size_t)b1 * 1024 + d) * SEQ; bf16* o2 = ZT + ((size_t)b2 * 1024 + d) * SEQ;
#pragma unroll
            for (int r2 = 0; r2 < 2; ++r2) { const int t0 = 4 * (F.tid + NT * r2); float ga[4], gb[4], za[4], zb[4]; HY_LD4(g2a, t0, ga); HY_LD4(g2b, t0, gb);
#pragma unroll
                for (int e = 0; e < 4; ++e) { const f32x2 wr = HY_TW(r2, e); const int t = t0 + e;
                    const f32x2 y = (x[FP(t)] + cmulc(x[FP(t + SEQ)], wr)) * invn;
                    const f32x2 zz = (f32x2){ga[e], gb[e]} * (y + z1[t] * bias1); za[e] = zz.x; zb[e] = zz.y; }
                *(v2u*)(o1 + t0) = (v2u){pk2(za[0], za[1]), pk2(za[2], za[3])}; *(v2u*)(o2 + t0) = (v2u){pk2(zb[0], zb[1]), pk2(zb[2], zb[3])}; }
        }
        BSYNC();
        {   LAS float* hh = (LAS float*)(F.lds + HY_DATA);
            LAS float* zc = hh + 1028;
            LAS float* zc1 = zc + 2048;
            LAS float* red = zc1 + 2048;
            { const int side = F.tid >> 8, l = F.tid & 255;
              const float h0 = HFC[(((size_t)((0 * 2 + side) * 4 + (l >> 6)) * 1024) + d) * 64 + (l & 63)], h1 = HFC[(((size_t)((1 * 2 + side) * 4 + (l >> 6)) * 1024) + d) * 64 + (l & 63)];
              const float n0 = block_sum(fabsf(h0), red, F), n1 = block_sum(fabsf(h1), red, F);
              if (side == 0) { hh[1 + 255 + l] = h0 / n0; hh[514 + 1 + 255 + l] = h1 / n1; } else if (l > 0) { hh[1 + 255 - l] = h0 / n0; hh[514 + 1 + 255 - l] = h1 / n1; }
              if (F.tid == 0) { hh[0] = 0.f; hh[514] = 0.f; } }
            for (int i = F.tid; i < 2048; i += NT) zc[i] = bf2f(UTC[((size_t)(2 * 8 + (i >> 8)) * 1024 + d) * 256 + (i & 255)]);
            BSYNC();
            const int b = F.tid >> 6, t0 = 4 * (F.tid & 63);
#pragma unroll
            for (int o = 0; o < 2; ++o) {
                const LAS float* hp = hh + o * 514 + 1 + 255 + t0; const LAS float* zin = (o == 0 ? zc : zc1) + b * 256;
                float h0 = hp[0], h1 = hp[1], h2 = hp[2], h3 = hp[3], y0 = 0.f, y1 = 0.f, y2 = 0.f, y3 = 0.f;
#pragma unroll 4
                for (int s = 0; s < 256; ++s) { const float zv = zin[s]; y0 += h0 * zv; y1 += h1 * zv; y2 += h2 * zv; y3 += h3 * zv; h3 = h2; h2 = h1; h1 = h0; h0 = hp[-1 - s]; }
                const float bias = o == 0 ? bias0 : bias1; const float yy[4] = {y0, y1, y2, y3};
                const bf16* gp = UTC + ((size_t)(o * 8 + b) * 1024 + d) * 256 + t0;
                float zz[4];
#pragma unroll
                for (int e = 0; e < 4; ++e) zz[e] = bf2f(gp[e]) * (yy[e] + zin[t0 + e] * bias);
                if (o == 0) {
#pragma unroll
                    for (int e = 0; e < 4; ++e) zc1[b * 256 + t0 + e] = zz[e]; }
                else { v2u w; w.x = pk2(zz[0], zz[1]); w.y = pk2(zz[2], zz[3]); *(v2u*)(ZTC + ((size_t)b * 1024 + d) * 256 + t0) = w; }
                BSYNC();
            }
        }
    }
}
__device__ __forceinline__ void ph_hy_transpose(const Args& a, const Frame& F) {
    const bf16* ZT = (const bf16*)(a.ws + WS_ZT); const bf16* ZTC = (const bf16*)(a.ws + WS_ZTC); bf16* A2 = (bf16*)(a.ws + WS_HYA2);
    LAS bf16* tile = (LAS bf16*)F.lds;
    for (int unit = F.bid; unit < 16 * 272; unit += F.G) {
        const int tix = unit % 272, dt = unit / 272, d0 = dt * 64;
        int b, t0, rowb; const bf16* src; int lsrc;
        if (tix < 256) { b = tix >> 5; t0 = (tix & 31) * 128; rowb = b * SEQ; src = ZT + ((size_t)b * 1024 + d0) * SEQ + t0; lsrc = SEQ; }
        else { b = (tix - 256) >> 1; t0 = ((tix - 256) & 1) * 128; rowb = NLAT + b * CTXL; src = ZTC + ((size_t)b * 1024 + d0) * CTXL + t0; lsrc = CTXL; }
#pragma unroll
        for (int k = 0; k < 2; ++k) { const int idx = F.tid + NT * k, dd = idx >> 4, ch = idx & 15; const v4u w = *(const v4u*)(src + (size_t)dd * lsrc + 8 * ch);
            LAS unsigned* tp = (LAS unsigned*)(tile + dd * 130 + 8 * ch); tp[0] = w.x; tp[1] = w.y; tp[2] = w.z; tp[3] = w.w; }
        BSYNC();
#pragma unroll
        for (int k = 0; k < 2; ++k) { const int idx = F.tid + NT * k, tt = idx >> 3, dq = idx & 7; const LAS bf16* s = tile + (8 * dq) * 130 + tt;
            v4u o; o.x = s[0] | ((unsigned)s[130] << 16); o.y = s[260] | ((unsigned)s[390] << 16); o.z = s[520] | ((unsigned)s[650] << 16); o.w = s[780] | ((unsigned)s[910] << 16);
            *(v4u*)(A2 + (size_t)(rowb + t0 + tt) * 1024 + d0 + 8 * dq) = o; }
        BSYNC();
    }
}
__device__ __forceinline__ void moe_gemm1(const Args& a, const Frame& F, int nM) {
    pg8::Gemm g{(const pg8::bf16_t*)(a.ws + WS_H), (const pg8::bf16_t*)(a.ws + WS_WGU), MG, NE * 4096, 1024, (const int*)(a.ws + WS_SRCROW)};
    GroupedOrder S{16, F.G, F.bid, nM}; EpiSwiGLU E{(bf16*)(a.ws + WS_HID)};
    pg8::gemm_phase<EpiSwiGLU, GroupedOrder, true, true, true>(F.lds, g, S, E);
}
__device__ __forceinline__ void moe_gemm2(const Args& a, const Frame& F, bool with_ctx) {
    {   pg8::Gemm g{(const pg8::bf16_t*)(a.ws + WS_HID), (const pg8::bf16_t*)(a.ws + WS_WDN), MG, NE * 1024, 2048};
        GroupedOrder S{4, F.G, F.bid, 16}; EpiDown E{(bf16*)(a.ws + WS_YE), (const float*)(a.ws + WS_GATE)};
        pg8::gemm_phase<EpiDown, GroupedOrder, true, true>(F.lds, g, S, E); }
    if (with_ctx) { pg8::Gemm g{(const pg8::bf16_t*)(a.ws + WS_HID), (const pg8::bf16_t*)(a.ws + WS_WDN), MG, NE * 1024, 512, nullptr, 2048};
        CtxQuarterOrder S{F.G, F.bid}; EpiDownPart E{(bf16*)(a.ws + WS_YEP), (const float*)(a.ws + WS_GATE)};
        pg8::gemm_phase<EpiDownPart, CtxQuarterOrder, true, true>(F.lds, g, S, E); }
}
__device__ __forceinline__ void gemm_in(const Args& a, const Frame& F, int N, const float* bias, bool mamba_split = false, int cvt_layer = -1, int ncvt = 0) {
    const int Gg = F.G > 2 * ncvt ? F.G - ncvt : F.G;
    if (F.bid < Gg) {
        pg8::Gemm g{(const pg8::bf16_t*)(a.ws + WS_H), (const pg8::bf16_t*)(a.ws + WS_WIN), MROWS, N, 1024};
        pg8::StaticOrder S; S.init(MROWS, N, Gg, F.bid);
        EpiStoreBf16 E{(bf16*)(a.ws + WS_P), mamba_split ? N_MBP : N, bias, (bf16*)(a.ws + WS_ZB), 2048, mamba_split ? 8 : 0};
        pg8::gemm_phase<EpiStoreBf16, pg8::StaticOrder, true, true>(F.lds, g, S, E);
    }
    if (cvt_layer >= 0) { asm volatile("s_waitcnt vmcnt(0)" ::: "memory"); BSYNC(); cvt_moe_dyn(a, F, cvt_layer, cvt_layer); }
}
__device__ __forceinline__ void gemm_out(const Args& a, const Frame& F, int layer, size_t a2off, int K, const float* bias, int M = MROWS) {
    pg8::Gemm g{(const pg8::bf16_t*)(a.ws + a2off), (const pg8::bf16_t*)(a.ws + WS_WOUT), M, 1024, K};
    pg8::StaticOrder S; S.init(M, 1024, F.G, F.bid);
    EpiResid E{(bf16*)(a.ws + WS_X), (const float*)(a.ws + WS_MOD) + (size_t)layer * 9 * 6144 + 2 * 1024, bias, layer == 0 ? a.in[I_X] : nullptr, layer == 0 ? a.in[I_CTX] : nullptr};
    pg8::gemm_phase<EpiResid, pg8::StaticOrder, true, true>(F.lds, g, S, E);
}

constexpr int NPHASES = 43;
__global__ void __launch_bounds__(NT, 2) fwd_kernel(Args a0) {
    extern __shared__ __attribute__((aligned(16))) unsigned char lds_raw[];
    Frame F; F.lds = (LAS unsigned char*)lds_raw + LDSCTL_BYTES; F.tid = threadIdx.x; F.lane = F.tid & 63; F.wave = __builtin_amdgcn_readfirstlane(F.tid >> 6); F.G = gridDim.x; F.bid = blockIdx.x;
    volatile LAS unsigned* MISC = (volatile LAS unsigned*)((LAS unsigned char*)lds_raw + MISC_OFF);
    for (int u = F.tid; u < LDSCTL_BYTES / 4; u += NT) ((LAS unsigned*)lds_raw)[u] = 0u;
    __syncthreads();
    const int lo = a0.ph_lo, hi = a0.ph_hi; int rep = 0; (void)rep;
    XcdBarrier bar; bar.bar = (unsigned*)(a0.ws + WS_CTL) + CW_BAR; bar.x = 0; bar.st = nullptr;
    if (hi - lo > 1) bar = xcd_barrier_post((unsigned*)(a0.ws + WS_CTL) + CW_BAR, MISC + 8);
#ifndef PH_LO
#define PH_LO 0
#define PH_HI 1000
#endif
#ifndef PH_LO
#define PH_LO 0
#define PH_HI 1000
#endif
#ifdef DUP_LO
#ifndef S2VAR
#define S2VAR 0
#endif
#define PH(k, body) if ((k) >= PH_LO && (k) <= PH_HI && lo <= (k) && (k) < hi) { Args a = a0; { GAS unsigned char* wsg_ = (GAS unsigned char*)a0.ws; asm volatile("" : "+s"(wsg_)); a.ws = (unsigned char*)wsg_; } rep = 0; body; if ((k) >= DUP_LO && (k) <= DUP_HI) { xcd_barrier(bar); rep = 1; body; } if ((k) + 1 < hi) xcd_barrier(bar); }
#define PH4_S2() do { if (rep == 0) ph_s2_gla<0>(a, F); else (ph_s2_gla<0, S2VAR>)(a, F); } while (0)
#else
#define PH(k, body) if ((k) >= PH_LO && (k) <= PH_HI && lo <= (k) && (k) < hi) { Args a = a0; { GAS unsigned char* wsg_ = (GAS unsigned char*)a0.ws; asm volatile("" : "+s"(wsg_)); a.ws = (unsigned char*)wsg_; } body; if ((k) + 1 < hi) xcd_barrier(bar); }
#define PH4_S2() ph_s2_gla<0>(a, F)
#endif

    PH(0, { ph_prologue(a, F); ph_hy_mlp(a, F); BSYNC();
            cvt_plain(F, a.in[I_HG_WIN], 1024, N_HG, (bf16*)(a.ws + WS_WIN), N_HG); cvt_plain(F, a.in[I_HG_WOUT], 1024, 1024, (bf16*)(a.ws + WS_WOUT), 1024); });
    PH(1, ph_norm1(a, F, 0));
    PH(2, gemm_in(a, F, N_HG, nullptr));
    PH(3, { ph_s1_gla<0>(a, F); ph_hy_filters(a, F, F.bid, F.G, 544); });
    PH(4, { if (F.bid < 128 || F.G <= 128) PH4_S2(); if (rep == 0) { if (F.G < 256) ph_hy_spectra(a, F, F.bid, F.G); else if (F.bid >= 128) ph_hy_spectra(a, F, F.bid - 128, F.G - 128); } BSYNC(); cvt_moe_dyn(a, F, 0, 0); });
    PH(5, ph_post_gla<128>(a, F, a.in[I_HG_ONG], N_HG, 4096));
    PH(6, gemm_out(a, F, 0, WS_A2, 1024, nullptr));
    PH(7, ph_norm2_router(a, F, 0, false));
    PH(8, ph_select_gather(a, F, false));
    PH(9, moe_gemm1(a, F, 17));
    PH(10, moe_gemm2(a, F, true));
    PH(11, { ph_combine(a, F, 0, false); cvt_plain(F, a.in[I_HY_WIN], 1024, N_HY, (bf16*)(a.ws + WS_WIN), N_HY); cvt_plain(F, a.in[I_HY_WOUT], 1024, 1024, (bf16*)(a.ws + WS_WOUT), 1024); });
    PH(12, gemm_in(a, F, N_HY, a.in[I_HY_BIN], false, 1, 16));
    PH(13, ph_hy_conv(a, F));
    PH(14, ph_hy_fftconv(a, F));
    PH(15, ph_hy_transpose(a, F));
    PH(16, gemm_out(a, F, 1, WS_HYA2, 1024, a.in[I_HY_BOUT]));
    PH(17, ph_norm2_router(a, F, 1, false));
    PH(18, ph_select_gather(a, F, false));
    PH(19, moe_gemm1(a, F, 17));
    PH(20, moe_gemm2(a, F, true));
    PH(21, { ph_combine(a, F, 1, false); cvt_plain(F, a.in[I_MB_WIN], 1024, N_MB_REAL, (bf16*)(a.ws + WS_WIN), N_MB); cvt_plain(F, a.in[I_MB_WOUT], 2048, 1024, (bf16*)(a.ws + WS_WOUT), 1024); });
    PH(22, gemm_in(a, F, N_MB, nullptr, true));
    PH(23, ph_mamba_conv(a, F));
    PH(24, ph_s1_mamba(a, F));
    PH(25, { ph_s2_mamba(a, F); if (F.G >= 256) { cvt_moe(a, F, 2, 0, 128, F.G - 128, 0, 7); cvt_moe(a, F, 2, 1, 128, F.G - 128, 0, 7); cvt_moe(a, F, 2, 0, 0, 128, 7, 8); cvt_moe(a, F, 2, 1, 0, 128, 7, 8); } else { cvt_moe(a, F, 2, 0, 0, F.G); cvt_moe(a, F, 2, 1, 0, F.G); } });
    PH(26, ph_post_mamba(a, F));
    PH(27, gemm_out(a, F, 2, WS_A2, 2048, nullptr));
    PH(28, ph_norm2_router(a, F, 2, false));
    PH(29, ph_select_gather(a, F, false));
    PH(30, moe_gemm1(a, F, 17));
    PH(31, moe_gemm2(a, F, true));
    PH(32, { ph_combine(a, F, 2, false); cvt_plain(F, a.in[I_GLA_WIN], 1024, N_GLA_REAL, (bf16*)(a.ws + WS_WIN), N_GLA); cvt_plain(F, a.in[I_GLA_WOUT], 1024, 1024, (bf16*)(a.ws + WS_WOUT), 1024); });
    PH(33, gemm_in(a, F, N_GLA, nullptr));
    PH(34, ph_s1_gla<1>(a, F));
    PH(35, { ph_s2_gla<1>(a, F); if (F.G >= 256) { cvt_moe(a, F, 3, 0, 128, F.G - 128, 0, 7); cvt_moe(a, F, 3, 1, 128, F.G - 128, 0, 7); cvt_moe(a, F, 3, 0, 0, 128, 7, 8); cvt_moe(a, F, 3, 1, 0, 128, 7, 8); } else { cvt_moe(a, F, 3, 0, 0, F.G); cvt_moe(a, F, 3, 1, 0, F.G); } });
    PH(36, ph_post_gla<256>(a, F, a.in[I_GLA_ONG], N_GLA, 2048));
    PH(37, gemm_out(a, F, 3, WS_A2, 1024, nullptr, NLAT));
    PH(38, ph_norm2_router(a, F, 3, true));
    PH(39, ph_select_gather(a, F, true));
    PH(40, moe_gemm1(a, F, 16));
    PH(41, moe_gemm2(a, F, false));
    PH(42, ph_combine(a, F, 3, true));
#undef PH
}

#ifndef N_LAUNCH_MODE
#define N_LAUNCH_MODE 0
#endif
extern "C" void kernel_launch(void* const* d_in, const int* in_sizes, int n_in, void* d_out, int out_size, void* d_ws, size_t ws_size, hipStream_t stream) {
    static int grid = 0;
    if (grid == 0) {
        if (n_in != N_IN || out_size != NLAT * D || ws_size < WS_END) { fprintf(stderr, "kernel_launch: unexpected shapes (n_in %d, out %d, ws %zu)\n", n_in, out_size, ws_size); grid = -1; return; }
        int dev = 0, cus = 0, per_cu = 0;
        if (hipGetDevice(&dev) != hipSuccess || hipDeviceGetAttribute(&cus, hipDeviceAttributeMultiprocessorCount, dev) != hipSuccess) { grid = -1; return; }
        if (hipFuncSetAttribute((const void*)fwd_kernel, hipFuncAttributeMaxDynamicSharedMemorySize, LDS_BYTES) != hipSuccess) { fprintf(stderr, "kernel_launch: hipFuncSetAttribute failed\n"); grid = -1; return; }
        if (hipOccupancyMaxActiveBlocksPerMultiprocessor(&per_cu, (const void*)fwd_kernel, NT, LDS_BYTES) != hipSuccess || per_cu < 1) { fprintf(stderr, "kernel_launch: occupancy query reports %d\n", per_cu); }
        (void)hipGetLastError();
        grid = cus;
    }
    if (grid < 0) return;
    (void)in_sizes;
    if (hipMemsetAsync((char*)d_ws + WS_CTL, 0, CTL_ZERO_BYTES, stream) != hipSuccess) return;
    Args a{};
    for (int i = 0; i < N_IN; ++i) a.in[i] = (const float*)d_in[i];
    a.out = (float*)d_out; a.ws = (unsigned char*)d_ws;
#if N_LAUNCH_MODE == 0
    a.ph_lo = 0; a.ph_hi = NPHASES;
    hipLaunchKernelGGL(fwd_kernel, dim3(grid), dim3(NT), LDS_BYTES, stream, a);
#else
    for (int p = 0; p < NPHASES; ++p) { a.ph_lo = p; a.ph_hi = p + 1; hipLaunchKernelGGL(fwd_kernel, dim3(grid), dim3(NT), LDS_BYTES, stream, a); }
#endif
}
```
